# Optimizing an MI355X kernel written in HIP

```python
import jax, jax.numpy as jnp
from jax import lax
import numpy as np

D_MODEL = 2048
BATCH = 8
SEQ = 2048
DEPTH = 1

MEM_LEN = 256
CONV_WIDTH = D_MODEL // 4
CONV_GROUPS = 8
CONV_K = 3
DIFF_WIDTH = D_MODEL // 2
DIFF_VDIM = 128
DIFF_HALF = 64
DIFF_HEADS = DIFF_WIDTH // DIFF_VDIM
MEM_WIDTH = D_MODEL // 4
MEM_HEADS = 4
MEM_HEAD_DIM = MEM_WIDTH // MEM_HEADS
MIX_WIDTH = CONV_WIDTH + DIFF_WIDTH + MEM_WIDTH
IN_SPLITS = [CONV_WIDTH, CONV_WIDTH, CONV_WIDTH,
             DIFF_WIDTH, DIFF_WIDTH, DIFF_WIDTH, MEM_WIDTH]
IN_WIDTH = sum(IN_SPLITS)
ROT_DIM = DIFF_HALF // 4
ROPE_THETA = 500000.0
FFN_HIDDEN = -(-(8 * D_MODEL) // (3 * 256)) * 256
Q_BLOCK = 128
EPS = 1e-6

kernel_name = "hybrid_conv_diffattn_memxattn_layer"


def rmsnorm(x, g):
    xf = x.astype(jnp.float32)
    r = lax.rsqrt(jnp.mean(xf * xf, axis=-1, keepdims=True) + EPS)
    return (xf * r * g.astype(jnp.float32)).astype(x.dtype)


def lambda_init(layer_idx):
    return 0.8 - 0.6 * float(np.exp(-0.3 * (layer_idx - 1)))


def rope_tables(positions):
    inv_freq = ROPE_THETA ** (-jnp.arange(0, ROT_DIM, 2, dtype=jnp.float32) / ROT_DIM)
    ang = positions.astype(jnp.float32)[..., None] * inv_freq
    return jnp.cos(ang), jnp.sin(ang)


def apply_partial_rope(t, cos, sin):
    c = cos[:, :, None, None, :]
    s = sin[:, :, None, None, :]
    tf = t.astype(jnp.float32)
    half = ROT_DIM // 2
    r1, r2, rest = tf[..., :half], tf[..., half:ROT_DIM], tf[..., ROT_DIM:]
    out = jnp.concatenate([r1 * c - r2 * s, r2 * c + r1 * s, rest], axis=-1)
    return out.astype(t.dtype)


def short_gated_conv(u, c_gate, b_gate, conv_w):
    z = c_gate * u
    w = conv_w[:, None, :].astype(z.dtype)
    conv = lax.conv_general_dilated(
        z, w, window_strides=(1,), padding=[(CONV_K - 1, 0)],
        dimension_numbers=("NWC", "WIO", "NWC"), feature_group_count=CONV_WIDTH)
    return b_gate * conv


def diff_attention(q, k, v, cos, sin, g_q, g_k, lq1, lk1, lq2, lk2, g_sub, lam_init):
    B, S, _ = q.shape
    q = q.reshape(B, S, DIFF_HEADS, 2, DIFF_HALF)
    k = k.reshape(B, S, DIFF_HEADS, 2, DIFF_HALF)
    vf = v.reshape(B, S, DIFF_HEADS, DIFF_VDIM).astype(jnp.float32)
    q = apply_partial_rope(rmsnorm(q, g_q), cos, sin)
    k = apply_partial_rope(rmsnorm(k, g_k), cos, sin)
    lam = (jnp.exp(jnp.sum(lq1.astype(jnp.float32) * lk1.astype(jnp.float32)))
           - jnp.exp(jnp.sum(lq2.astype(jnp.float32) * lk2.astype(jnp.float32)))
           + lam_init)
    scale = DIFF_HALF ** -0.5
    key_pos = jnp.arange(S)

    def one_block(i):
        start = i * Q_BLOCK
        qb = lax.dynamic_slice_in_dim(q, start, Q_BLOCK, axis=1)
        s = jnp.einsum('bqhmd,bkhmd->bhmqk', qb, k,
                       preferred_element_type=jnp.float32) * scale
        qpos = start + jnp.arange(Q_BLOCK)
        mask = qpos[:, None] >= key_pos[None, :]
        p = jax.nn.softmax(jnp.where(mask, s, -jnp.inf), axis=-1)
        a = p[:, :, 0] - lam * p[:, :, 1]
        return jnp.einsum('bhqk,bkhd->bqhd', a, vf)

    o = lax.map(one_block, jnp.arange(S // Q_BLOCK))
    o = jnp.transpose(o, (1, 0, 2, 3, 4)).reshape(B, S, DIFF_HEADS, DIFF_VDIM)
    o = rmsnorm(o, g_sub) * (1.0 - lam_init)
    return o.reshape(B, S, DIFF_WIDTH).astype(v.dtype)


def memory_cross_attention(q_m, kv_m, g_q, g_k):
    B, S, _ = q_m.shape
    q = rmsnorm(q_m.reshape(B, S, MEM_HEADS, MEM_HEAD_DIM), g_q)
    k, v = jnp.split(kv_m, 2, axis=-1)
    k = rmsnorm(k.reshape(B, MEM_LEN, MEM_HEADS, MEM_HEAD_DIM), g_k)
    v = v.reshape(B, MEM_LEN, MEM_HEADS, MEM_HEAD_DIM)
    s = jnp.einsum('bqhd,bmhd->bhqm', q, k,
                   preferred_element_type=jnp.float32) * (MEM_HEAD_DIM ** -0.5)
    p = jax.nn.softmax(s, axis=-1)
    o = jnp.einsum('bhqm,bmhd->bqhd', p, v.astype(jnp.float32))
    return o.reshape(B, S, MEM_WIDTH).astype(q_m.dtype)


def setup_inputs(seed: int = 0) -> dict:
    key = jax.random.key(seed)
    ks = jax.random.split(key, 26)
    f32 = jnp.float32
    L, D = DEPTH, D_MODEL

    def nrm(k, shape, scale):
        return jax.random.normal(k, shape, f32) * scale

    def gain(k, shape):
        return 1.0 + 0.05 * jax.random.normal(k, shape, f32)

    x = jax.random.normal(ks[0], (BATCH, SEQ, D), f32)
    mem = jax.random.normal(ks[1], (BATCH, MEM_LEN, D), f32)
    offsets = jax.random.randint(ks[2], (BATCH, 1), 0, 4096, dtype=jnp.int32)
    positions = offsets + jnp.arange(SEQ, dtype=jnp.int32)[None, :]
    return {
        "x": x,
        "mem": mem,
        "positions": positions,
        "g_mix": gain(ks[3], (L, D)),
        "g_mem": gain(ks[4], (L, D)),
        "w_in": nrm(ks[5], (L, D, IN_WIDTH), D ** -0.5),
        "conv_w": nrm(ks[6], (L, CONV_K, CONV_WIDTH), CONV_K ** -0.5),
        "g_conv_out": gain(ks[7], (L, CONV_WIDTH)),
        "g_dq": gain(ks[8], (L, DIFF_HALF)),
        "g_dk": gain(ks[9], (L, DIFF_HALF)),
        "lam_q1": nrm(ks[10], (L, DIFF_HALF), 0.1),
        "lam_k1": nrm(ks[11], (L, DIFF_HALF), 0.1),
        "lam_q2": nrm(ks[12], (L, DIFF_HALF), 0.1),
        "lam_k2": nrm(ks[13], (L, DIFF_HALF), 0.1),
        "g_sub": gain(ks[14], (L, DIFF_VDIM)),
        "w_mem_kv": nrm(ks[15], (L, D, 2 * MEM_WIDTH), D ** -0.5),
        "g_mq": gain(ks[16], (L, MEM_HEAD_DIM)),
        "g_mk": gain(ks[17], (L, MEM_HEAD_DIM)),
        "g_mem_out": gain(ks[18], (L, MEM_WIDTH)),
        "w_o": nrm(ks[19], (L, MIX_WIDTH, D), MIX_WIDTH ** -0.5),
        "g_ffn": gain(ks[20], (L, D)),
        "w_gate": nrm(ks[21], (L, D, FFN_HIDDEN), D ** -0.5),
        "w_up": nrm(ks[22], (L, D, FFN_HIDDEN), D ** -0.5),
        "w_down": nrm(ks[23], (L, FFN_HIDDEN, D), FFN_HIDDEN ** -0.5),
    }


def reference(x, mem, positions, g_mix, g_mem, w_in, conv_w, g_conv_out, g_dq, g_dk,
              lam_q1, lam_k1, lam_q2, lam_k2, g_sub, w_mem_kv, g_mq, g_mk, g_mem_out,
              w_o, g_ffn, w_gate, w_up, w_down):
    cos, sin = rope_tables(positions)
    split_idx = [int(i) for i in np.cumsum(IN_SPLITS)[:-1]]
    for l in range(DEPTH):
        h = rmsnorm(x, g_mix[l])
        proj = h @ w_in[l]
        u, c_gate, b_gate, q, k, v, q_m = jnp.split(proj, split_idx, axis=-1)

        y_conv = rmsnorm(short_gated_conv(u, c_gate, b_gate, conv_w[l]), g_conv_out[l])
        y_diff = diff_attention(q, k, v, cos, sin, g_dq[l], g_dk[l],
                                lam_q1[l], lam_k1[l], lam_q2[l], lam_k2[l],
                                g_sub[l], lambda_init(l + 1))
        kv_m = rmsnorm(mem, g_mem[l]) @ w_mem_kv[l]
        y_mem = rmsnorm(memory_cross_attention(q_m, kv_m, g_mq[l], g_mk[l]), g_mem_out[l])

        mixed = jnp.concatenate([y_conv, y_diff, y_mem], axis=-1)
        x = x + mixed @ w_o[l]

        hf = rmsnorm(x, g_ffn[l])
        x = x + (jax.nn.silu(hf @ w_gate[l]) * (hf @ w_up[l])) @ w_down[l]
    return x
```

```cpp
#include <hip/hip_runtime.h>
#include <hip/hip_cooperative_groups.h>
#include <cstdio>
#include <cstdint>
namespace cg = cooperative_groups;
#ifndef MK_MULTI
#define MK_MULTI 0
#endif
#ifndef PROBE_DUP
#define PROBE_DUP -1
#endif
#ifndef MK_FUSE_PREP
#define MK_FUSE_PREP 1
#endif
namespace pg8 {
#define PG8_LAS __attribute__((address_space(3)))
typedef unsigned short bf16_t;
typedef short bf16x8 __attribute__((ext_vector_type(8)));
typedef float f32x4 __attribute__((ext_vector_type(4)));
typedef unsigned u32x4 __attribute__((ext_vector_type(4)));
constexpr int BM = 256, BK = 64, HALF = 128, HTB = HALF * BK * 2  , STAGE_BYTES = 8 * HTB, NXCD = 8, WGM = 8;

__host__ __device__ __forceinline__ int lds_byte(int r, int c) { const int st = (r >> 4) * 2 + (c >> 5), rr = r & 15, cc = c & 31, ob = rr * 64 + cc * 2; return st * 1024 + (ob ^ (((ob >> 9) & 1) << 5)); }
__host__ __device__ __forceinline__ void stage_rc(int b, int& R, int& C) { const int st = b / 1024, sb = b % 1024, swz = sb ^ (((sb >> 9) & 1) << 5); R = (st >> 1) * 16 + swz / 64; C = (st & 1) * 32 + (swz % 64) / 2; }
__host__ __device__ __forceinline__ int perm32(int rho) { const int n = rho >> 4, i = rho & 15; return 8 * (i >> 2) + 4 * n + (i & 3); }

struct Unit { int pm, pn; };
struct Gemm { const bf16_t* A; const bf16_t* Bt; int M, N, K; };

struct StaticOrder {
    int nM, nN, nwg, G, c;
    __host__ __device__ void init(int M, int N, int G_, int c_) { nM = M / BM; nN = N / BM; nwg = nM * nN; G = G_; c = c_; }
    __host__ __device__ bool next(int i, Unit& u) const {
        const long L = (long)i * G + c; if (L >= nwg) return false;
        int wgid = (int)L; { const int q = nwg / NXCD, r = nwg % NXCD, xcd = wgid % NXCD, off = wgid / NXCD; wgid = (xcd < r ? xcd * (q + 1) : r * (q + 1) + (xcd - r) * q) + off; }
        const int nig = WGM * nN, gid = wgid / nig, fm = gid * WGM, gsz = (nM - fm) < WGM ? (nM - fm) : WGM;
        u.pm = fm + ((wgid % nig) % gsz); u.pn = (wgid % nig) / gsz; return true;
    }
    __device__ __forceinline__ void a_ready(const Unit&) const {}
    __device__ __forceinline__ void done(const Unit&) const {}
};
__device__ __forceinline__ unsigned cvt_pk_bf16(float lo, float hi) { unsigned r; asm volatile("v_cvt_pk_bf16_f32 %0, %1, %2" : "=v"(r) : "v"(lo), "v"(hi)); return r; }
typedef unsigned u32x2 __attribute__((ext_vector_type(2)));
template <bool FUSE> struct EpiProj {
    static constexpr bool PERM = true, AFTER_DRAIN = false; static constexpr int MID_T = -1;
    bf16_t* O; int ldc; const int* positions; const float* g_dq; const float* g_dk; float qscale, eps;
    __device__ __forceinline__ void operator()(const f32x4 (&acc)[2][2][4][2], const Unit& u, int wr, int wc, int fr, int fq) const {
        const int row0 = u.pm * BM + wr * 64 + fr, col0 = u.pn * BM + wc * 64 + 8 * fq;
        const bool qk = FUSE && u.pn >= 6 && u.pn < 14;
        if (!qk) {
#pragma unroll
            for (int ai = 0; ai < 2; ++ai)
#pragma unroll
                for (int m = 0; m < 4; ++m) { bf16_t* rowp = O + (size_t)(row0 + ai * HALF + m * 16) * ldc + col0;
#pragma unroll
                    for (int bj = 0; bj < 2; ++bj) { const f32x4 v0 = acc[ai][bj][m][0], v1 = acc[ai][bj][m][1];
                        u32x4 w; w.x = cvt_pk_bf16(v0[0], v0[1]); w.y = cvt_pk_bf16(v0[2], v0[3]); w.z = cvt_pk_bf16(v1[0], v1[1]); w.w = cvt_pk_bf16(v1[2], v1[3]);
                        *(u32x4*)(rowp + bj * 32) = w; } }
        } else {
            const bool isq = u.pn < 10, lo = fq < 2;
            const float* gb = isq ? g_dq : g_dk;
            const int d00 = lo ? 4 * fq : 8 * fq, d01 = lo ? 8 + 4 * fq : 8 * fq + 4;
            f32x4 gv[2][2];
            gv[0][0] = *(const f32x4*)(gb + d00); gv[0][1] = *(const f32x4*)(gb + d01);
            gv[1][0] = *(const f32x4*)(gb + 32 + 8 * fq); gv[1][1] = *(const f32x4*)(gb + 32 + 8 * fq + 4);
            const float sc = isq ? qscale : 1.0f;
            constexpr double I2PI = 0.15915494309189535;
            constexpr double IFR[8] = {1.0 * I2PI, 0.19392274474868576 * I2PI, 0.03760603093086393 * I2PI, 0.007292664737217109 * I2PI,
                                       0.001414213562373095 * I2PI, 0.0002742481756762073 * I2PI, 5.318295896944988e-05 * I2PI, 1.031338537721246e-05 * I2PI};
            const bool hi4 = (fq & 1) != 0;
            const double if0 = hi4 ? IFR[4] : IFR[0], if1 = hi4 ? IFR[5] : IFR[1], if2 = hi4 ? IFR[6] : IFR[2], if3 = hi4 ? IFR[7] : IFR[3];
            int posr[2][4]; float ssr[2][4];
#pragma unroll
            for (int ai = 0; ai < 2; ++ai)
#pragma unroll
                for (int m = 0; m < 4; ++m) { posr[ai][m] = positions[row0 + ai * HALF + m * 16]; float s = 0.f;
#pragma unroll
                    for (int bj = 0; bj < 2; ++bj)
#pragma unroll
                        for (int n = 0; n < 2; ++n) { const f32x4 x = acc[ai][bj][m][n]; s += (x[0] * x[0] + x[1] * x[1]) + (x[2] * x[2] + x[3] * x[3]); }
                    ssr[ai][m] = s; }
#pragma unroll
            for (int ai = 0; ai < 2; ++ai)
#pragma unroll
                for (int m = 0; m < 4; ++m) ssr[ai][m] += __shfl_xor(ssr[ai][m], 16);
#pragma unroll
            for (int ai = 0; ai < 2; ++ai)
#pragma unroll
                for (int m = 0; m < 4; ++m) ssr[ai][m] += __shfl_xor(ssr[ai][m], 32);
#pragma unroll
            for (int ai = 0; ai < 2; ++ai)
#pragma unroll
                for (int m = 0; m < 4; ++m) { bf16_t* rowp = O + (size_t)(row0 + ai * HALF + m * 16) * ldc + u.pn * BM + wc * 64;
                    const double pos = (double)posr[ai][m];
                    f32x4 cs, sn;
#define PG8_ROPE(i, IFJ) { double rev = pos * (IFJ); rev -= __builtin_rint(rev); const float frv = (float)rev; cs[i] = __builtin_amdgcn_cosf(frv); sn[i] = __builtin_amdgcn_sinf(frv); }
                    PG8_ROPE(0, if0) PG8_ROPE(1, if1) PG8_ROPE(2, if2) PG8_ROPE(3, if3)
#undef PG8_ROPE
                    const float r = 1.0f / sqrtf(ssr[ai][m] * (1.0f / 64.0f) + eps);
                    f32x4 t[2][2];
#pragma unroll
                    for (int bj = 0; bj < 2; ++bj)
#pragma unroll
                        for (int n = 0; n < 2; ++n) t[bj][n] = acc[ai][bj][m][n] * r * gv[bj][n];
                    if (lo) { const f32x4 a = t[0][0], b = t[0][1]; t[0][0] = a * cs - b * sn; t[0][1] = b * cs + a * sn; }
                    { const f32x4 v0 = t[0][0] * sc, v1 = t[0][1] * sc; u32x2 w0, w1; w0.x = cvt_pk_bf16(v0[0], v0[1]); w0.y = cvt_pk_bf16(v0[2], v0[3]); w1.x = cvt_pk_bf16(v1[0], v1[1]); w1.y = cvt_pk_bf16(v1[2], v1[3]);
                      *(u32x2*)(rowp + d00) = w0; *(u32x2*)(rowp + d01) = w1; }
                    { const f32x4 v0 = t[1][0] * sc, v1 = t[1][1] * sc; u32x4 w; w.x = cvt_pk_bf16(v0[0], v0[1]); w.y = cvt_pk_bf16(v0[2], v0[3]); w.z = cvt_pk_bf16(v1[0], v1[1]); w.w = cvt_pk_bf16(v1[2], v1[3]);
                      *(u32x4*)(rowp + 32 + 8 * fq) = w; } }
        }
    }
};
struct EpiStoreBf16 {
    static constexpr bool PERM = true, AFTER_DRAIN = false; static constexpr int MID_T = -1;
    bf16_t* O; int ldc;
    __device__ __forceinline__ void operator()(const f32x4 (&acc)[2][2][4][2], const Unit& u, int wr, int wc, int fr, int fq) const {
        const int row0 = u.pm * BM + wr * 64 + fr, col0 = u.pn * BM + wc * 32 + 8 * fq;
#pragma unroll
        for (int ai = 0; ai < 2; ++ai)
#pragma unroll
            for (int m = 0; m < 4; ++m) { bf16_t* rowp = O + (size_t)(row0 + ai * HALF + m * 16) * ldc + col0;
#pragma unroll
                for (int bj = 0; bj < 2; ++bj) { const f32x4 v0 = acc[ai][bj][m][0], v1 = acc[ai][bj][m][1];
                    u32x4 w; w.x = cvt_pk_bf16(v0[0], v0[1]); w.y = cvt_pk_bf16(v0[2], v0[3]); w.z = cvt_pk_bf16(v1[0], v1[1]); w.w = cvt_pk_bf16(v1[2], v1[3]);
                    *(u32x4*)(rowp + bj * HALF) = w; } }
    }
};
#define PG8_EPI_SB() __builtin_amdgcn_sched_barrier(0)
#define PG8_ROWB(g, mm) (bo + (unsigned)((((g) >> 1) * HALF + (2 * ((g) & 1) + (mm)) * 16) * ldc) * 4u)
#define PG8_LDRES(B, g) _Pragma("unroll") for (int mm = 0; mm < 2; ++mm) { const unsigned rb = PG8_ROWB(g, mm); \
            _Pragma("unroll") for (int bj = 0; bj < 2; ++bj) _Pragma("unroll") for (int n = 0; n < 2; ++n) B[mm][bj][n] = *(const f32x4*)((const char*)base + (rb + (unsigned)(bj * HALF + 4 * n) * 4u)); }
#define PG8_ADDRES(B, g) _Pragma("unroll") for (int mm = 0; mm < 2; ++mm) _Pragma("unroll") for (int bj = 0; bj < 2; ++bj) _Pragma("unroll") for (int n = 0; n < 2; ++n) acc[(g) >> 1][bj][2 * ((g) & 1) + mm][n] += B[mm][bj][n];
struct EpiResF32 {
    static constexpr bool PERM = true, AFTER_DRAIN = false; static constexpr int MID_T = -1;
    const float* base; float* out; int ldc;
    __device__ __forceinline__ void operator()(f32x4 (&acc)[2][2][4][2], const Unit& u, int wr, int wc, int fr, int fq) const {
        const int row0 = u.pm * BM + wr * 64 + fr, col0 = u.pn * BM + wc * 32 + 8 * fq; const unsigned bo = (unsigned)(row0 * ldc + col0) * 4u;
        f32x4 ba[2][2][2], bb[2][2][2];
#define PG8_STRES(g) _Pragma("unroll") for (int mm = 0; mm < 2; ++mm) { const unsigned rb = PG8_ROWB(g, mm); \
            _Pragma("unroll") for (int bj = 0; bj < 2; ++bj) _Pragma("unroll") for (int n = 0; n < 2; ++n) *(f32x4*)((char*)out + (rb + (unsigned)(bj * HALF + 4 * n) * 4u)) = acc[(g) >> 1][bj][2 * ((g) & 1) + mm][n]; }
        PG8_LDRES(ba, 0) PG8_LDRES(bb, 1) PG8_EPI_SB(); PG8_ADDRES(ba, 0) PG8_EPI_SB(); PG8_LDRES(ba, 2) PG8_EPI_SB(); PG8_ADDRES(bb, 1) PG8_EPI_SB();
        PG8_STRES(0) PG8_STRES(1) PG8_EPI_SB(); PG8_LDRES(bb, 3) PG8_EPI_SB(); PG8_ADDRES(ba, 2) PG8_STRES(2) PG8_EPI_SB(); PG8_ADDRES(bb, 3) PG8_STRES(3)
#undef PG8_STRES
    }
};
struct EpiResNorm {
    static constexpr bool PERM = true, AFTER_DRAIN = false; static constexpr int MID_T = -1;
    const float* base; int ldc; bf16_t* XG; float* rowss;
    __device__ __forceinline__ void operator()(f32x4 (&acc)[2][2][4][2], const Unit& u, int wr, int wc, int fr, int fq) const {
        const int row0 = u.pm * BM + wr * 64 + fr, col0 = u.pn * BM + wc * 32 + 8 * fq; const unsigned bo = (unsigned)(row0 * ldc + col0) * 4u;
        f32x4 ba[2][2][2], bb[2][2][2];
#define PG8_STNORM(g) _Pragma("unroll") for (int mm = 0; mm < 2; ++mm) { const int m = 2 * ((g) & 1) + mm, row = row0 + ((g) >> 1) * HALF + m * 16; const unsigned rb = PG8_ROWB(g, mm); float ss = 0.f; \
            _Pragma("unroll") for (int bj = 0; bj < 2; ++bj) { const unsigned p = rb + (unsigned)(bj * HALF) * 4u; const f32x4 v0 = acc[(g) >> 1][bj][m][0], v1 = acc[(g) >> 1][bj][m][1]; \
                ss += ((v0[0] * v0[0] + v0[1] * v0[1]) + (v0[2] * v0[2] + v0[3] * v0[3])) + ((v1[0] * v1[0] + v1[1] * v1[1]) + (v1[2] * v1[2] + v1[3] * v1[3])); \
                u32x4 w; w.x = cvt_pk_bf16(v0[0], v0[1]); w.y = cvt_pk_bf16(v0[2], v0[3]); w.z = cvt_pk_bf16(v1[0], v1[1]); w.w = cvt_pk_bf16(v1[2], v1[3]); \
                *(u32x4*)((char*)XG + (p >> 1)) = w; } \
            ss += __shfl_xor(ss, 16); ss += __shfl_xor(ss, 32); \
            if (fq == 0) unsafeAtomicAdd(rowss + row, ss); }
        PG8_LDRES(ba, 0) PG8_LDRES(bb, 1) PG8_EPI_SB(); PG8_ADDRES(ba, 0) PG8_EPI_SB(); PG8_LDRES(ba, 2) PG8_EPI_SB(); PG8_ADDRES(bb, 1) PG8_EPI_SB();
        PG8_STNORM(0) PG8_STNORM(1) PG8_EPI_SB(); PG8_LDRES(bb, 3) PG8_EPI_SB(); PG8_ADDRES(ba, 2) PG8_STNORM(2) PG8_EPI_SB(); PG8_ADDRES(bb, 3) PG8_STNORM(3)
#undef PG8_STNORM
    }
};
#undef PG8_LDRES
#undef PG8_ADDRES
#undef PG8_ROWB
struct EpiResNormMid {
    static constexpr bool PERM = true, AFTER_DRAIN = false; static constexpr int MID_T = 24;
    const float* base; int ldc; bf16_t* XG; float* rowss; const float* rowss2; float inv_n2, eps;
    __device__ __forceinline__ void load_scale(const Unit& u, int wr, int fr, float (&rs)[2][4]) const {
        const unsigned rb = (unsigned)(u.pm * BM + wr * 64 + fr) * 4u;
#pragma unroll
        for (int ai = 0; ai < 2; ++ai)
#pragma unroll
            for (int m = 0; m < 4; ++m) rs[ai][m] = sqrtf(*(const float*)((const char*)rowss2 + (rb + (unsigned)(ai * HALF + m * 16) * 4u)) * inv_n2 + eps);
#pragma unroll
        for (int ai = 0; ai < 2; ++ai)
#pragma unroll
            for (int m = 0; m < 4; ++m) asm volatile("" : "+v"(rs[ai][m]));
    }
    __device__ __forceinline__ void operator()(f32x4 (&acc)[2][2][4][2], const Unit& u, int wr, int wc, int fr, int fq) const {
        float rs[2][4]; load_scale(u, wr, fr, rs);
#pragma unroll
        for (int ai = 0; ai < 2; ++ai)
#pragma unroll
            for (int m = 0; m < 4; ++m) { const float r = 1.0f / rs[ai][m];
#pragma unroll
                for (int bj = 0; bj < 2; ++bj)
#pragma unroll
                    for (int n = 0; n < 2; ++n) acc[ai][bj][m][n] *= r; }
        EpiResNorm{base, ldc, XG, rowss}(acc, u, wr, wc, fr, fq);
    }
};
struct EpiResBf16 {
    static constexpr bool PERM = true, AFTER_DRAIN = false; static constexpr int MID_T = -1;
    const bf16_t* resid; float* out; int ldc;
    __device__ __forceinline__ void operator()(f32x4 (&acc)[2][2][4][2], const Unit& u, int wr, int wc, int fr, int fq) const {
        const int row0 = u.pm * BM + wr * 64 + fr, col0 = u.pn * BM + wc * 32 + 8 * fq; const unsigned bo = (unsigned)(row0 * ldc + col0) * 4u;
        u32x4 rb[2][4][2];
#pragma unroll
        for (int ai = 0; ai < 2; ++ai)
#pragma unroll
            for (int m = 0; m < 4; ++m)
#pragma unroll
                for (int bj = 0; bj < 2; ++bj) rb[ai][m][bj] = *(const u32x4*)((const char*)resid + ((bo + (unsigned)((ai * HALF + m * 16) * ldc + bj * HALF) * 4u) >> 1));
        PG8_EPI_SB();
#pragma unroll
        for (int ai = 0; ai < 2; ++ai)
#pragma unroll
            for (int m = 0; m < 4; ++m)
#pragma unroll
                for (int bj = 0; bj < 2; ++bj) { const unsigned p = bo + (unsigned)((ai * HALF + m * 16) * ldc + bj * HALF) * 4u; const u32x4 w = rb[ai][m][bj];
                    f32x4 r0, r1; r0[0] = __uint_as_float(w.x << 16); r0[1] = __uint_as_float(w.x & 0xffff0000u); r0[2] = __uint_as_float(w.y << 16); r0[3] = __uint_as_float(w.y & 0xffff0000u);
                    r1[0] = __uint_as_float(w.z << 16); r1[1] = __uint_as_float(w.z & 0xffff0000u); r1[2] = __uint_as_float(w.w << 16); r1[3] = __uint_as_float(w.w & 0xffff0000u);
                    *(f32x4*)((char*)out + p) = r0 + acc[ai][bj][m][0]; *(f32x4*)((char*)out + (p + 16u)) = r1 + acc[ai][bj][m][1]; }
    }
};
typedef float f32x2 __attribute__((ext_vector_type(2)));
__device__ __forceinline__ f32x2 swiglu_pk(f32x2 g, f32x2 u, float rl, float r2) {
    const f32x2 t = g * rl; f32x2 e; e.x = __builtin_amdgcn_exp2f(t.x); e.y = __builtin_amdgcn_exp2f(t.y);
    const f32x2 d = e + 1.0f; f32x2 q; q.x = __builtin_amdgcn_rcpf(d.x); q.y = __builtin_amdgcn_rcpf(d.y);
    return (g * u) * (q * r2);
}
struct EpiSwiGLU {
    static constexpr bool PERM = true, AFTER_DRAIN = false; static constexpr int MID_T = -1;
    bf16_t* O; int ldc; const float* rowss; float inv_n, eps;
    __device__ __forceinline__ void operator()(const f32x4 (&acc)[2][2][4][2], const Unit& u, int wr, int wc, int fr, int fq) const {
        const int row0 = u.pm * BM + wr * 64 + fr, col0 = u.pn * HALF + wc * 32 + 8 * fq;
        float rs[2][4];
#pragma unroll
        for (int ai = 0; ai < 2; ++ai)
#pragma unroll
            for (int m = 0; m < 4; ++m) rs[ai][m] = rowss[row0 + ai * HALF + m * 16];
#pragma unroll
        for (int ai = 0; ai < 2; ++ai)
#pragma unroll
            for (int m = 0; m < 4; ++m) { const int row = row0 + ai * HALF + m * 16; bf16_t* rowp = O + (size_t)row * ldc + col0;
                const float r = 1.0f / sqrtf(rs[ai][m] * inv_n + eps), rl = -1.4426950408889634f * r, r2 = r * r;
                const f32x4 g0 = acc[ai][0][m][0], g1 = acc[ai][0][m][1], u0 = acc[ai][1][m][0], u1 = acc[ai][1][m][1];
                const f32x2 a = swiglu_pk((f32x2){g0[0], g0[1]}, (f32x2){u0[0], u0[1]}, rl, r2), b = swiglu_pk((f32x2){g0[2], g0[3]}, (f32x2){u0[2], u0[3]}, rl, r2);
                const f32x2 c = swiglu_pk((f32x2){g1[0], g1[1]}, (f32x2){u1[0], u1[1]}, rl, r2), d = swiglu_pk((f32x2){g1[2], g1[3]}, (f32x2){u1[2], u1[3]}, rl, r2);
                u32x4 w; w.x = cvt_pk_bf16(a.x, a.y); w.y = cvt_pk_bf16(b.x, b.y); w.z = cvt_pk_bf16(c.x, c.y); w.w = cvt_pk_bf16(d.x, d.y);
                *(u32x4*)rowp = w; }
    }
};

template <class Epi, class Sched, bool ALIGN_EPI = false, bool SP2 = false>
__device__ __forceinline__ void gemm_phase(const int tid, PG8_LAS unsigned char* lds, const Gemm g, const Sched& S, const Epi& E) {
    const int wid = __builtin_amdgcn_readfirstlane(tid >> 6), lane = tid & 63, wr = wid >> 2, wc = wid & 3, fr = lane & 15, fq = lane >> 4;
    const int K = g.K, nt = K / BK;
    unsigned voffA[2], voffB[2];
#pragma unroll
    for (int i = 0; i < 2; ++i) { int R, C; stage_rc(tid * 16 + i * 8192, R, C); const int Rb = Epi::PERM ? ((R & ~31) + perm32(R & 31)) : R;
        voffA[i] = (unsigned)(R * K + C) * 2u; voffB[i] = (unsigned)(Rb * K + C) * 2u; }
    const size_t kstep = (size_t)(BK * 2);
    const size_t hstep = (size_t)HALF * K * 2;
    const size_t tstep = 2 * hstep;
    const unsigned ldsw = (unsigned)wid * 1024u;
    const int aoff = lds_byte(wr * 64 + fr, fq * 8), boff = lds_byte(wc * 32 + fr, fq * 8);
#define PG8_SA(b, h) (((b) * 2 + (h)) * HTB)
#define PG8_SB(b, h) ((4 + (b) * 2 + (h)) * HTB)
#define PG8_STAGE(bufoff, gbase, voff) do { _Pragma("unroll") for (int _i = 0; _i < 2; ++_i) \
        __builtin_amdgcn_global_load_lds((const unsigned*)((const char*)(gbase) + (voff)[_i]), (PG8_LAS unsigned*)(lds + (bufoff) + ldsw + _i * 8192), 16, 0, 0); } while (0)
#define PG8_LDA(dst, b, h) do { _Pragma("unroll") for (int m = 0; m < 4; ++m) _Pragma("unroll") for (int k = 0; k < 2; ++k) dst[m][k] = *(const PG8_LAS bf16x8*)(lds + PG8_SA(b, h) + aoff + m * 2048 + k * 1024); } while (0)
#define PG8_LDB(dst, b, h) do { _Pragma("unroll") for (int n = 0; n < 2; ++n) _Pragma("unroll") for (int k = 0; k < 2; ++k) dst[n][k] = *(const PG8_LAS bf16x8*)(lds + PG8_SB(b, h) + boff + n * 2048 + k * 1024); } while (0)
#define PG8_MMA(ai, bj, At, Bt) do { __builtin_amdgcn_s_setprio(1); _Pragma("unroll") for (int m = 0; m < 4; ++m) _Pragma("unroll") for (int n = 0; n < 2; ++n) _Pragma("unroll") for (int k = 0; k < 2; ++k) \
        acc[ai][bj][m][n] = __builtin_amdgcn_mfma_f32_16x16x32_bf16(Bt[n][k], At[m][k], acc[ai][bj][m][n], 0, 0, 0); __builtin_amdgcn_s_setprio(0); } while (0)
#define PG8_WAIT_V(n) asm volatile("s_waitcnt vmcnt(" #n ")" ::: "memory")
#define PG8_WAIT_L(n) asm volatile("s_waitcnt lgkmcnt(" #n ")" ::: "memory")
#define PG8_BAR __builtin_amdgcn_s_barrier()
#define PG8_SCHED __builtin_amdgcn_sched_barrier(0)
    Unit cur, nxt; int ui = 0;
    if (!S.next(0, cur)) return;
    f32x4 acc[2][2][4][2];
#pragma unroll
    for (int a = 0; a < 2; ++a)
#pragma unroll
        for (int b = 0; b < 2; ++b)
#pragma unroll
            for (int m = 0; m < 4; ++m)
#pragma unroll
                for (int n = 0; n < 2; ++n) acc[a][b][m][n] = (f32x4){0.f, 0.f, 0.f, 0.f};
    bf16x8 At[4][2], B0[2][2], B1[2][2];
    const char* cA = (const char*)g.A + (size_t)cur.pm * tstep; const char* cB = (const char*)g.Bt + (size_t)cur.pn * tstep;
    S.a_ready(cur);
    if constexpr (SP2) {
        PG8_STAGE(PG8_SB(0, 0), cB, voffB); PG8_STAGE(PG8_SB(0, 1), cB + hstep, voffB); PG8_STAGE(PG8_SA(0, 0), cA, voffA); PG8_STAGE(PG8_SA(0, 1), cA + hstep, voffA);
        if (wr == 1) PG8_BAR;
        PG8_WAIT_V(2); PG8_BAR;
        PG8_STAGE(PG8_SB(1, 0), cB + kstep, voffB); PG8_STAGE(PG8_SA(1, 0), cA + kstep, voffA); PG8_STAGE(PG8_SB(1, 1), cB + hstep + kstep, voffB);
        PG8_WAIT_V(6); PG8_BAR;
    } else {
        PG8_STAGE(PG8_SB(0, 0), cB, voffB); PG8_STAGE(PG8_SA(0, 0), cA, voffA); PG8_STAGE(PG8_SB(0, 1), cB + hstep, voffB); PG8_STAGE(PG8_SA(0, 1), cA + hstep, voffA);
        if (wr == 1) PG8_BAR;
        PG8_WAIT_V(4); PG8_BAR;
        PG8_STAGE(PG8_SB(1, 0), cB + kstep, voffB); PG8_STAGE(PG8_SA(1, 0), cA + kstep, voffA); PG8_STAGE(PG8_SB(1, 1), cB + hstep + kstep, voffB);
        PG8_WAIT_V(6); PG8_BAR;
    }
    for (;;) {
        const bool has_next = S.next(ui + 1, nxt);
        const char* nA = has_next ? (const char*)g.A + (size_t)nxt.pm * tstep : cA; const char* nB = has_next ? (const char*)g.Bt + (size_t)nxt.pn * tstep : cB;
        for (int t = 0; t < nt; t += 2) {
            const bool last = (t == nt - 2);
            if constexpr (Epi::MID_T >= 0) { if (t == Epi::MID_T) { float rs[2][4]; E.load_scale(cur, wr, fr, rs);
                _Pragma("unroll") for (int a_ = 0; a_ < 2; ++a_) _Pragma("unroll") for (int m_ = 0; m_ < 4; ++m_) _Pragma("unroll") for (int b_ = 0; b_ < 2; ++b_) _Pragma("unroll") for (int n_ = 0; n_ < 2; ++n_) acc[a_][b_][m_][n_] *= rs[a_][m_]; } }
            const char* a1 = cA + (size_t)(t + 1) * kstep;
            const char* a2 = last ? nA : cA + (size_t)(t + 2) * kstep; const char* b2 = last ? nB : cB + (size_t)(t + 2) * kstep;
            const char* a3 = a2 + kstep; const char* b3 = b2 + kstep;
            if (last && has_next) S.a_ready(nxt);
            if constexpr (SP2) {
            PG8_LDB(B0, 0, 0); PG8_LDB(B1, 0, 1); PG8_SCHED; PG8_LDA(At, 0, 0); PG8_STAGE(PG8_SA(1, 1), a1 + hstep, voffA);
            PG8_WAIT_V(8); PG8_WAIT_L(0); PG8_BAR; PG8_MMA(0, 0, At, B0); PG8_MMA(0, 1, At, B1); PG8_BAR; PG8_SCHED;
            PG8_LDA(At, 0, 1); PG8_STAGE(PG8_SB(0, 0), b2, voffB); PG8_STAGE(PG8_SB(0, 1), b2 + hstep, voffB); PG8_STAGE(PG8_SA(0, 0), a2, voffA);
            PG8_WAIT_V(8); PG8_WAIT_L(0); PG8_BAR; PG8_MMA(1, 0, At, B0); PG8_MMA(1, 1, At, B1); PG8_BAR; PG8_SCHED;
            PG8_LDB(B0, 1, 0); PG8_LDB(B1, 1, 1); PG8_SCHED; PG8_LDA(At, 1, 0); PG8_STAGE(PG8_SA(0, 1), a2 + hstep, voffA);
            PG8_WAIT_V(8); PG8_WAIT_L(0); PG8_BAR; PG8_MMA(0, 0, At, B0); PG8_MMA(0, 1, At, B1); PG8_BAR; PG8_SCHED;
            PG8_LDA(At, 1, 1); PG8_STAGE(PG8_SB(1, 0), b3, voffB); PG8_STAGE(PG8_SB(1, 1), b3 + hstep, voffB); PG8_STAGE(PG8_SA(1, 0), a3, voffA);
            PG8_WAIT_V(8); PG8_WAIT_L(0); PG8_BAR; PG8_MMA(1, 0, At, B0); PG8_MMA(1, 1, At, B1); PG8_BAR; PG8_SCHED;
            } else {
            PG8_LDB(B0, 0, 0); PG8_SCHED; PG8_LDA(At, 0, 0); PG8_STAGE(PG8_SA(1, 1), a1 + hstep, voffA);
            PG8_WAIT_L(8); PG8_BAR; PG8_WAIT_L(0); PG8_MMA(0, 0, At, B0); PG8_BAR; PG8_SCHED;
            PG8_LDB(B1, 0, 1); PG8_STAGE(PG8_SB(0, 0), b2, voffB);
            PG8_BAR; PG8_WAIT_L(0); PG8_MMA(0, 1, At, B1); PG8_BAR;
            PG8_LDA(At, 0, 1); PG8_STAGE(PG8_SA(0, 0), a2, voffA);
            PG8_BAR; PG8_WAIT_L(0); PG8_MMA(1, 0, At, B0); PG8_BAR; PG8_SCHED;
            PG8_STAGE(PG8_SB(0, 1), b2 + hstep, voffB);
            PG8_WAIT_V(6); PG8_BAR; PG8_MMA(1, 1, At, B1); PG8_BAR;
            PG8_LDB(B0, 1, 0); PG8_SCHED; PG8_LDA(At, 1, 0); PG8_STAGE(PG8_SA(0, 1), a2 + hstep, voffA);
            PG8_WAIT_L(8); PG8_BAR; PG8_WAIT_L(0); PG8_MMA(0, 0, At, B0); PG8_BAR; PG8_SCHED;
            PG8_LDB(B1, 1, 1); PG8_STAGE(PG8_SB(1, 0), b3, voffB);
            PG8_BAR; PG8_WAIT_L(0); PG8_MMA(0, 1, At, B1); PG8_BAR;
            PG8_LDA(At, 1, 1); PG8_STAGE(PG8_SA(1, 0), a3, voffA);
            PG8_BAR; PG8_WAIT_L(0); PG8_MMA(1, 0, At, B0); PG8_BAR; PG8_SCHED;
            PG8_STAGE(PG8_SB(1, 1), b3 + hstep, voffB);
            PG8_WAIT_V(6); PG8_BAR; PG8_MMA(1, 1, At, B1); PG8_BAR;
            }
        }
        if constexpr (ALIGN_EPI) { if (wr == 0) PG8_BAR; }
        if constexpr (!Epi::AFTER_DRAIN) { E(acc, cur, wr, wc, fr, fq); S.done(cur); }
        if (!has_next) break;
#pragma unroll
        for (int a = 0; a < 2; ++a)
#pragma unroll
            for (int b = 0; b < 2; ++b)
#pragma unroll
                for (int m = 0; m < 4; ++m)
#pragma unroll
                    for (int n = 0; n < 2; ++n) acc[a][b][m][n] = (f32x4){0.f, 0.f, 0.f, 0.f};
        cur = nxt; cA = nA; cB = nB; ++ui;
        if constexpr (ALIGN_EPI) { if (wr == 1) PG8_BAR; }
    }
    PG8_WAIT_V(0);
    if constexpr (!ALIGN_EPI) { if (wr == 0) PG8_BAR; }
    PG8_BAR;
    if constexpr (Epi::AFTER_DRAIN) { E.fused(acc, cur, wr, wc, fr, fq, lds, wid, lane); S.done(cur); }
#undef PG8_SA
#undef PG8_SB
#undef PG8_STAGE
#undef PG8_LDA
#undef PG8_LDB
#undef PG8_MMA
#undef PG8_WAIT_V
#undef PG8_WAIT_L
#undef PG8_BAR
#undef PG8_SCHED
}
}
#include <hip/hip_bf16.h>
#include <cmath>
namespace attn_body {
using bf16=__hip_bfloat16;
using bf16x8=__attribute__((ext_vector_type(8)))short;
using s16x4=__attribute__((ext_vector_type(4)))short;
using f32x16=__attribute__((ext_vector_type(16)))float;
using u32x4=__attribute__((ext_vector_type(4)))unsigned;
constexpr int SEQ=2048,D=64,PQKV=5120,PO=2048;
constexpr int NW=8,QBLK=32,QB=QBLK*NW,KVBLK=64,NQB=SEQ/QB;
__device__ __forceinline__ int crow(int r,int hi){return (r&3)+8*(r>>2)+4*hi;}
#define SBAR() __builtin_amdgcn_sched_barrier(0)
__device__ __forceinline__ void cmask(f32x16&p0,f32x16&p1,int jb,int qrel,int hi){
  const float NEG=-INFINITY; int kb=64*jb+4*hi;
  #pragma unroll
  for(int r=0;r<16;++r){int kv=kb+(r&3)+8*(r>>2); if(kv>qrel)p0[r]=NEG; if(kv+32>qrel)p1[r]=NEG;}
}

constexpr int NSLOT=3, SLOTB=8192;
constexpr int LDS_K=0, LDS_V=NSLOT*SLOTB, LDS_WS=2*NSLOT*SLOTB, LDS_OST=LDS_WS+NW*64*4, LDS_V2=LDS_OST+NW*4096, LDS_BYTES=LDS_V2+NSLOT*SLOTB;
constexpr float C2=0.125f*1.4426950408889634f;
__device__ __forceinline__ void glds16s(const void*sbase,unsigned voff,unsigned lds_dst){unsigned keep;
  asm volatile("s_mov_b32 %0, m0\n\ts_mov_b32 m0, %3\n\ts_nop 0\n\tglobal_load_lds_dwordx4 %1, %2\n\ts_mov_b32 m0, %0":"=&s"(keep):"v"(voff),"s"(sbase),"s"(lds_dst):"memory");}
__device__ __forceinline__ void glds16(const void*gsrc,unsigned lds_dst){unsigned keep;
  asm volatile("s_mov_b32 %0, m0\n\ts_mov_b32 m0, %2\n\ts_nop 0\n\tglobal_load_lds_dwordx4 %1, off\n\ts_mov_b32 m0, %0":"=&s"(keep):"v"(gsrc),"s"(lds_dst):"memory");}
__device__ __forceinline__ float max3f(float a,float b,float c){float r;asm("v_max3_f32 %0, %1, %2, %3":"=v"(r):"v"(a),"v"(b),"v"(c));return r;}
__device__ __forceinline__ float max2f(float a,float b){float r;asm("v_max_f32_e32 %0, %1, %2":"=v"(r):"v"(a),"v"(b));return r;}
__device__ __forceinline__ float fadd_s(float a,float b){float r;asm("v_add_f32_e32 %0, %1, %2":"=v"(r):"v"(a),"v"(b));return r;}
__device__ __forceinline__ float fsub_s(float a,float b){float r;asm("v_sub_f32_e32 %0, %1, %2":"=v"(r):"v"(a),"v"(b));return r;}
typedef float f32x2_t __attribute__((ext_vector_type(2))); typedef __bf16 bf16x2_t __attribute__((ext_vector_type(2)));
__device__ __forceinline__ unsigned cvtpk_s(float lo,float hi){f32x2_t v={lo,hi};bf16x2_t b=__builtin_convertvector(v,bf16x2_t);return __builtin_bit_cast(unsigned,b);}
#define WAIT_BAR(N) asm volatile("s_waitcnt vmcnt(" #N ") lgkmcnt(0)\n\ts_barrier":::"memory")

__device__ __forceinline__ void qkt(f32x16&p0,f32x16&p1,const char*Kslot,const bf16x8*qr,const f32x16&negm,int r32,int hi){
  const char*kb=Kslot+hi*1024+r32*16;
  #pragma unroll
  for(int d0=0;d0<4;++d0){
    const bf16x8 b0=*reinterpret_cast<const bf16x8*>(kb+d0*2048);
    const bf16x8 b1=*reinterpret_cast<const bf16x8*>(kb+d0*2048+512);
    if(d0==0){p0=__builtin_amdgcn_mfma_f32_32x32x16_bf16(b0,qr[0],negm,0,0,0);p1=__builtin_amdgcn_mfma_f32_32x32x16_bf16(b1,qr[0],negm,0,0,0);}
    else{p0=__builtin_amdgcn_mfma_f32_32x32x16_bf16(b0,qr[d0],p0,0,0,0);p1=__builtin_amdgcn_mfma_f32_32x32x16_bf16(b1,qr[d0],p1,0,0,0);}}
}
typedef __attribute__((address_space(3))) const char* lds_cptr;
typedef short v4i16_t __attribute__((ext_vector_type(4)));
__device__ __forceinline__ void kload8(bf16x8*kf,lds_cptr kp){
  kf[0]=*(const __attribute__((address_space(3))) bf16x8*)(kp);      kf[1]=*(const __attribute__((address_space(3))) bf16x8*)(kp+512);
  kf[2]=*(const __attribute__((address_space(3))) bf16x8*)(kp+2048); kf[3]=*(const __attribute__((address_space(3))) bf16x8*)(kp+2560);
  kf[4]=*(const __attribute__((address_space(3))) bf16x8*)(kp+4096); kf[5]=*(const __attribute__((address_space(3))) bf16x8*)(kp+4608);
  kf[6]=*(const __attribute__((address_space(3))) bf16x8*)(kp+6144); kf[7]=*(const __attribute__((address_space(3))) bf16x8*)(kp+6656);
}
__device__ __forceinline__ void kload2(bf16x8*kf,lds_cptr kp,int j){ kf[2*j]=*(const __attribute__((address_space(3))) bf16x8*)(kp+j*2048); kf[2*j+1]=*(const __attribute__((address_space(3))) bf16x8*)(kp+j*2048+512); }
__device__ __forceinline__ s16x4 vtr(lds_cptr p){ return __builtin_bit_cast(s16x4,__builtin_amdgcn_ds_read_tr16_b64_v4i16((__attribute__((address_space(3))) v4i16_t*)p)); }
__device__ __forceinline__ float rowmax(const f32x16&p0,const f32x16&p1){
  float a=max3f(p0[0],p0[1],p1[0]),b=max3f(p0[2],p0[3],p1[1]);a=max3f(a,p1[2],p1[3]);
  #pragma unroll
  for(int r=4;r<16;r+=4){a=max3f(a,p0[r],p0[r+1]);b=max3f(b,p0[r+2],p0[r+3]);a=max3f(a,p1[r],p1[r+1]);b=max3f(b,p1[r+2],p1[r+3]);}
  const float m=max2f(a,b);
  auto rr=__builtin_amdgcn_permlane32_swap(__float_as_uint(m),__float_as_uint(m),false,false);
  return max2f(__uint_as_float(rr[0]),__uint_as_float(rr[1]));
}
__device__ __forceinline__ void pv(f32x16*o,int vb,bf16x8 pa0,bf16x8 pa1,bf16x8 pa2,bf16x8 pa3){
  #pragma unroll
  for(int d0=0;d0<2;++d0){s16x4 lo[4],hi[4];
    #pragma unroll
    for(int ks=0;ks<4;++ks){
      asm volatile("ds_read_b64_tr_b16 %0,%1 offset:%c2":"=&v"(lo[ks]):"v"(vb),"i"(d0*4096+ks*1024):"memory");
      asm volatile("ds_read_b64_tr_b16 %0,%1 offset:%c2":"=&v"(hi[ks]):"v"(vb),"i"(d0*4096+ks*1024+512):"memory");}
    asm volatile("s_waitcnt lgkmcnt(0)":::"memory");SBAR();
    #define PK(k) (bf16x8){lo[k][0],lo[k][1],lo[k][2],lo[k][3],hi[k][0],hi[k][1],hi[k][2],hi[k][3]}
    o[d0]=__builtin_amdgcn_mfma_f32_32x32x16_bf16(pa0,PK(0),o[d0],0,0,0);
    o[d0]=__builtin_amdgcn_mfma_f32_32x32x16_bf16(pa1,PK(1),o[d0],0,0,0);
    o[d0]=__builtin_amdgcn_mfma_f32_32x32x16_bf16(pa2,PK(2),o[d0],0,0,0);
    o[d0]=__builtin_amdgcn_mfma_f32_32x32x16_bf16(pa3,PK(3),o[d0],0,0,0);
    #undef PK
  }
}

#ifndef ATTN_STORE16
#define ATTN_STORE16(p,v) (*(u32x4*)(p)=(v))
#endif
typedef float f32x8a __attribute__((ext_vector_type(8))); typedef float f32x4a __attribute__((ext_vector_type(4)));
__device__ __forceinline__ f32x8a unpk8(u32x4 w){ f32x8a t; t[0]=__uint_as_float(w.x<<16); t[1]=__uint_as_float(w.x&0xffff0000u); t[2]=__uint_as_float(w.y<<16); t[3]=__uint_as_float(w.y&0xffff0000u);
  t[4]=__uint_as_float(w.z<<16); t[5]=__uint_as_float(w.z&0xffff0000u); t[6]=__uint_as_float(w.w<<16); t[7]=__uint_as_float(w.w&0xffff0000u); return t; }
template<int THRL,int MODE> __device__ __forceinline__ void attn_unit(int tid,int qb,const bf16*__restrict__ Qb,const bf16*__restrict__ Kh,const bf16*__restrict__ Vh,bf16*Ob,char*shm,const bf16*Ob0,float lam,const float*gsub,float dscale){
  const int lane=tid&63,r32=lane&31,hi=lane>>5; const int wid=__builtin_amdgcn_readfirstlane(tid>>6);
  const int q0=qb*QB;
  const bf16*Qw=Qb+(long)(q0+wid*QBLK)*PQKV;
  const unsigned lds0=(unsigned)(uintptr_t)shm;
  float*wsf=(float*)(shm+LDS_WS)+wid*64;
  const unsigned koff=(unsigned)(lane*PQKV+wid*8)*2u;
  const unsigned voff=(unsigned)((16*(wid&3)+(lane>>2))*PQKV+(wid>>2)*32+(lane&3)*8)*2u;
  const unsigned kdst=lds0+LDS_K+wid*1024, vdst=lds0+LDS_V+wid*1024, vdst2=lds0+LDS_V2+wid*1024;
  #define DMA_K(t,slot) glds16s(Kh+(long)(t)*KVBLK*PQKV,koff,(unsigned)__builtin_amdgcn_readfirstlane(kdst+(slot)))
  #define DMA_V(t,slot) do{ glds16s(Vh+(long)(t)*KVBLK*PQKV,voff,(unsigned)__builtin_amdgcn_readfirstlane(vdst+(slot))); glds16s(Vh+64+(long)(t)*KVBLK*PQKV,voff,(unsigned)__builtin_amdgcn_readfirstlane(vdst2+(slot))); }while(0)
  const int vb0=(int)(lds0+LDS_V)+((lane>>4)&1)*32+(lane&3)*8+(4*hi+((lane&15)>>2))*64;
  const char*Kbase=shm+LDS_K; bf16x8 kf[8];
  const lds_cptr shm3=(lds_cptr)shm; const lds_cptr kp0=shm3+LDS_K+hi*1024+r32*16; const lds_cptr vp0=shm3+LDS_V+((lane>>4)&1)*32+(lane&3)*8+(4*hi+((lane&15)>>2))*64;
  const int NT=(q0+QB)/KVBLK;
  DMA_K(0,0);DMA_V(0,0);DMA_K(1,SLOTB);
  bf16x8 qr[4];
  #pragma unroll
  for(int d0=0;d0<4;++d0)qr[d0]=*reinterpret_cast<const bf16x8*>(&Qw[(long)r32*PQKV+d0*16+hi*8]);
  float mhat=0.f,l_reg=0.f;float zz_=0.f;asm volatile("":"+v"(zz_));f32x16 o[4];f32x16 negm;
  _Pragma("unroll") for(int r=0;r<16;++r){o[0][r]=zz_;o[1][r]=zz_;o[2][r]=zz_;o[3][r]=zz_;negm[r]=zz_;} asm volatile("":"+v"(negm));
  const int qrel=wid*QBLK+r32;
  #define CMASK(P0,P1,t) do{int jb_=(t)-(NT-4); if(jb_>=0)cmask(P0,P1,jb_,qrel,hi);}while(0)
  bool resc=false;
  #define START(P0,P1) do{ const float rm=rowmax(P0,P1); resc=false; \
    { const float dl=rm; mhat=fadd_s(mhat,dl); \
      _Pragma("unroll") for(int r=0;r<16;++r){P0[r]=fsub_s(P0[r],dl);P1[r]=fsub_s(P1[r],dl);} \
      _Pragma("unroll") for(int r=0;r<16;++r)negm[r]=-mhat; asm volatile("":"+v"(negm)); } \
    _Pragma("unroll") for(int r=0;r<16;++r)P0[r]=__builtin_amdgcn_exp2f(P0[r]); }while(0)
  #define RESC() do{ if(resc){ asm volatile("s_waitcnt lgkmcnt(0)":::"memory"); \
      _Pragma("unroll") for(int d_=0;d_<4;++d_) _Pragma("unroll") for(int r=0;r<16;++r)o[d_][r]*=wsf[crow(r,hi)]; } }while(0)
  f32x16 pA0,pA1,pB0,pB1;
  int sl_prev=0,sl_cur=0,sl_next=SLOTB;
  #define ROT() do{sl_prev=sl_cur;sl_cur=sl_next;sl_next=(sl_next==(NSLOT-1)*SLOTB)?0:sl_next+SLOTB;}while(0)
  DMA_K(2,2*SLOTB);
  WAIT_BAR(4);
  qkt(pA0,pA1,Kbase,qr,negm,r32,hi);asm volatile("s_nop 15\n\ts_nop 7":"+v"(pA0),"+v"(pA1));CMASK(pA0,pA1,0);
  START(pA0,pA1);
  _Pragma("unroll") for(int r=0;r<16;++r)pA1[r]=__builtin_amdgcn_exp2f(pA1[r]);
  WAIT_BAR(0);
  DMA_K(3,0);DMA_V(1,SLOTB);
  ROT();
  kload8(kf,kp0+sl_cur);
  WAIT_BAR(3);
  s16x4 vlo[8],vhi[8]; u32x4 pw0,pw1,pw2,pw3;
  #define PKW(P,B) cvtpk_s(P[B],P[B+1])
  #define PAF(k) __builtin_bit_cast(bf16x8,pw##k)
  #define VFR(i) (bf16x8){vlo[i][0],vlo[i][1],vlo[i][2],vlo[i][3],vhi[i][0],vhi[i][1],vhi[i][2],vhi[i][3]}
  #define PIN(x) asm volatile("":"+v"(x))
  #define MX3(a,b,c) __builtin_fmaxf(__builtin_fmaxf((a),(b)),(c))
  #define GAPA(MF,A0,A1,A2,A3,W0,W1,PW) do{ MF; sacc+=A0; sacc+=A1; sacc+=A2; sacc+=A3; PIN(sacc); W0; W1; PIN(PW); SBAR(); }while(0)
  #define EX(v) __builtin_amdgcn_exp2f(v)
  #define GAPB(MF,X,B) do{ MF; X[B]=EX(X[B]); X[B+1]=EX(X[B+1]); X[B+2]=EX(X[B+2]); X[B+3]=EX(X[B+3]); PIN(X); SBAR(); }while(0)
  #define VRD(i) do{ vlo[i]=vtr(vp_+(((i)>>2)*4096+((i)&3)*1024)); vhi[i]=vtr(vp_+(((i)>>2)*4096+((i)&3)*1024+512)); }while(0)
  #define KRD(G,j) do{ if(G){ kload2(kf,kp0+sl_next,j); SBAR(); } }while(0)
  #define STEP(C0,C1,P0,P1,t,GK,GV,GL) do{ SBAR(); \
    const lds_cptr vp_=vp0+sl_prev; \
    VRD(0); SBAR(); float sacc=(P0[0]+P0[1]); \
    GAPA(C0=__builtin_amdgcn_mfma_f32_32x32x16_bf16(kf[0],qr[0],negm,0,0,0), P0[2],P0[3],P0[4],P0[5],     pw0[0]=PKW(P0,0), pw0[1]=PKW(P0,2), pw0); \
    VRD(4); SBAR(); GAPA(C1=__builtin_amdgcn_mfma_f32_32x32x16_bf16(kf[1],qr[0],negm,0,0,0), P0[6],P0[7],P0[8],P0[9],     pw0[2]=PKW(P0,4), pw0[3]=PKW(P0,6), pw0); \
    VRD(1); SBAR(); GAPA(C0=__builtin_amdgcn_mfma_f32_32x32x16_bf16(kf[2],qr[1],C0,0,0,0),   P0[10],P0[11],P0[12],P0[13], pw1[0]=PKW(P0,8), pw1[1]=PKW(P0,10), pw1); \
    VRD(5); SBAR(); GAPA(C1=__builtin_amdgcn_mfma_f32_32x32x16_bf16(kf[3],qr[1],C1,0,0,0),   P0[14],P0[15],P1[0],P1[1],   pw1[2]=PKW(P0,12),pw1[3]=PKW(P0,14), pw1); \
    VRD(2); SBAR(); GAPA(C0=__builtin_amdgcn_mfma_f32_32x32x16_bf16(kf[4],qr[2],C0,0,0,0),   P1[2],P1[3],P1[4],P1[5],     pw2[0]=PKW(P1,0), pw2[1]=PKW(P1,2), pw2); \
    VRD(6); SBAR(); GAPA(C1=__builtin_amdgcn_mfma_f32_32x32x16_bf16(kf[5],qr[2],C1,0,0,0),   P1[6],P1[7],P1[8],P1[9],     pw2[2]=PKW(P1,4), pw2[3]=PKW(P1,6), pw2); \
    VRD(3); SBAR(); GAPA(C0=__builtin_amdgcn_mfma_f32_32x32x16_bf16(kf[6],qr[3],C0,0,0,0),   P1[10],P1[11],P1[12],P1[13], pw3[0]=PKW(P1,8), pw3[1]=PKW(P1,10), pw3); \
    VRD(7); SBAR(); GAPA(C1=__builtin_amdgcn_mfma_f32_32x32x16_bf16(kf[7],qr[3],C1,0,0,0),   P1[14],P1[15],0.f,0.f,       pw3[2]=PKW(P1,12),pw3[3]=PKW(P1,14), pw3); \
    l_reg+=sacc; \
    if(GK){DMA_K((t)+3,sl_cur);} if(GV){DMA_V((t)+1,sl_next);} \
    CMASK(C0,C1,t); \
    { float a=MX3(C0[0],C0[1],C1[0]),b=MX3(C0[2],C0[3],C1[1]); a=MX3(a,C1[2],C1[3]); \
      _Pragma("unroll") for(int r=4;r<16;r+=4){a=MX3(a,C0[r],C0[r+1]);b=MX3(b,C0[r+2],C0[r+3]);a=MX3(a,C1[r],C1[r+1]);b=MX3(b,C1[r+2],C1[r+3]);} \
      float rm=__builtin_fmaxf(a,b); { auto rr=__builtin_amdgcn_permlane32_swap(__float_as_uint(rm),__float_as_uint(rm),false,false); rm=__builtin_fmaxf(__uint_as_float(rr[0]),__uint_as_float(rr[1])); } \
      resc=false; \
      if(__builtin_expect(__any(rm>(float)THRL),0)){ const float dl=__builtin_fmaxf(rm,0.f); mhat+=dl; \
        _Pragma("unroll") for(int r=0;r<16;++r){C0[r]-=dl;C1[r]-=dl;} \
        _Pragma("unroll") for(int r=0;r<16;++r)negm[r]=-mhat; asm volatile("":"+v"(negm)); \
        const float f=__builtin_amdgcn_exp2f(-dl); l_reg*=f; if(hi==0)wsf[r32]=f; resc=true; } } \
    SBAR(); \
    GAPB(o[0]=__builtin_amdgcn_mfma_f32_32x32x16_bf16(PAF(0),VFR(0),o[0],0,0,0), C0,0); \
    GAPB(o[1]=__builtin_amdgcn_mfma_f32_32x32x16_bf16(PAF(0),VFR(4),o[1],0,0,0), C0,4); \
    KRD(GL,0); GAPB(o[0]=__builtin_amdgcn_mfma_f32_32x32x16_bf16(PAF(1),VFR(1),o[0],0,0,0), C0,8); \
    KRD(GL,1); GAPB(o[1]=__builtin_amdgcn_mfma_f32_32x32x16_bf16(PAF(1),VFR(5),o[1],0,0,0), C0,12); \
    KRD(GL,2); GAPB(o[0]=__builtin_amdgcn_mfma_f32_32x32x16_bf16(PAF(2),VFR(2),o[0],0,0,0), C1,0); \
    KRD(GL,3); GAPB(o[1]=__builtin_amdgcn_mfma_f32_32x32x16_bf16(PAF(2),VFR(6),o[1],0,0,0), C1,4); \
    GAPB(o[0]=__builtin_amdgcn_mfma_f32_32x32x16_bf16(PAF(3),VFR(3),o[0],0,0,0), C1,8); \
    GAPB(o[1]=__builtin_amdgcn_mfma_f32_32x32x16_bf16(PAF(3),VFR(7),o[1],0,0,0), C1,12); \
    pv(o+2,vb0+(LDS_V2-LDS_V)+sl_prev,PAF(0),PAF(1),PAF(2),PAF(3));   \
    }while(0)
  int t=1;
  #undef CMASK
  #define CMASK(P0,P1,t) do{}while(0)
  for(;t+5<NT;t+=2){
    STEP(pB0,pB1,pA0,pA1,t,true,true,true);     WAIT_BAR(3); RESC(); ROT();
    STEP(pA0,pA1,pB0,pB1,t+1,true,true,true);   WAIT_BAR(3); RESC(); ROT();
  }
  #undef CMASK
  #define CMASK(P0,P1,t) do{int jb_=(t)-(NT-4); if(jb_>=0)cmask(P0,P1,jb_,qrel,hi);}while(0)
  #define ENDW(tt) do{ if((tt)+3<NT){WAIT_BAR(3);} else if((tt)+2<NT){WAIT_BAR(2);} else {WAIT_BAR(0);} }while(0)
  for(;t+1<NT;t+=2){
    STEP(pB0,pB1,pA0,pA1,t,(t+3<NT),(t+1<NT),(t+1<NT));       ENDW(t);   RESC(); ROT();
    STEP(pA0,pA1,pB0,pB1,t+1,(t+4<NT),(t+2<NT),(t+2<NT));     ENDW(t+1); RESC(); ROT();
  }
  STEP(pB0,pB1,pA0,pA1,NT-1,false,false,false); RESC();
  { float sacc=pB0[0]+pB0[1]; _Pragma("unroll") for(int r=2;r<16;++r)sacc+=pB0[r]; _Pragma("unroll") for(int r=0;r<16;++r)sacc+=pB1[r]; l_reg+=sacc;
    pw0=(u32x4){PKW(pB0,0),PKW(pB0,2),PKW(pB0,4),PKW(pB0,6)};pw1=(u32x4){PKW(pB0,8),PKW(pB0,10),PKW(pB0,12),PKW(pB0,14)};pw2=(u32x4){PKW(pB1,0),PKW(pB1,2),PKW(pB1,4),PKW(pB1,6)};pw3=(u32x4){PKW(pB1,8),PKW(pB1,10),PKW(pB1,12),PKW(pB1,14)};
    SBAR(); pv(o,vb0+sl_cur,PAF(0),PAF(1),PAF(2),PAF(3)); pv(o+2,vb0+(LDS_V2-LDS_V)+sl_cur,PAF(0),PAF(1),PAF(2),PAF(3)); }
  #undef PKW
  #undef PAF
  #undef VFR
  #undef PIN
  #undef MX3
  #undef GAPA
  #undef GAPB
  #undef EX
  #undef VRD
  #undef KRD
  #undef STEP
  #undef ENDW
  {auto rr=__builtin_amdgcn_permlane32_swap(__float_as_uint(l_reg),__float_as_uint(l_reg),false,false);l_reg=__uint_as_float(rr[0])+__uint_as_float(rr[1]);}
  if(hi==0)wsf[32+r32]=l_reg;asm volatile("s_waitcnt lgkmcnt(0)":::"memory");
  float rli[16];
  #pragma unroll
  for(int r=0;r<16;++r)rli[r]=__builtin_amdgcn_rcpf(wsf[32+crow(r,hi)]);
  bf16*Ow=Ob+(long)(q0+wid*QBLK)*PO;
  { bf16*stg=(bf16*)(shm+LDS_OST)+wid*2048;
    f32x8a dd[2][4];
    #pragma unroll
    for(int ph=0;ph<2;++ph){
      #pragma unroll
      for(int r=0;r<16;++r){const int orow=crow(r,hi);
        #pragma unroll
        for(int d0=0;d0<2;++d0)stg[orow*64+d0*32+r32]=__float2bfloat16(o[2*ph+d0][r]*rli[r]);}
      asm volatile("s_waitcnt lgkmcnt(0)":::"memory");
      #pragma unroll
      for(int i=0;i<4;++i){const int row=i*8+(lane>>3),ch=lane&7; const u32x4 v=*(const u32x4*)(stg+row*64+ch*8);
        if constexpr(MODE==0){ ATTN_STORE16(Ow+(long)row*PO+ph*64+ch*8,v); }
        else { const u32x4 w0=__builtin_nontemporal_load((const u32x4*)(Ob0+(long)(q0+wid*QBLK+row)*PO+ph*64+ch*8)); dd[ph][i]=unpk8(w0)-unpk8(v)*lam; } }
      asm volatile("s_waitcnt lgkmcnt(0)":::"memory"); }
    if constexpr(MODE==1){
      #pragma unroll
      for(int i=0;i<4;++i){const int row=i*8+(lane>>3),ch=lane&7; float ss=0.f;
        #pragma unroll
        for(int ph=0;ph<2;++ph){ _Pragma("unroll") for(int k=0;k<8;++k)ss+=dd[ph][i][k]*dd[ph][i][k]; }
        ss+=__shfl_xor(ss,1);ss+=__shfl_xor(ss,2);ss+=__shfl_xor(ss,4);
        const float rr=dscale/sqrtf(ss*(1.f/128.f)+1e-6f);
        #pragma unroll
        for(int ph=0;ph<2;++ph){ const float*gp=gsub+ph*64+ch*8; const f32x4a ga=*(const f32x4a*)gp, gb=*(const f32x4a*)(gp+4);
          const f32x8a d=dd[ph][i]*rr; u32x4 w; w.x=cvtpk_s(d[0]*ga[0],d[1]*ga[1]); w.y=cvtpk_s(d[2]*ga[2],d[3]*ga[3]); w.z=cvtpk_s(d[4]*gb[0],d[5]*gb[1]); w.w=cvtpk_s(d[6]*gb[2],d[7]*gb[3]);
          ATTN_STORE16(Ow+(long)row*PO+ph*64+ch*8,w); } } } }
  asm volatile("s_waitcnt lgkmcnt(0)\n\ts_barrier":::"memory");
  #undef DMA_K
  #undef DMA_V
  #undef CMASK
  #undef START
  #undef RESC
  #undef ROT
}
#undef SBAR
#undef WAIT_BAR
}
#define GAS __attribute__((address_space(1)))
#define LAS __attribute__((address_space(3)))
typedef unsigned short bfu;
typedef unsigned v4u __attribute__((ext_vector_type(4)));
typedef unsigned v2u __attribute__((ext_vector_type(2)));
typedef float f32x4 __attribute__((ext_vector_type(4)));
typedef float f32x8 __attribute__((ext_vector_type(8)));
typedef float f32x16 __attribute__((ext_vector_type(16)));
typedef short bf16x8 __attribute__((ext_vector_type(8)));
typedef short s16x4 __attribute__((ext_vector_type(4)));

constexpr int NWAVES = 8;
constexpr int NB = 8, SEQL = 2048, DMODEL = 2048, MTOK = NB * SEQL, MEML = 256, MROWS = NB * MEML;
constexpr int NIN = 5120, NKV = 1024, FFH = 5632, NGU = 2 * FFH;
constexpr int C_U = 0, C_C = 512, C_B = 1024, C_Q = 1536, C_K = 2560, C_V = 3584, C_QM = 4608;
constexpr float EPS = 1e-6f;
constexpr float LOG2E = 1.4426950408889634f;
constexpr float C2Q = 0.125f * LOG2E;
constexpr float C2M = 0.08838834764831845f * LOG2E;
constexpr float LAM_INIT = 0.2f;

constexpr size_t MiB = 1u << 20;
constexpr size_t WS_BAR = 0, BAR_ZERO_BYTES = 16384;
constexpr size_t WS_ROWSS2 = 65536 + 262144;
constexpr size_t WS_ROWSS = 65536;
constexpr size_t WS_WIN = 2 * MiB, WS_WKV = 22 * MiB, WS_WO = 26 * MiB, WS_WGU = 34 * MiB, WS_WD = 78 * MiB;
constexpr size_t WS_HB = 100 * MiB, WS_MEMN = 164 * MiB, WS_KVM = 172 * MiB, WS_VMT = 176 * MiB;
constexpr size_t WS_PROJ = 178 * MiB, WS_ODIFF = 338 * MiB, WS_MIXED = 402 * MiB, WS_OMEM = 466 * MiB, WS_END = 482 * MiB;
constexpr size_t WS_ACT = WS_PROJ;
static_assert(WS_ACT + (size_t)MTOK * FFH * 2 <= WS_MIXED, "act overlay");

constexpr int LDS_BARST = 147456 - 64;
constexpr int LDS_BYTES = 147456;

#define LDS_WAIT() asm volatile("s_waitcnt lgkmcnt(0)" ::: "memory")
__device__ __forceinline__ unsigned f2bf(float f) { unsigned u = __builtin_bit_cast(unsigned, f); return (u + 0x7fffu + ((u >> 16) & 1u)) >> 16; }
__device__ __forceinline__ unsigned pk2(float lo, float hi) { return f2bf(lo) | (f2bf(hi) << 16); }
__device__ __forceinline__ float bf_lo(unsigned w) { return __builtin_bit_cast(float, w << 16); }
__device__ __forceinline__ float bf_hi(unsigned w) { return __builtin_bit_cast(float, w & 0xffff0000u); }
__device__ __forceinline__ f32x8 unpack8(v4u w) { f32x8 t; t[0] = bf_lo(w.x); t[1] = bf_hi(w.x); t[2] = bf_lo(w.y); t[3] = bf_hi(w.y); t[4] = bf_lo(w.z); t[5] = bf_hi(w.z); t[6] = bf_lo(w.w); t[7] = bf_hi(w.w); return t; }
__device__ __forceinline__ v4u pack8(f32x8 t) { v4u w; w.x = pk2(t[0], t[1]); w.y = pk2(t[2], t[3]); w.z = pk2(t[4], t[5]); w.w = pk2(t[6], t[7]); return w; }
__device__ __forceinline__ f32x8 ld8f(const float* p) { const f32x4 a = *(const f32x4*)p, b = *(const f32x4*)(p + 4); f32x8 t; t[0] = a.x; t[1] = a.y; t[2] = a.z; t[3] = a.w; t[4] = b.x; t[5] = b.y; t[6] = b.z; t[7] = b.w; return t; }
__device__ __forceinline__ float sumsq8(f32x8 t) { return ((t[0] * t[0] + t[1] * t[1]) + (t[2] * t[2] + t[3] * t[3])) + ((t[4] * t[4] + t[5] * t[5]) + (t[6] * t[6] + t[7] * t[7])); }
__device__ __forceinline__ float wave_sum(float v) {
#pragma unroll
    for (int o = 1; o < 64; o <<= 1) v += __shfl_xor(v, o);
    return v;
}
__device__ __forceinline__ float rsq(float v) { return 1.0f / sqrtf(v); }

__device__ __forceinline__ void p0_transpose_item(const float* W, int K, int N, bfu* WT, int mode, const float* gk, LAS float* scr, int item, int lane) {
    const int nblk = N / 32, kb = item / nblk, nb = item % nblk, k0 = 64 * kb, n0 = 32 * nb;
    const int r0 = (mode == 0) ? n0 : (mode == 3) ? (256 * (n0 >> 8) + 128 * ((n0 >> 5) & 1) + 32 * ((n0 >> 6) & 3)) : (256 * (n0 >> 7) + (mode == 2 ? 128 : 0) + (n0 & 127));
#pragma unroll 8
    for (int i = 0; i < 32; ++i) { const int kk = 2 * i + (lane >> 5); scr[kk * 33 + (lane & 31)] = W[(size_t)(k0 + kk) * N + n0 + (lane & 31)]; }
    LDS_WAIT(); asm volatile("" ::: "memory");
    const int c = lane & 7;
    f32x8 gg; if (gk) gg = ld8f(gk + k0 + 8 * c); else { _Pragma("unroll") for (int i = 0; i < 8; ++i) gg[i] = 1.0f; }
    const bool pairperm = MK_FUSE_PREP && mode == 3 && n0 >= C_Q && n0 < C_V && ((n0 >> 5) & 1) == 0;
#pragma unroll
    for (int j = 0; j < 4; ++j) { const int n = (lane >> 3) + 8 * j; const LAS float* s = scr + (8 * c) * 33 + n;
        v4u o; o.x = pk2(s[0 * 33] * gg[0], s[1 * 33] * gg[1]); o.y = pk2(s[2 * 33] * gg[2], s[3 * 33] * gg[3]); o.z = pk2(s[4 * 33] * gg[4], s[5 * 33] * gg[5]); o.w = pk2(s[6 * 33] * gg[6], s[7 * 33] * gg[7]);
        const int nd = (pairperm && n < 16) ? (8 * ((n >> 2) & 1) + 4 * (n >> 3) + (n & 3)) : n;
        *(v4u*)(WT + (size_t)(r0 + nd) * K + k0 + 8 * c) = o; }
    LDS_WAIT(); asm volatile("" ::: "memory");
}
__device__ __forceinline__ void rms_row_to_bf16(const float* xrow, const float* g, bfu* orow, int lane) {
    const f32x4* xr = (const f32x4*)xrow + lane; const f32x4* gr = (const f32x4*)g + lane;
    f32x4 v[8]; float s = 0.f;
#pragma unroll
    for (int j = 0; j < 8; ++j) { v[j] = xr[64 * j]; s += (v[j].x * v[j].x + v[j].y * v[j].y) + (v[j].z * v[j].z + v[j].w * v[j].w); }
    const float r = rsq(wave_sum(s) * (1.f / DMODEL) + EPS);
    unsigned long long* o8 = (unsigned long long*)orow + lane;
#pragma unroll
    for (int j = 0; j < 8; ++j) { const f32x4 gg = gr[64 * j]; const f32x4 o = v[j] * r * gg;
        o8[64 * j] = (unsigned long long)pk2(o.x, o.y) | ((unsigned long long)pk2(o.z, o.w) << 32); }
}

__device__ __forceinline__ void prep_phase(bfu* PROJ, bfu* DST, int dmask, const int* positions, const float* g_dq, const float* g_dk, const float* g_mq, int gw, int NGW, int lane) {
    const int sub = lane & 7;
    const f32x8 gq = ld8f(g_dq + 8 * sub), gk = ld8f(g_dk + 8 * sub), gmq = ld8f(g_mq + 8 * (lane & 15));
    constexpr double I2PI = 0.15915494309189535;
    constexpr double IF0 = 1.0 * I2PI, IF1 = 0.19392274474868576 * I2PI, IF2 = 0.03760603093086393 * I2PI, IF3 = 0.007292664737217109 * I2PI,
                     IF4 = 0.001414213562373095 * I2PI, IF5 = 0.0002742481756762073 * I2PI, IF6 = 5.318295896944988e-05 * I2PI, IF7 = 1.031338537721246e-05 * I2PI;
    v4u nx[5]; int npos = 0;
#define PREP_LOAD(mm) { const bfu* pr_ = PROJ + (size_t)(mm) * NIN; _Pragma("unroll") for (int s_ = 0; s_ < 4; ++s_) nx[s_] = *(const v4u*)(pr_ + C_Q + s_ * 512 + lane * 8); nx[4] = *(const v4u*)(pr_ + C_QM + lane * 8); npos = positions[mm]; }
    if (gw < MTOK) PREP_LOAD(gw)
    for (int m = gw; m < MTOK; m += NGW) {
        bfu* drow = DST + (size_t)(m & dmask) * NIN;
        v4u cu[5];
#pragma unroll
        for (int s_ = 0; s_ < 5; ++s_) cu[s_] = nx[s_];
        const double pos = (double)npos;
        if (m + NGW < MTOK) PREP_LOAD(m + NGW)
        f32x8 cs, sn;
#define ROPE_J(j, IFJ) { double rev = pos * (IFJ); rev -= __builtin_rint(rev); const float fr = (float)rev; cs[j] = __builtin_amdgcn_cosf(fr); sn[j] = __builtin_amdgcn_sinf(fr); }
        ROPE_J(0, IF0) ROPE_J(1, IF1) ROPE_J(2, IF2) ROPE_J(3, IF3) ROPE_J(4, IF4) ROPE_J(5, IF5) ROPE_J(6, IF6) ROPE_J(7, IF7)
#undef ROPE_J
#pragma unroll
        for (int st = 0; st < 4; ++st) {
            f32x8 t = unpack8(cu[st]);
            float ss = sumsq8(t); ss += __shfl_xor(ss, 1); ss += __shfl_xor(ss, 2); ss += __shfl_xor(ss, 4);
            const float r = rsq(ss * (1.f / 64.f) + EPS);
            const f32x8 g = (st < 2) ? gq : gk;
#pragma unroll
            for (int i = 0; i < 8; ++i) t[i] = t[i] * r * g[i];
            f32x8 o;
#pragma unroll
            for (int i = 0; i < 8; ++i) { const float other = __shfl_xor(t[i], 1);
                o[i] = (sub == 0) ? (t[i] * cs[i] - other * sn[i]) : ((sub == 1) ? (t[i] * cs[i] + other * sn[i]) : t[i]); }
            if (st < 2) {
#pragma unroll
                for (int i = 0; i < 8; ++i) o[i] *= C2Q;
            }
            *(v4u*)(drow + C_Q + st * 512 + lane * 8) = pack8(o);
        }
        {
            f32x8 t = unpack8(cu[4]);
            float ss = sumsq8(t); ss += __shfl_xor(ss, 1); ss += __shfl_xor(ss, 2); ss += __shfl_xor(ss, 4); ss += __shfl_xor(ss, 8);
            const float r = rsq(ss * (1.f / 128.f) + EPS) * C2M;
#pragma unroll
            for (int i = 0; i < 8; ++i) t[i] = t[i] * r * gmq[i];
            *(v4u*)(drow + C_QM + lane * 8) = pack8(t);
        }
    }
#undef PREP_LOAD
}

namespace memattn {
constexpr int KSTR = 272, VSTR = 520;
constexpr int LDS_KM = 0, LDS_VT = MEML * KSTR, LDS_TOTAL = LDS_VT + 128 * VSTR;
static_assert(LDS_TOTAL <= LDS_BYTES, "mem-attn LDS");
__device__ __forceinline__ int crow(int r, int hi) { return (r & 3) + 8 * (r >> 2) + 4 * hi; }
__device__ __forceinline__ unsigned cvtpk(float lo, float hi) { typedef float f2 __attribute__((ext_vector_type(2))); typedef __bf16 b2 __attribute__((ext_vector_type(2))); f2 v = {lo, hi}; b2 b = __builtin_convertvector(v, b2); return __builtin_bit_cast(unsigned, b); }
__device__ __forceinline__ bf16x8 pack_half(const f32x16& p, int s) { v4u w; w.x = cvtpk(p[8 * s], p[8 * s + 1]); w.y = cvtpk(p[8 * s + 2], p[8 * s + 3]); w.z = cvtpk(p[8 * s + 4], p[8 * s + 5]); w.w = cvtpk(p[8 * s + 6], p[8 * s + 7]); return __builtin_bit_cast(bf16x8, w); }
__device__ __forceinline__ void mem_unit(int tid, int b, int h, int qblk, const bfu* PROJ, const bfu* KVM, const float* g_mk, const float* g_mq, bfu* MIXED, float* rowss2, LAS unsigned char* lds) {
    const int lane = tid & 63, r32 = lane & 31, hi = lane >> 5; const int wid = __builtin_amdgcn_readfirstlane(tid >> 6);
    { const f32x8 gmk = ld8f(g_mk + 8 * (tid & 15));
#pragma unroll
      for (int i = 0; i < 8; ++i) { const int c = tid + 512 * i, kv = c >> 4, ch = c & 15;
        f32x8 t = unpack8(*(const v4u*)(KVM + (size_t)(b * MEML + kv) * NKV + h * 128 + ch * 8));
        float ss = sumsq8(t); ss += __shfl_xor(ss, 1); ss += __shfl_xor(ss, 2); ss += __shfl_xor(ss, 4); ss += __shfl_xor(ss, 8);
        const float r = rsq(ss * (1.f / 128.f) + EPS);
        t = t * r * gmk;
        *(LAS v4u*)(lds + LDS_KM + kv * KSTR + ch * 16) = pack8(t); } }
#pragma unroll
    for (int i = 0; i < 8; ++i) { const int c = tid + 512 * i, kv = c & 255, ch = c >> 8;
        const v4u w = *(const v4u*)(KVM + (size_t)(b * MEML + kv) * NKV + 512 + h * 128 + ch * 8);
        LAS bfu* dst = (LAS bfu*)(lds + LDS_VT + (ch * 8) * VSTR + kv * 2);
        dst[0 * (VSTR / 2)] = (bfu)(w.x & 0xffffu); dst[1 * (VSTR / 2)] = (bfu)(w.x >> 16); dst[2 * (VSTR / 2)] = (bfu)(w.y & 0xffffu); dst[3 * (VSTR / 2)] = (bfu)(w.y >> 16);
        dst[4 * (VSTR / 2)] = (bfu)(w.z & 0xffffu); dst[5 * (VSTR / 2)] = (bfu)(w.z >> 16); dst[6 * (VSTR / 2)] = (bfu)(w.w & 0xffffu); dst[7 * (VSTR / 2)] = (bfu)(w.w >> 16); }
    __syncthreads();
    const size_t row = (size_t)b * SEQL + qblk * 256 + wid * 32 + r32;
    const bfu* qrow = PROJ + row * NIN + C_QM + h * 128 + hi * 8;
    bf16x8 qf[8];
#pragma unroll
    for (int d0 = 0; d0 < 8; ++d0) qf[d0] = *(const bf16x8*)(qrow + d0 * 16);
#if MK_FUSE_PREP
    {
        float ss = 0.f;
#pragma unroll
        for (int d0 = 0; d0 < 8; ++d0) ss += sumsq8(unpack8(__builtin_bit_cast(v4u, qf[d0])));
        ss += __shfl_xor(ss, 32);
        const float r = rsq(ss * (1.f / 128.f) + EPS) * C2M;
#pragma unroll
        for (int d0 = 0; d0 < 8; ++d0) { f32x8 t = unpack8(__builtin_bit_cast(v4u, qf[d0])); const f32x8 g = ld8f(g_mq + d0 * 16 + hi * 8); t = t * r * g; qf[d0] = __builtin_bit_cast(bf16x8, pack8(t)); }
    }
#endif
    f32x16 oT[4];
#pragma unroll
    for (int dt = 0; dt < 4; ++dt)
#pragma unroll
        for (int r = 0; r < 16; ++r) oT[dt][r] = 0.f;
    float mrun = -1e30f, l = 0.f;
#pragma unroll 1
    for (int kc = 0; kc < 4; ++kc) {
        f32x16 p0, p1;
#pragma unroll
        for (int r = 0; r < 16; ++r) { p0[r] = 0.f; p1[r] = 0.f; }
        const LAS unsigned char* kb = lds + LDS_KM + (kc * 64 + r32) * KSTR + hi * 16;
#pragma unroll
        for (int d0 = 0; d0 < 8; ++d0) { const bf16x8 a0 = *(const LAS bf16x8*)(kb + d0 * 32), a1 = *(const LAS bf16x8*)(kb + 32 * KSTR + d0 * 32);
            p0 = __builtin_amdgcn_mfma_f32_32x32x16_bf16(a0, qf[d0], p0, 0, 0, 0); p1 = __builtin_amdgcn_mfma_f32_32x32x16_bf16(a1, qf[d0], p1, 0, 0, 0); }
        float mx = fmaxf(p0[0], p1[0]);
#pragma unroll
        for (int r = 1; r < 16; ++r) mx = fmaxf(mx, fmaxf(p0[r], p1[r]));
        mx = fmaxf(mx, __shfl_xor(mx, 32));
        const float mnew = fmaxf(mrun, mx), f = __builtin_amdgcn_exp2f(mrun - mnew); mrun = mnew;
        l *= f;
#pragma unroll
        for (int dt = 0; dt < 4; ++dt)
#pragma unroll
            for (int r = 0; r < 16; ++r) oT[dt][r] *= f;
        float sacc = 0.f;
#pragma unroll
        for (int r = 0; r < 16; ++r) { p0[r] = __builtin_amdgcn_exp2f(p0[r] - mnew); p1[r] = __builtin_amdgcn_exp2f(p1[r] - mnew); sacc += p0[r] + p1[r]; }
        l += sacc;
        bf16x8 pa[4]; pa[0] = pack_half(p0, 0); pa[1] = pack_half(p0, 1); pa[2] = pack_half(p1, 0); pa[3] = pack_half(p1, 1);
#pragma unroll
        for (int s = 0; s < 4; ++s)
#pragma unroll
            for (int dt = 0; dt < 4; ++dt) { const LAS unsigned char* va = lds + LDS_VT + (dt * 32 + r32) * VSTR + (kc * 64 + 16 * s + 4 * hi) * 2;
                const s16x4 lo = *(const LAS s16x4*)va, h4 = *(const LAS s16x4*)(va + 16);
                const bf16x8 a = __builtin_shufflevector(lo, h4, 0, 1, 2, 3, 4, 5, 6, 7);
                oT[dt] = __builtin_amdgcn_mfma_f32_32x32x16_bf16(a, pa[s], oT[dt], 0, 0, 0); }
    }
    l += __shfl_xor(l, 32);
    const float inv = 1.0f / l;
    bfu* orow = MIXED + row * DMODEL + 1536 + h * 128;
    { float ss = 0.f;
#pragma unroll
      for (int dt = 0; dt < 4; ++dt)
#pragma unroll
          for (int r = 0; r < 16; ++r) { const float v = oT[dt][r] * inv; ss += v * v; }
      ss += __shfl_xor(ss, 32);
      if (hi == 0) unsafeAtomicAdd(rowss2 + row, ss); }
#pragma unroll
    for (int dt = 0; dt < 4; ++dt)
#pragma unroll
        for (int g = 0; g < 4; ++g) { v2u w; w.x = pk2(oT[dt][4 * g] * inv, oT[dt][4 * g + 1] * inv); w.y = pk2(oT[dt][4 * g + 2] * inv, oT[dt][4 * g + 3] * inv);
            *(v2u*)(orow + dt * 32 + 8 * g + 4 * hi) = w; }
    __syncthreads();
}
}

__device__ __forceinline__ void conv_phase(const bfu* PROJ, bfu* MIXED, const float* conv_w, const float* g_conv_out, int gw, int NGW, int lane) {
    const f32x8 w0 = ld8f(conv_w + lane * 8), w1 = ld8f(conv_w + 512 + lane * 8), w2 = ld8f(conv_w + 1024 + lane * 8), gco = ld8f(g_conv_out + lane * 8);
    v4u nx[7];
#define CONV_LOAD(mm) { const int s_ = (mm) & (SEQL - 1); const bfu* p0_ = PROJ + (size_t)(mm) * NIN + lane * 8; const bfu* p1_ = p0_ - (s_ >= 1 ? NIN : 0); const bfu* p2_ = p0_ - (s_ >= 2 ? 2 * NIN : 0); \
        nx[0] = *(const v4u*)(p0_ + C_U); nx[1] = *(const v4u*)(p0_ + C_C); nx[2] = *(const v4u*)(p0_ + C_B); nx[3] = *(const v4u*)(p1_ + C_U); nx[4] = *(const v4u*)(p1_ + C_C); nx[5] = *(const v4u*)(p2_ + C_U); nx[6] = *(const v4u*)(p2_ + C_C); }
    if (gw < MTOK) CONV_LOAD(gw)
    for (int m = gw; m < MTOK; m += NGW) {
        const int s = m & (SEQL - 1);
        v4u cu[7];
#pragma unroll
        for (int i = 0; i < 7; ++i) cu[i] = nx[i];
        if (m + NGW < MTOK) CONV_LOAD(m + NGW)
        const f32x8 z2 = unpack8(cu[0]) * unpack8(cu[1]), bg = unpack8(cu[2]);
        const float k1 = (s >= 1) ? 1.f : 0.f, k0 = (s >= 2) ? 1.f : 0.f;
        const f32x8 z1 = unpack8(cu[3]) * unpack8(cu[4]) * k1, z0 = unpack8(cu[5]) * unpack8(cu[6]) * k0;
        f32x8 y = bg * (w0 * z0 + w1 * z1 + w2 * z2);
        const float r = rsq(wave_sum(sumsq8(y)) * (1.f / 512.f) + EPS);
        y = y * r * gco;
        *(v4u*)(MIXED + (size_t)m * DMODEL + lane * 8) = pack8(y);
    }
#undef CONV_LOAD
}
__device__ __forceinline__ void finalize_phase(const bfu* PROJ, const bfu* ODIFF, const bfu* OMEM, bfu* MIXED, const float* conv_w, const float* g_conv_out, const float* lq1, const float* lk1, const float* lq2, const float* lk2,
                                               const float* g_sub, const float* g_mem_out, int gw, int NGW, int lane) {
#if !MK_FUSE_PREP
    conv_phase(PROJ, MIXED, conv_w, g_conv_out, gw, NGW, lane);
#endif
    const f32x8 gmo = ld8f(g_mem_out + lane * 8);
    const int hd = lane >> 3, sub = lane & 7;
    const f32x8 gs0 = ld8f(g_sub + sub * 16), gs1 = ld8f(g_sub + sub * 16 + 8);
    const float lam = __expf(wave_sum(lq1[lane] * lk1[lane])) - __expf(wave_sum(lq2[lane] * lk2[lane])) + LAM_INIT;
    v4u nx[5];
#define FIN_LOAD(mm) { nx[4] = *(const v4u*)(OMEM + (size_t)(mm) * 512 + lane * 8); }
    if (gw < MTOK) FIN_LOAD(gw)
    for (int m = gw; m < MTOK; m += NGW) {
        bfu* mrow = MIXED + (size_t)m * DMODEL;
        v4u cu[5];
#pragma unroll
        for (int i = 0; i < 5; ++i) cu[i] = nx[i];
        if (m + NGW < MTOK) FIN_LOAD(m + NGW)
        {
            f32x8 t = unpack8(cu[4]);
            const float r = rsq(wave_sum(sumsq8(t)) * (1.f / 512.f) + EPS);
            t = t * r * gmo;
            *(v4u*)(mrow + 1536 + lane * 8) = pack8(t);
        }
    }
#undef FIN_LOAD
}

#define XB_TMO      128
#define XB_XCNT(j)  (256  + 64 * (j))
#define XB_XSUB(j)  (1280 + 64 * (j))
#define XB_XGEN(j)  (2304 + 64 * (j))
#define XB_TOP      3328
#define XB_TOPGEN   3392
#define XCD_BAR_WORDS 3456
#define XB_SPIN_CAP (1u << 18)

__device__ __forceinline__ unsigned xb_ld(unsigned* p)              { return __hip_atomic_load(p, __ATOMIC_RELAXED, __HIP_MEMORY_SCOPE_AGENT); }
__device__ __forceinline__ unsigned xb_add(unsigned* p, unsigned v) { return __hip_atomic_fetch_add(p, v, __ATOMIC_RELAXED, __HIP_MEMORY_SCOPE_AGENT); }
__device__ __forceinline__ unsigned xb_xcc_id() { return (unsigned)__builtin_amdgcn_s_getreg((3 << 11) | 20) & 0xFu; }
#define XB_SPIN(cond, bar) do { unsigned _sp = 0; while (cond) { __builtin_amdgcn_s_sleep(1); \
    if ((++_sp & 255u) == 0u) { if (xb_ld(&(bar)[XB_TMO])) break; if (_sp > XB_SPIN_CAP) { atomicAdd(&(bar)[XB_TMO], 1u); break; } } } } while (0)

struct XcdBarrier {
    unsigned* bar; unsigned x;
    volatile LAS unsigned* st;
};

__device__ __forceinline__ XcdBarrier xcd_barrier_post(unsigned* bar, volatile LAS unsigned* st, int tid) {
    XcdBarrier b; b.bar = bar; b.x = xb_xcc_id(); b.st = st;
    if (tid == 0) (void)xb_add(&bar[XB_XCNT(b.x)], 1u);
    return b;
}
__device__ __forceinline__ void xcd_barrier_complete(unsigned* bar, unsigned x, unsigned& nloc, unsigned& nx) {
    const unsigned G = gridDim.x * gridDim.y * gridDim.z;
    unsigned sum, cnt, mine, sp = 0u;
    for (;;) {
        sum = 0u; cnt = 0u; mine = 0u;
#pragma unroll
        for (unsigned j = 0; j < 16; ++j) { const unsigned c = xb_ld(&bar[XB_XCNT(j)]); sum += c; cnt += (c > 0u) ? 1u : 0u; mine = (j == x) ? c : mine; }
        if (sum == G) break;
        __builtin_amdgcn_s_sleep(1);
        if ((++sp & 255u) == 0u) { if (xb_ld(&bar[XB_TMO])) break; if (sp > XB_SPIN_CAP) { atomicAdd(&bar[XB_TMO], 1u); break; } }
    }
    nloc = mine > 0u ? mine : 1u; nx = cnt > 0u ? cnt : 1u;
}

__device__ __forceinline__ void xcd_barrier(const XcdBarrier& b, int tid) {
    asm volatile("s_waitcnt vmcnt(0)" ::: "memory");
    __syncthreads();
    if (tid == 0) {
        unsigned* bar = b.bar;
        __builtin_amdgcn_s_waitcnt(0);
        unsigned nloc = b.st[0], nx = b.st[1];
        if (nloc == 0u) { xcd_barrier_complete(bar, b.x, nloc, nx); b.st[0] = nloc; b.st[1] = nx; }
        const unsigned old = xb_add(&bar[XB_XSUB(b.x)], 1u);
        const unsigned gen = old / nloc;
        if (old + 1u == (gen + 1u) * nloc) {
            __builtin_amdgcn_fence(__ATOMIC_RELEASE, "agent");
            asm volatile("s_waitcnt vmcnt(0)" ::: "memory");
            const unsigned og = xb_add(&bar[XB_TOP], 1u);
            const unsigned tg = og / nx;
            if (og + 1u == (tg + 1u) * nx) xb_add(&bar[XB_TOPGEN], 1u);
            else XB_SPIN(xb_ld(&bar[XB_TOPGEN]) == tg, bar);
            __builtin_amdgcn_fence(__ATOMIC_ACQUIRE, "agent");
            xb_add(&bar[XB_XGEN(b.x)], 1u);
            asm volatile("s_waitcnt vmcnt(0)" ::: "memory");
        } else {
            XB_SPIN(xb_ld(&bar[XB_XGEN(b.x)]) == gen, bar);
            __builtin_amdgcn_fence(__ATOMIC_ACQUIRE, "agent");
            asm volatile("s_waitcnt vmcnt(0)" ::: "memory");
        }
    }
    __syncthreads();
}

__device__ __forceinline__ int fresh_tid(int wave) { unsigned z; asm volatile("s_mov_b32 %0, 0" : "=s"(z)); return wave * 64 + (int)__builtin_amdgcn_mbcnt_hi(~0u, __builtin_amdgcn_mbcnt_lo(~0u, z)); }
struct Args { const float* in[24]; float* out; unsigned char* ws; int ph_lo, ph_hi; };
constexpr int N_PHASES = 8;
__global__ void __launch_bounds__(NWAVES * 64, 2) mk_fwd(Args a) {
    extern __shared__ __attribute__((aligned(16))) unsigned char lds_raw[];
    LAS unsigned char* lds = (LAS unsigned char*)lds_raw;
    cg::grid_group grid = cg::this_grid();
    const int wave0 = __builtin_amdgcn_readfirstlane((int)threadIdx.x >> 6);
    const int G = gridDim.x, bx = blockIdx.x, vcu = (G % 8 == 0) ? (bx % 8) * (G / 8) + bx / 8 : bx;
    const int NGW = G * NWAVES;
#define LANE_VARS() const int tid_ = fresh_tid(wave0); const int lane = tid_ & 63, wave = wave0, gw = vcu * NWAVES + wave; (void)lane; (void)gw;
    typedef const __attribute__((address_space(4))) Args* kargs_t;
#define KARGS() ({ unsigned long long v_ = (unsigned long long)__builtin_amdgcn_kernarg_segment_ptr(); asm volatile("" : "+s"(v_)); (kargs_t)v_; })
#define WSP(ka, off) ((bfu*)((ka)->ws + (off)))
#define IN(k) (a.ph_lo <= (k) && (k) < a.ph_hi)
#define SEAM(k) do { if (IN(k) && IN((k) + 1)) { xcd_barrier(xbar, fresh_tid(wave0)); if (PROBE_DUP == 100) xcd_barrier(xbar, fresh_tid(wave0)); } } while (0)
    volatile LAS unsigned* xst = (volatile LAS unsigned*)(lds + LDS_BARST);
    { const int t_ = fresh_tid(wave0); if (t_ == 0) { xst[0] = 0u; xst[1] = 0u; } __syncthreads(); }
    XcdBarrier xbar; xbar.bar = (unsigned*)(a.ws + WS_BAR); xbar.x = 0; xbar.st = xst;
    if (a.ph_hi - a.ph_lo > 2) { xbar = xcd_barrier_post((unsigned*)(a.ws + WS_BAR), xst, fresh_tid(wave0)); if (PROBE_DUP == 101) grid.sync(); }

    for (int rep_ = 0; rep_ < (PROBE_DUP == 0 ? 2 : 1); ++rep_) if (IN(0)) {
        LANE_VARS(); kargs_t ka = KARGS(); const float *x = ka->in[0], *mem = ka->in[1], *g_mix = ka->in[3], *g_mem = ka->in[4], *w_in = ka->in[5], *w_mem_kv = ka->in[15], *w_o = ka->in[19], *w_gate = ka->in[21], *w_up = ka->in[22], *w_down = ka->in[23], *g_ffn = ka->in[20];
        bfu *WIN = WSP(ka, WS_WIN), *WKV = WSP(ka, WS_WKV), *WO = WSP(ka, WS_WO), *WGU = WSP(ka, WS_WGU), *WD = WSP(ka, WS_WD), *HB = WSP(ka, WS_HB), *MEMN = WSP(ka, WS_MEMN);
        LAS float* scr = (LAS float*)(lds + wave * 16384);
        constexpr int I_IN = (DMODEL / 64) * (NIN / 32), I_KV = (DMODEL / 64) * (NKV / 32), I_O = (DMODEL / 64) * (DMODEL / 32), I_G = (DMODEL / 64) * (FFH / 32), I_D = (FFH / 64) * (DMODEL / 32);
        constexpr int NITEMS = I_IN + I_KV + (MK_FUSE_PREP ? 0 : 2 * I_G);
        for (int it = gw; it < NITEMS; it += NGW) {
            int r = it;
            if (r < I_IN) { p0_transpose_item(w_in, DMODEL, NIN, WIN, 3, nullptr, scr, r, lane); continue; } r -= I_IN;
            if (r < I_KV) { p0_transpose_item(w_mem_kv, DMODEL, NKV, WKV, 0, nullptr, scr, r, lane); continue; } r -= I_KV;
            if (r < I_G) { p0_transpose_item(w_gate, DMODEL, FFH, WGU, 1, g_ffn, scr, r, lane); continue; } r -= I_G;
            p0_transpose_item(w_up, DMODEL, FFH, WGU, 2, g_ffn, scr, r, lane);
        }
        { float* rowss = (float*)(ka->ws + WS_ROWSS); float* rowss2 = (float*)(ka->ws + WS_ROWSS2); for (int i = gw * 64 + lane; i < MTOK; i += NGW * 64) { rowss[i] = 0.f; rowss2[i] = 0.f; } }
        for (int m = gw; m < MTOK; m += NGW) rms_row_to_bf16(x + (size_t)m * DMODEL, g_mix, HB + (size_t)m * DMODEL, lane);
        for (int m = gw; m < MROWS; m += NGW) rms_row_to_bf16(mem + (size_t)m * DMODEL, g_mem, MEMN + (size_t)m * DMODEL, lane);
        __syncthreads();
    }
    SEAM(0);
    for (int rep_ = 0; rep_ < (PROBE_DUP == 1 ? 2 : 1); ++rep_) if (IN(1)) {
        kargs_t ka = KARGS(); bfu *WIN = WSP(ka, WS_WIN), *HB = WSP(ka, WS_HB), *PROJ = WSP(ka, WS_PROJ);
        { pg8::Gemm g{HB, WIN, MTOK, NIN, DMODEL}; pg8::StaticOrder S; S.init(MTOK, NIN, G, bx); pg8::EpiProj<MK_FUSE_PREP != 0> E{PROJ, NIN, (const int*)ka->in[2], ka->in[8], ka->in[9], C2Q, EPS};
          pg8::gemm_phase<pg8::EpiProj<MK_FUSE_PREP != 0>, pg8::StaticOrder, true, true>(fresh_tid(wave0), lds, g, S, E); }
    }
    SEAM(1);
    for (int rep_ = 0; rep_ < (PROBE_DUP == 2 ? 2 : 1); ++rep_) if (IN(2)) {
        constexpr int NGEMM = 32; const bool split = G >= 2 * NGEMM;
        if (!split || bx < NGEMM) { kargs_t ka = KARGS(); pg8::Gemm g{WSP(ka, WS_MEMN), WSP(ka, WS_WKV), MROWS, NKV, DMODEL}; pg8::StaticOrder S; S.init(MROWS, NKV, split ? NGEMM : G, bx); pg8::EpiStoreBf16 E{WSP(ka, WS_KVM), NKV};
            pg8::gemm_phase<pg8::EpiStoreBf16, pg8::StaticOrder, true, true>(fresh_tid(wave0), lds, g, S, E); }
        if (!split || bx >= NGEMM) { LANE_VARS(); kargs_t ka = KARGS(); const int ci = split ? bx - NGEMM : bx, ncu = split ? G - NGEMM : G;
#if !MK_FUSE_PREP
            prep_phase(WSP(ka, WS_PROJ), WSP(ka, WS_PROJ), 0xffffff, (const int*)ka->in[2], ka->in[8], ka->in[9], ka->in[16], ci * NWAVES + wave, ncu * NWAVES, lane);
#else
            conv_phase(WSP(ka, WS_PROJ), WSP(ka, WS_MIXED), ka->in[6], ka->in[7], ci * NWAVES + wave, ncu * NWAVES, lane);
#endif
            { constexpr int I_O = (DMODEL / 64) * (DMODEL / 32), I_D = (FFH / 64) * (DMODEL / 32), I_G = MK_FUSE_PREP ? (DMODEL / 64) * (FFH / 32) : 0; LAS float* scr = (LAS float*)(lds + wave * 16384);
              const float *w_o = ka->in[19], *w_down = ka->in[23]; bfu *WO = WSP(ka, WS_WO), *WD = WSP(ka, WS_WD);
              for (int it = ci * NWAVES + wave; it < I_O + I_D + 2 * I_G; it += ncu * NWAVES) { int r = it;
                  if (r < I_O) { p0_transpose_item(w_o, DMODEL, DMODEL, WO, 0, (64 * (r / (DMODEL / 32)) >= 1536) ? ka->in[18] - 1536 : nullptr, scr, r, lane); continue; } r -= I_O;
                  if (r < I_D) { p0_transpose_item(w_down, FFH, DMODEL, WD, 0, nullptr, scr, r, lane); continue; } r -= I_D;
                  if (r < I_G) { p0_transpose_item(ka->in[21], DMODEL, FFH, WSP(ka, WS_WGU), 1, ka->in[20], scr, r, lane); continue; } r -= I_G;
                  p0_transpose_item(ka->in[22], DMODEL, FFH, WSP(ka, WS_WGU), 2, ka->in[20], scr, r, lane); }
              __syncthreads(); } }
    }
    SEAM(2);
    for (int rep_ = 0; rep_ < (PROBE_DUP == 3 ? 2 : 1); ++rep_) if (IN(3)) {
        kargs_t ka = KARGS(); bfu *PROJ = WSP(ka, WS_PROJ), *ODIFF = WSP(ka, WS_ODIFF), *KVM = WSP(ka, WS_KVM);
        for (int s = vcu; s < NB * 32; s += G) {
            const int pr = s & 3, h = (s >> 2) & 7, b = s >> 5;
            const attn_body::bf16* base = (const attn_body::bf16*)PROJ + (size_t)b * SEQL * NIN;
            const attn_body::bf16* Q0 = base + C_Q + h * 128; const attn_body::bf16* K0 = base + C_K + h * 128; const attn_body::bf16* Vh = base + C_V + h * 128;
            attn_body::bf16* Opark = (attn_body::bf16*)ODIFF + (size_t)b * SEQL * DMODEL + h * 256;
            attn_body::bf16* Omix = (attn_body::bf16*)WSP(ka, WS_MIXED) + (size_t)b * SEQL * DMODEL + 512 + h * 128;
            float lam; { LANE_VARS(); lam = __expf(wave_sum(ka->in[10][lane] * ka->in[11][lane])) - __expf(wave_sum(ka->in[12][lane] * ka->in[13][lane])) + LAM_INIT; }
            const float* gsub = ka->in[14];
#define AU2_(q) do { attn_body::attn_unit<8, 0>(fresh_tid(wave0), (q), Q0, K0, Vh, Opark, (char*)lds_raw, nullptr, 0.f, nullptr, 0.f); \
                     attn_body::attn_unit<8, 1>(fresh_tid(wave0), (q), Q0 + 64, K0 + 64, Vh, Omix, (char*)lds_raw, Opark, lam, gsub, 1.0f - LAM_INIT); } while (0)
            if (pr == 0) { AU2_(7); AU2_(0); } else if (pr == 1) { AU2_(6); AU2_(1); } else if (pr == 2) { AU2_(5); AU2_(2); } else { AU2_(4); AU2_(3); }
#undef AU2_
        }
        for (int mrep_ = 0; mrep_ < (PROBE_DUP == 103 ? 2 : 1); ++mrep_)
        for (int u = vcu; u < NB * 4 * 8; u += G) memattn::mem_unit(fresh_tid(wave0), u >> 5, (u >> 3) & 3, u & 7, PROJ, KVM, ka->in[17], ka->in[16], WSP(ka, WS_MIXED), (float*)(ka->ws + WS_ROWSS2), lds);
    }
    SEAM(3);
    for (int rep_ = 0; rep_ < (PROBE_DUP == 5 ? 2 : 1); ++rep_) if (IN(5)) { kargs_t ka = KARGS(); const float* x = ka->in[0]; bfu *MIXED = WSP(ka, WS_MIXED), *WO = WSP(ka, WS_WO);
        pg8::Gemm g{MIXED, WO, MTOK, DMODEL, DMODEL}; pg8::StaticOrder S; S.init(MTOK, DMODEL, G, bx); pg8::EpiResNormMid E{x, DMODEL, WSP(ka, WS_HB), (float*)(ka->ws + WS_ROWSS + (rep_ == 0 ? 0 : 131072)), (const float*)(ka->ws + WS_ROWSS2), 1.0f / 512.0f, EPS};
        pg8::gemm_phase<pg8::EpiResNormMid, pg8::StaticOrder, true, true>(fresh_tid(wave0), lds, g, S, E); }
    SEAM(5);
    for (int rep_ = 0; rep_ < (PROBE_DUP == 6 ? 2 : 1); ++rep_) if (IN(6)) { kargs_t ka = KARGS(); bfu *HB = WSP(ka, WS_HB), *WGU = WSP(ka, WS_WGU), *ACT = WSP(ka, WS_ACT);
        pg8::Gemm g{HB, WGU, MTOK, NGU, DMODEL}; pg8::StaticOrder S; S.init(MTOK, NGU, G, bx); pg8::EpiSwiGLU E{ACT, FFH, (const float*)(ka->ws + WS_ROWSS), 1.0f / DMODEL, EPS};
        pg8::gemm_phase<pg8::EpiSwiGLU, pg8::StaticOrder, true, true>(fresh_tid(wave0), lds, g, S, E); }
    SEAM(6);
    for (int rep_ = 0; rep_ < (PROBE_DUP == 7 ? 2 : 1); ++rep_) if (IN(7)) { kargs_t ka = KARGS(); float* out = ka->out; bfu *ACT = WSP(ka, WS_ACT), *WD = WSP(ka, WS_WD);
        pg8::Gemm g{ACT, WD, MTOK, DMODEL, FFH}; pg8::StaticOrder S; S.init(MTOK, DMODEL, G, bx); pg8::EpiResBf16 E{WSP(ka, WS_HB), out, DMODEL};
        pg8::gemm_phase<pg8::EpiResBf16, pg8::StaticOrder, true, true>(fresh_tid(wave0), lds, g, S, E); }
#undef IN
#undef SEAM
#undef KARGS
#undef LANE_VARS
#undef WSP
}

extern "C" void kernel_launch(void* const* d_in, const int* in_sizes, int n_in, void* d_out, int out_size, void* d_ws, size_t ws_size, hipStream_t stream) {
    static int grid = 0;
    if (grid == 0) {
        if (n_in != 24 || in_sizes[0] != MTOK * DMODEL || out_size != MTOK * DMODEL || ws_size < WS_END) {
            fprintf(stderr, "kernel_launch: unexpected shapes (n_in %d, in0 %d, out %d, ws %zu); nothing launched\n", n_in, n_in > 0 ? in_sizes[0] : -1, out_size, ws_size); grid = -1; return; }
        int dev = 0, cus = 0, per_cu = 0;
        if (hipGetDevice(&dev) != hipSuccess || hipDeviceGetAttribute(&cus, hipDeviceAttributeMultiprocessorCount, dev) != hipSuccess) { fprintf(stderr, "kernel_launch: device query failed\n"); grid = -1; return; }
        if (hipFuncSetAttribute((const void*)mk_fwd, hipFuncAttributeMaxDynamicSharedMemorySize, LDS_BYTES) != hipSuccess) { fprintf(stderr, "kernel_launch: hipFuncSetAttribute failed\n"); grid = -1; return; }
        if (hipOccupancyMaxActiveBlocksPerMultiprocessor(&per_cu, (const void*)mk_fwd, NWAVES * 64, LDS_BYTES) != hipSuccess || per_cu < 1) { fprintf(stderr, "kernel_launch: occupancy query reports %d workgroups per CU\n", per_cu); (void)hipGetLastError(); grid = -1; return; }
        grid = cus;
    }
    if (grid < 0) return;
    if (hipMemsetAsync((char*)d_ws + WS_BAR, 0, BAR_ZERO_BYTES, stream) != hipSuccess) { fprintf(stderr, "kernel_launch: hipMemsetAsync of the barrier words failed\n"); return; }
    Args a{};
    for (int i = 0; i < 24; ++i) a.in[i] = (const float*)d_in[i];
    a.out = (float*)d_out; a.ws = (unsigned char*)d_ws;
#if MK_MULTI
    for (int p = 0; p < N_PHASES; ++p) { a.ph_lo = p; a.ph_hi = p + 1; hipLaunchKernelGGL(mk_fwd, dim3(grid), dim3(NWAVES * 64), LDS_BYTES, stream, a); }
#else
    a.ph_lo = 0; a.ph_hi = N_PHASES;
    void* args[] = {&a};
    const hipError_t e = hipLaunchCooperativeKernel((const void*)mk_fwd, dim3(grid), dim3(NWAVES * 64), args, LDS_BYTES, stream);
    if (e != hipSuccess) fprintf(stderr, "kernel_launch: cooperative launch failed: %s (grid %d)\n", hipGetErrorString(e), grid);
#endif
}
```

```cpp
#include <hip/hip_runtime.h>
#include <hip/hip_cooperative_groups.h>
#include <cstdio>
#include <cstdint>
namespace cg = cooperative_groups;
#ifndef MK_MULTI
#define MK_MULTI 0
#endif
#ifndef PROBE_DUP
#define PROBE_DUP -1
#endif
#ifndef MK_FUSE_PREP
#define MK_FUSE_PREP 1
#endif
namespace pg8 {
#define PG8_LAS __attribute__((address_space(3)))
typedef unsigned short bf16_t;
typedef short bf16x8 __attribute__((ext_vector_type(8)));
typedef float f32x4 __attribute__((ext_vector_type(4)));
typedef unsigned u32x4 __attribute__((ext_vector_type(4)));
constexpr int BM = 256, BK = 64, HALF = 128, HTB = HALF * BK * 2  , STAGE_BYTES = 8 * HTB, NXCD = 8, WGM = 8;

__host__ __device__ __forceinline__ int lds_byte(int r, int c) { const int st = (r >> 4) * 2 + (c >> 5), rr = r & 15, cc = c & 31, ob = rr * 64 + cc * 2; return st * 1024 + (ob ^ (((ob >> 9) & 1) << 5)); }
__host__ __device__ __forceinline__ void stage_rc(int b, int& R, int& C) { const int st = b / 1024, sb = b % 1024, swz = sb ^ (((sb >> 9) & 1) << 5); R = (st >> 1) * 16 + swz / 64; C = (st & 1) * 32 + (swz % 64) / 2; }
__host__ __device__ __forceinline__ int perm32(int rho) { const int n = rho >> 4, i = rho & 15; return 8 * (i >> 2) + 4 * n + (i & 3); }

struct Unit { int pm, pn; };
struct Gemm { const bf16_t* A; const bf16_t* Bt; int M, N, K; };

struct StaticOrder {
    int nM, nN, nwg, G, c;
    __host__ __device__ void init(int M, int N, int G_, int c_) { nM = M / BM; nN = N / BM; nwg = nM * nN; G = G_; c = c_; }
    __host__ __device__ bool next(int i, Unit& u) const {
        const long L = (long)i * G + c; if (L >= nwg) return false;
        int wgid = (int)L; { const int q = nwg / NXCD, r = nwg % NXCD, xcd = wgid % NXCD, off = wgid / NXCD; wgid = (xcd < r ? xcd * (q + 1) : r * (q + 1) + (xcd - r) * q) + off; }
        const int nig = WGM * nN, gid = wgid / nig, fm = gid * WGM, gsz = (nM - fm) < WGM ? (nM - fm) : WGM;
        u.pm = fm + ((wgid % nig) % gsz); u.pn = (wgid % nig) / gsz; return true;
    }
    __device__ __forceinline__ void a_ready(const Unit&) const {}
    __device__ __forceinline__ void done(const Unit&) const {}
};
__device__ __forceinline__ unsigned cvt_pk_bf16(float lo, float hi) { unsigned r; asm volatile("v_cvt_pk_bf16_f32 %0, %1, %2" : "=v"(r) : "v"(lo), "v"(hi)); return r; }
typedef unsigned u32x2 __attribute__((ext_vector_type(2)));
template <bool FUSE> struct EpiProj {
    static constexpr bool PERM = true, AFTER_DRAIN = false; static constexpr int MID_T = -1;
    bf16_t* O; int ldc; const int* positions; const float* g_dq; const float* g_dk; float qscale, eps;
    __device__ __forceinline__ void operator()(const f32x4 (&acc)[2][2][4][2], const Unit& u, int wr, int wc, int fr, int fq) const {
        const int row0 = u.pm * BM + wr * 64 + fr, col0 = u.pn * BM + wc * 64 + 8 * fq;
        const bool qk = FUSE && u.pn >= 6 && u.pn < 14;
        if (!qk) {
#pragma unroll
            for (int ai = 0; ai < 2; ++ai)
#pragma unroll
                for (int m = 0; m < 4; ++m) { bf16_t* rowp = O + (size_t)(row0 + ai * HALF + m * 16) * ldc + col0;
#pragma unroll
                    for (int bj = 0; bj < 2; ++bj) { const f32x4 v0 = acc[ai][bj][m][0], v1 = acc[ai][bj][m][1];
                        u32x4 w; w.x = cvt_pk_bf16(v0[0], v0[1]); w.y = cvt_pk_bf16(v0[2], v0[3]); w.z = cvt_pk_bf16(v1[0], v1[1]); w.w = cvt_pk_bf16(v1[2], v1[3]);
                        *(u32x4*)(rowp + bj * 32) = w; } }
        } else {
            const bool isq = u.pn < 10, lo = fq < 2;
            const float* gb = isq ? g_dq : g_dk;
            const int d00 = lo ? 4 * fq : 8 * fq, d01 = lo ? 8 + 4 * fq : 8 * fq + 4;
            f32x4 gv[2][2];
            gv[0][0] = *(const f32x4*)(gb + d00); gv[0][1] = *(const f32x4*)(gb + d01);
            gv[1][0] = *(const f32x4*)(gb + 32 + 8 * fq); gv[1][1] = *(const f32x4*)(gb + 32 + 8 * fq + 4);
            const float sc = isq ? qscale : 1.0f;
            constexpr double I2PI = 0.15915494309189535;
            constexpr double IFR[8] = {1.0 * I2PI, 0.19392274474868576 * I2PI, 0.03760603093086393 * I2PI, 0.007292664737217109 * I2PI,
                                       0.001414213562373095 * I2PI, 0.0002742481756762073 * I2PI, 5.318295896944988e-05 * I2PI, 1.031338537721246e-05 * I2PI};
            const bool hi4 = (fq & 1) != 0;
            const double if0 = hi4 ? IFR[4] : IFR[0], if1 = hi4 ? IFR[5] : IFR[1], if2 = hi4 ? IFR[6] : IFR[2], if3 = hi4 ? IFR[7] : IFR[3];
            int posr[2][4]; float ssr[2][4];
#pragma unroll
            for (int ai = 0; ai < 2; ++ai)
#pragma unroll
                for (int m = 0; m < 4; ++m) { posr[ai][m] = positions[row0 + ai * HALF + m * 16]; float s = 0.f;
#pragma unroll
                    for (int bj = 0; bj < 2; ++bj)
#pragma unroll
                        for (int n = 0; n < 2; ++n) { const f32x4 x = acc[ai][bj][m][n]; s += (x[0] * x[0] + x[1] * x[1]) + (x[2] * x[2] + x[3] * x[3]); }
                    ssr[ai][m] = s; }
#pragma unroll
            for (int ai = 0; ai < 2; ++ai)
#pragma unroll
                for (int m = 0; m < 4; ++m) ssr[ai][m] += __shfl_xor(ssr[ai][m], 16);
#pragma unroll
            for (int ai = 0; ai < 2; ++ai)
#pragma unroll
                for (int m = 0; m < 4; ++m) ssr[ai][m] += __shfl_xor(ssr[ai][m], 32);
#pragma unroll
            for (int ai = 0; ai < 2; ++ai)
#pragma unroll
                for (int m = 0; m < 4; ++m) { bf16_t* rowp = O + (size_t)(row0 + ai * HALF + m * 16) * ldc + u.pn * BM + wc * 64;
                    const double pos = (double)posr[ai][m];
                    f32x4 cs, sn;
#define PG8_ROPE(i, IFJ) { double rev = pos * (IFJ); rev -= __builtin_rint(rev); const float frv = (float)rev; cs[i] = __builtin_amdgcn_cosf(frv); sn[i] = __builtin_amdgcn_sinf(frv); }
                    PG8_ROPE(0, if0) PG8_ROPE(1, if1) PG8_ROPE(2, if2) PG8_ROPE(3, if3)
#undef PG8_ROPE
                    const float r = 1.0f / sqrtf(ssr[ai][m] * (1.0f / 64.0f) + eps);
                    f32x4 t[2][2];
#pragma unroll
                    for (int bj = 0; bj < 2; ++bj)
#pragma unroll
                        for (int n = 0; n < 2; ++n) t[bj][n] = acc[ai][bj][m][n] * r * gv[bj][n];
                    if (lo) { const f32x4 a = t[0][0], b = t[0][1]; t[0][0] = a * cs - b * sn; t[0][1] = b * cs + a * sn; }
                    { const f32x4 v0 = t[0][0] * sc, v1 = t[0][1] * sc; u32x2 w0, w1; w0.x = cvt_pk_bf16(v0[0], v0[1]); w0.y = cvt_pk_bf16(v0[2], v0[3]); w1.x = cvt_pk_bf16(v1[0], v1[1]); w1.y = cvt_pk_bf16(v1[2], v1[3]);
                      *(u32x2*)(rowp + d00) = w0; *(u32x2*)(rowp + d01) = w1; }
                    { const f32x4 v0 = t[1][0] * sc, v1 = t[1][1] * sc; u32x4 w; w.x = cvt_pk_bf16(v0[0], v0[1]); w.y = cvt_pk_bf16(v0[2], v0[3]); w.z = cvt_pk_bf16(v1[0], v1[1]); w.w = cvt_pk_bf16(v1[2], v1[3]);
                      *(u32x4*)(rowp + 32 + 8 * fq) = w; } }
        }
    }
};
struct EpiStoreBf16 {
    static constexpr bool PERM = true, AFTER_DRAIN = false; static constexpr int MID_T = -1;
    bf16_t* O; int ldc;
    __device__ __forceinline__ void operator()(const f32x4 (&acc)[2][2][4][2], const Unit& u, int wr, int wc, int fr, int fq) const {
        const int row0 = u.pm * BM + wr * 64 + fr, col0 = u.pn * BM + wc * 32 + 8 * fq;
#pragma unroll
        for (int ai = 0; ai < 2; ++ai)
#pragma unroll
            for (int m = 0; m < 4; ++m) { bf16_t* rowp = O + (size_t)(row0 + ai * HALF + m * 16) * ldc + col0;
#pragma unroll
                for (int bj = 0; bj < 2; ++bj) { const f32x4 v0 = acc[ai][bj][m][0], v1 = acc[ai][bj][m][1];
                    u32x4 w; w.x = cvt_pk_bf16(v0[0], v0[1]); w.y = cvt_pk_bf16(v0[2], v0[3]); w.z = cvt_pk_bf16(v1[0], v1[1]); w.w = cvt_pk_bf16(v1[2], v1[3]);
                    *(u32x4*)(rowp + bj * HALF) = w; } }
    }
};
#define PG8_EPI_SB() __builtin_amdgcn_sched_barrier(0)
#define PG8_ROWB(g, mm) (bo + (unsigned)((((g) >> 1) * HALF + (2 * ((g) & 1) + (mm)) * 16) * ldc) * 4u)
#define PG8_LDRES(B, g) _Pragma("unroll") for (int mm = 0; mm < 2; ++mm) { const unsigned rb = PG8_ROWB(g, mm); \
            _Pragma("unroll") for (int bj = 0; bj < 2; ++bj) _Pragma("unroll") for (int n = 0; n < 2; ++n) B[mm][bj][n] = *(const f32x4*)((const char*)base + (rb + (unsigned)(bj * HALF + 4 * n) * 4u)); }
#define PG8_ADDRES(B, g) _Pragma("unroll") for (int mm = 0; mm < 2; ++mm) _Pragma("unroll") for (int bj = 0; bj < 2; ++bj) _Pragma("unroll") for (int n = 0; n < 2; ++n) acc[(g) >> 1][bj][2 * ((g) & 1) + mm][n] += B[mm][bj][n];
struct EpiResF32 {
    static constexpr bool PERM = true, AFTER_DRAIN = false; static constexpr int MID_T = -1;
    const float* base; float* out; int ldc;
    __device__ __forceinline__ void operator()(f32x4 (&acc)[2][2][4][2], const Unit& u, int wr, int wc, int fr, int fq) const {
        const int row0 = u.pm * BM + wr * 64 + fr, col0 = u.pn * BM + wc * 32 + 8 * fq; const unsigned bo = (unsigned)(row0 * ldc + col0) * 4u;
        f32x4 ba[2][2][2], bb[2][2][2];
#define PG8_STRES(g) _Pragma("unroll") for (int mm = 0; mm < 2; ++mm) { const unsigned rb = PG8_ROWB(g, mm); \
            _Pragma("unroll") for (int bj = 0; bj < 2; ++bj) _Pragma("unroll") for (int n = 0; n < 2; ++n) *(f32x4*)((char*)out + (rb + (unsigned)(bj * HALF + 4 * n) * 4u)) = acc[(g) >> 1][bj][2 * ((g) & 1) + mm][n]; }
        PG8_LDRES(ba, 0) PG8_LDRES(bb, 1) PG8_EPI_SB(); PG8_ADDRES(ba, 0) PG8_EPI_SB(); PG8_LDRES(ba, 2) PG8_EPI_SB(); PG8_ADDRES(bb, 1) PG8_EPI_SB();
        PG8_STRES(0) PG8_STRES(1) PG8_EPI_SB(); PG8_LDRES(bb, 3) PG8_EPI_SB(); PG8_ADDRES(ba, 2) PG8_STRES(2) PG8_EPI_SB(); PG8_ADDRES(bb, 3) PG8_STRES(3)
#undef PG8_STRES
    }
};
struct EpiResNorm {
    static constexpr bool PERM = true, AFTER_DRAIN = false; static constexpr int MID_T = -1;
    const float* base; int ldc; bf16_t* XG; float* rowss;
    __device__ __forceinline__ void operator()(f32x4 (&acc)[2][2][4][2], const Unit& u, int wr, int wc, int fr, int fq) const {
        const int row0 = u.pm * BM + wr * 64 + fr, col0 = u.pn * BM + wc * 32 + 8 * fq; const unsigned bo = (unsigned)(row0 * ldc + col0) * 4u;
        f32x4 ba[2][2][2], bb[2][2][2];
#define PG8_STNORM(g) _Pragma("unroll") for (int mm = 0; mm < 2; ++mm) { const int m = 2 * ((g) & 1) + mm, row = row0 + ((g) >> 1) * HALF + m * 16; const unsigned rb = PG8_ROWB(g, mm); float ss = 0.f; \
            _Pragma("unroll") for (int bj = 0; bj < 2; ++bj) { const unsigned p = rb + (unsigned)(bj * HALF) * 4u; const f32x4 v0 = acc[(g) >> 1][bj][m][0], v1 = acc[(g) >> 1][bj][m][1]; \
                ss += ((v0[0] * v0[0] + v0[1] * v0[1]) + (v0[2] * v0[2] + v0[3] * v0[3])) + ((v1[0] * v1[0] + v1[1] * v1[1]) + (v1[2] * v1[2] + v1[3] * v1[3])); \
                u32x4 w; w.x = cvt_pk_bf16(v0[0], v0[1]); w.y = cvt_pk_bf16(v0[2], v0[3]); w.z = cvt_pk_bf16(v1[0], v1[1]); w.w = cvt_pk_bf16(v1[2], v1[3]); \
                *(u32x4*)((char*)XG + (p >> 1)) = w; } \
            ss += __shfl_xor(ss, 16); ss += __shfl_xor(ss, 32); \
            if (fq == 0) unsafeAtomicAdd(rowss + row, ss); }
        PG8_LDRES(ba, 0) PG8_LDRES(bb, 1) PG8_EPI_SB(); PG8_ADDRES(ba, 0) PG8_EPI_SB(); PG8_LDRES(ba, 2) PG8_EPI_SB(); PG8_ADDRES(bb, 1) PG8_EPI_SB();
        PG8_STNORM(0) PG8_STNORM(1) PG8_EPI_SB(); PG8_LDRES(bb, 3) PG8_EPI_SB(); PG8_ADDRES(ba, 2) PG8_STNORM(2) PG8_EPI_SB(); PG8_ADDRES(bb, 3) PG8_STNORM(3)
#undef PG8_STNORM
    }
};
#undef PG8_LDRES
#undef PG8_ADDRES
#undef PG8_ROWB
struct EpiResNormMid {
    static constexpr bool PERM = true, AFTER_DRAIN = false; static constexpr int MID_T = 24;
    const float* base; int ldc; bf16_t* XG; float* rowss; const float* rowss2; float inv_n2, eps;
    __device__ __forceinline__ void load_scale(const Unit& u, int wr, int fr, float (&rs)[2][4]) const {
        const unsigned rb = (unsigned)(u.pm * BM + wr * 64 + fr) * 4u;
#pragma unroll
        for (int ai = 0; ai < 2; ++ai)
#pragma unroll
            for (int m = 0; m < 4; ++m) rs[ai][m] = sqrtf(*(const float*)((const char*)rowss2 + (rb + (unsigned)(ai * HALF + m * 16) * 4u)) * inv_n2 + eps);
#pragma unroll
        for (int ai = 0; ai < 2; ++ai)
#pragma unroll
            for (int m = 0; m < 4; ++m) asm volatile("" : "+v"(rs[ai][m]));
    }
    __device__ __forceinline__ void operator()(f32x4 (&acc)[2][2][4][2], const Unit& u, int wr, int wc, int fr, int fq) const {
        float rs[2][4]; load_scale(u, wr, fr, rs);
#pragma unroll
        for (int ai = 0; ai < 2; ++ai)
#pragma unroll
            for (int m = 0; m < 4; ++m) { const float r = 1.0f / rs[ai][m];
#pragma unroll
                for (int bj = 0; bj < 2; ++bj)
#pragma unroll
                    for (int n = 0; n < 2; ++n) acc[ai][bj][m][n] *= r; }
        EpiResNorm{base, ldc, XG, rowss}(acc, u, wr, wc, fr, fq);
    }
};
struct EpiResBf16 {
    static constexpr bool PERM = true, AFTER_DRAIN = false; static constexpr int MID_T = -1;
    const bf16_t* resid; float* out; int ldc;
    __device__ __forceinline__ void operator()(f32x4 (&acc)[2][2][4][2], const Unit& u, int wr, int wc, int fr, int fq) const {
        const int row0 = u.pm * BM + wr * 64 + fr, col0 = u.pn * BM + wc * 32 + 8 * fq; const unsigned bo = (unsigned)(row0 * ldc + col0) * 4u;
        u32x4 rb[2][4][2];
#pragma unroll
        for (int ai = 0; ai < 2; ++ai)
#pragma unroll
            for (int m = 0; m < 4; ++m)
#pragma unroll
                for (int bj = 0; bj < 2; ++bj) rb[ai][m][bj] = *(const u32x4*)((const char*)resid + ((bo + (unsigned)((ai * HALF + m * 16) * ldc + bj * HALF) * 4u) >> 1));
        PG8_EPI_SB();
#pragma unroll
        for (int ai = 0; ai < 2; ++ai)
#pragma unroll
            for (int m = 0; m < 4; ++m)
#pragma unroll
                for (int bj = 0; bj < 2; ++bj) { const unsigned p = bo + (unsigned)((ai * HALF + m * 16) * ldc + bj * HALF) * 4u; const u32x4 w = rb[ai][m][bj];
                    f32x4 r0, r1; r0[0] = __uint_as_float(w.x << 16); r0[1] = __uint_as_float(w.x & 0xffff0000u); r0[2] = __uint_as_float(w.y << 16); r0[3] = __uint_as_float(w.y & 0xffff0000u);
                    r1[0] = __uint_as_float(w.z << 16); r1[1] = __uint_as_float(w.z & 0xffff0000u); r1[2] = __uint_as_float(w.w << 16); r1[3] = __uint_as_float(w.w & 0xffff0000u);
                    *(f32x4*)((char*)out + p) = r0 + acc[ai][bj][m][0]; *(f32x4*)((char*)out + (p + 16u)) = r1 + acc[ai][bj][m][1]; }
    }
};
typedef float f32x2 __attribute__((ext_vector_type(2)));
__device__ __forceinline__ f32x2 swiglu_pk(f32x2 g, f32x2 u, float rl, float r2) {
    const f32x2 t = g * rl; f32x2 e; e.x = __builtin_amdgcn_exp2f(t.x); e.y = __builtin_amdgcn_exp2f(t.y);
    const f32x2 d = e + 1.0f; f32x2 q; q.x = __builtin_amdgcn_rcpf(d.x); q.y = __builtin_amdgcn_rcpf(d.y);
    return (g * u) * (q * r2);
}
struct EpiSwiGLU {
    static constexpr bool PERM = true, AFTER_DRAIN = false; static constexpr int MID_T = -1;
    bf16_t* O; int ldc; const float* rowss; float inv_n, eps;
    __device__ __forceinline__ void operator()(const f32x4 (&acc)[2][2][4][2], const Unit& u, int wr, int wc, int fr, int fq) const {
        const int row0 = u.pm * BM + wr * 64 + fr, col0 = u.pn * HALF + wc * 32 + 8 * fq;
        float rs[2][4];
#pragma unroll
        for (int ai = 0; ai < 2; ++ai)
#pragma unroll
            for (int m = 0; m < 4; ++m) rs[ai][m] = rowss[row0 + ai * HALF + m * 16];
#pragma unroll
        for (int ai = 0; ai < 2; ++ai)
#pragma unroll
            for (int m = 0; m < 4; ++m) { const int row = row0 + ai * HALF + m * 16; bf16_t* rowp = O + (size_t)row * ldc + col0;
                const float r = 1.0f / sqrtf(rs[ai][m] * inv_n + eps), rl = -1.4426950408889634f * r, r2 = r * r;
                const f32x4 g0 = acc[ai][0][m][0], g1 = acc[ai][0][m][1], u0 = acc[ai][1][m][0], u1 = acc[ai][1][m][1];
                const f32x2 a = swiglu_pk((f32x2){g0[0], g0[1]}, (f32x2){u0[0], u0[1]}, rl, r2), b = swiglu_pk((f32x2){g0[2], g0[3]}, (f32x2){u0[2], u0[3]}, rl, r2);
                const f32x2 c = swiglu_pk((f32x2){g1[0], g1[1]}, (f32x2){u1[0], u1[1]}, rl, r2), d = swiglu_pk((f32x2){g1[2], g1[3]}, (f32x2){u1[2], u1[3]}, rl, r2);
                u32x4 w; w.x = cvt_pk_bf16(a.x, a.y); w.y = cvt_pk_bf16(b.x, b.y); w.z = cvt_pk_bf16(c.x, c.y); w.w = cvt_pk_bf16(d.x, d.y);
                *(u32x4*)rowp = w; }
    }
};

template <class Epi, class Sched, bool ALIGN_EPI = false, bool SP2 = false>
__device__ __forceinline__ void gemm_phase(const int tid, PG8_LAS unsigned char* lds, const Gemm g, const Sched& S, const Epi& E) {
    const int wid = __builtin_amdgcn_readfirstlane(tid >> 6), lane = tid & 63, wr = wid >> 2, wc = wid & 3, fr = lane & 15, fq = lane >> 4;
    const int K = g.K, nt = K / BK;
    unsigned voffA[2], voffB[2];
#pragma unroll
    for (int i = 0; i < 2; ++i) { int R, C; stage_rc(tid * 16 + i * 8192, R, C); const int Rb = Epi::PERM ? ((R & ~31) + perm32(R & 31)) : R;
        voffA[i] = (unsigned)(R * K + C) * 2u; voffB[i] = (unsigned)(Rb * K + C) * 2u; }
    const size_t kstep = (size_t)(BK * 2);
    const size_t hstep = (size_t)HALF * K * 2;
    const size_t tstep = 2 * hstep;
    const unsigned ldsw = (unsigned)wid * 1024u;
    const int aoff = lds_byte(wr * 64 + fr, fq * 8), boff = lds_byte(wc * 32 + fr, fq * 8);
#define PG8_SA(b, h) (((b) * 2 + (h)) * HTB)
#define PG8_SB(b, h) ((4 + (b) * 2 + (h)) * HTB)
#define PG8_STAGE(bufoff, gbase, voff) do { _Pragma("unroll") for (int _i = 0; _i < 2; ++_i) \
        __builtin_amdgcn_global_load_lds((const unsigned*)((const char*)(gbase) + (voff)[_i]), (PG8_LAS unsigned*)(lds + (bufoff) + ldsw + _i * 8192), 16, 0, 0); } while (0)
#define PG8_LDA(dst, b, h) do { _Pragma("unroll") for (int m = 0; m < 4; ++m) _Pragma("unroll") for (int k = 0; k < 2; ++k) dst[m][k] = *(const PG8_LAS bf16x8*)(lds + PG8_SA(b, h) + aoff + m * 2048 + k * 1024); } while (0)
#define PG8_LDB(dst, b, h) do { _Pragma("unroll") for (int n = 0; n < 2; ++n) _Pragma("unroll") for (int k = 0; k < 2; ++k) dst[n][k] = *(const PG8_LAS bf16x8*)(lds + PG8_SB(b, h) + boff + n * 2048 + k * 1024); } while (0)
#define PG8_MMA(ai, bj, At, Bt) do { __builtin_amdgcn_s_setprio(1); _Pragma("unroll") for (int m = 0; m < 4; ++m) _Pragma("unroll") for (int n = 0; n < 2; ++n) _Pragma("unroll") for (int k = 0; k < 2; ++k) \
        acc[ai][bj][m][n] = __builtin_amdgcn_mfma_f32_16x16x32_bf16(Bt[n][k], At[m][k], acc[ai][bj][m][n], 0, 0, 0); __builtin_amdgcn_s_setprio(0); } while (0)
#define PG8_WAIT_V(n) asm volatile("s_waitcnt vmcnt(" #n ")" ::: "memory")
#define PG8_WAIT_L(n) asm volatile("s_waitcnt lgkmcnt(" #n ")" ::: "memory")
#define PG8_BAR __builtin_amdgcn_s_barrier()
#define PG8_SCHED __builtin_amdgcn_sched_barrier(0)
    Unit cur, nxt; int ui = 0;
    if (!S.next(0, cur)) return;
    f32x4 acc[2][2][4][2];
#pragma unroll
    for (int a = 0; a < 2; ++a)
#pragma unroll
        for (int b = 0; b < 2; ++b)
#pragma unroll
            for (int m = 0; m < 4; ++m)
#pragma unroll
                for (int n = 0; n < 2; ++n) acc[a][b][m][n] = (f32x4){0.f, 0.f, 0.f, 0.f};
    bf16x8 At[4][2], B0[2][2], B1[2][2];
    const char* cA = (const char*)g.A + (size_t)cur.pm * tstep; const char* cB = (const char*)g.Bt + (size_t)cur.pn * tstep;
    S.a_ready(cur);
    if constexpr (SP2) {
        PG8_STAGE(PG8_SB(0, 0), cB, voffB); PG8_STAGE(PG8_SB(0, 1), cB + hstep, voffB); PG8_STAGE(PG8_SA(0, 0), cA, voffA); PG8_STAGE(PG8_SA(0, 1), cA + hstep, voffA);
        if (wr == 1) PG8_BAR;
        PG8_WAIT_V(2); PG8_BAR;
        PG8_STAGE(PG8_SB(1, 0), cB + kstep, voffB); PG8_STAGE(PG8_SA(1, 0), cA + kstep, voffA); PG8_STAGE(PG8_SB(1, 1), cB + hstep + kstep, voffB);
        PG8_WAIT_V(6); PG8_BAR;
    } else {
        PG8_STAGE(PG8_SB(0, 0), cB, voffB); PG8_STAGE(PG8_SA(0, 0), cA, voffA); PG8_STAGE(PG8_SB(0, 1), cB + hstep, voffB); PG8_STAGE(PG8_SA(0, 1), cA + hstep, voffA);
        if (wr == 1) PG8_BAR;
        PG8_WAIT_V(4); PG8_BAR;
        PG8_STAGE(PG8_SB(1, 0), cB + kstep, voffB); PG8_STAGE(PG8_SA(1, 0), cA + kstep, voffA); PG8_STAGE(PG8_SB(1, 1), cB + hstep + kstep, voffB);
        PG8_WAIT_V(6); PG8_BAR;
    }
    for (;;) {
        const bool has_next = S.next(ui + 1, nxt);
        const char* nA = has_next ? (const char*)g.A + (size_t)nxt.pm * tstep : cA; const char* nB = has_next ? (const char*)g.Bt + (size_t)nxt.pn * tstep : cB;
        for (int t = 0; t < nt; t += 2) {
            const bool last = (t == nt - 2);
            if constexpr (Epi::MID_T >= 0) { if (t == Epi::MID_T) { float rs[2][4]; E.load_scale(cur, wr, fr, rs);
                _Pragma("unroll") for (int a_ = 0; a_ < 2; ++a_) _Pragma("unroll") for (int m_ = 0; m_ < 4; ++m_) _Pragma("unroll") for (int b_ = 0; b_ < 2; ++b_) _Pragma("unroll") for (int n_ = 0; n_ < 2; ++n_) acc[a_][b_][m_][n_] *= rs[a_][m_]; } }
            const char* a1 = cA + (size_t)(t + 1) * kstep;
            const char* a2 = last ? nA : cA + (size_t)(t + 2) * kstep; const char* b2 = last ? nB : cB + (size_t)(t + 2) * kstep;
            const char* a3 = a2 + kstep; const char* b3 = b2 + kstep;
            if (last && has_next) S.a_ready(nxt);
            if constexpr (SP2) {
            PG8_LDB(B0, 0, 0); PG8_LDB(B1, 0, 1); PG8_SCHED; PG8_LDA(At, 0, 0); PG8_STAGE(PG8_SA(1, 1), a1 + hstep, voffA);
            PG8_WAIT_V(8); PG8_WAIT_L(0); PG8_BAR; PG8_MMA(0, 0, At, B0); PG8_MMA(0, 1, At, B1); PG8_BAR; PG8_SCHED;
            PG8_LDA(At, 0, 1); PG8_STAGE(PG8_SB(0, 0), b2, voffB); PG8_STAGE(PG8_SB(0, 1), b2 + hstep, voffB); PG8_STAGE(PG8_SA(0, 0), a2, voffA);
            PG8_WAIT_V(8); PG8_WAIT_L(0); PG8_BAR; PG8_MMA(1, 0, At, B0); PG8_MMA(1, 1, At, B1); PG8_BAR; PG8_SCHED;
            PG8_LDB(B0, 1, 0); PG8_LDB(B1, 1, 1); PG8_SCHED; PG8_LDA(At, 1, 0); PG8_STAGE(PG8_SA(0, 1), a2 + hstep, voffA);
            PG8_WAIT_V(8); PG8_WAIT_L(0); PG8_BAR; PG8_MMA(0, 0, At, B0); PG8_MMA(0, 1, At, B1); PG8_BAR; PG8_SCHED;
            PG8_LDA(At, 1, 1); PG8_STAGE(PG8_SB(1, 0), b3, voffB); PG8_STAGE(PG8_SB(1, 1), b3 + hstep, voffB); PG8_STAGE(PG8_SA(1, 0), a3, voffA);
            PG8_WAIT_V(8); PG8_WAIT_L(0); PG8_BAR; PG8_MMA(1, 0, At, B0); PG8_MMA(1, 1, At, B1); PG8_BAR; PG8_SCHED;
            } else {
            PG8_LDB(B0, 0, 0); PG8_SCHED; PG8_LDA(At, 0, 0); PG8_STAGE(PG8_SA(1, 1), a1 + hstep, voffA);
            PG8_WAIT_L(8); PG8_BAR; PG8_WAIT_L(0); PG8_MMA(0, 0, At, B0); PG8_BAR; PG8_SCHED;
            PG8_LDB(B1, 0, 1); PG8_STAGE(PG8_SB(0, 0), b2, voffB);
            PG8_BAR; PG8_WAIT_L(0); PG8_MMA(0, 1, At, B1); PG8_BAR;
            PG8_LDA(At, 0, 1); PG8_STAGE(PG8_SA(0, 0), a2, voffA);
            PG8_BAR; PG8_WAIT_L(0); PG8_MMA(1, 0, At, B0); PG8_BAR; PG8_SCHED;
            PG8_STAGE(PG8_SB(0, 1), b2 + hstep, voffB);
            PG8_WAIT_V(6); PG8_BAR; PG8_MMA(1, 1, At, B1); PG8_BAR;
            PG8_LDB(B0, 1, 0); PG8_SCHED; PG8_LDA(At, 1, 0); PG8_STAGE(PG8_SA(0, 1), a2 + hstep, voffA);
            PG8_WAIT_L(8); PG8_BAR; PG8_WAIT_L(0); PG8_MMA(0, 0, At, B0); PG8_BAR; PG8_SCHED;
            PG8_LDB(B1, 1, 1); PG8_STAGE(PG8_SB(1, 0), b3, voffB);
            PG8_BAR; PG8_WAIT_L(0); PG8_MMA(0, 1, At, B1); PG8_BAR;
            PG8_LDA(At, 1, 1); PG8_STAGE(PG8_SA(1, 0), a3, voffA);
            PG8_BAR; PG8_WAIT_L(0); PG8_MMA(1, 0, At, B0); PG8_BAR; PG8_SCHED;
            PG8_STAGE(PG8_SB(1, 1), b3 + hstep, voffB);
            PG8_WAIT_V(6); PG8_BAR; PG8_MMA(1, 1, At, B1); PG8_BAR;
            }
        }
        if constexpr (ALIGN_EPI) { if (wr == 0) PG8_BAR; }
        if constexpr (!Epi::AFTER_DRAIN) { E(acc, cur, wr, wc, fr, fq); S.done(cur); }
        if (!has_next) break;
#pragma unroll
        for (int a = 0; a < 2; ++a)
#pragma unroll
            for (int b = 0; b < 2; ++b)
#pragma unroll
                for (int m = 0; m < 4; ++m)
#pragma unroll
                    for (int n = 0; n < 2; ++n) acc[a][b][m][n] = (f32x4){0.f, 0.f, 0.f, 0.f};
        cur = nxt; cA = nA; cB = nB; ++ui;
        if constexpr (ALIGN_EPI) { if (wr == 1) PG8_BAR; }
    }
    PG8_WAIT_V(0);
    if constexpr (!ALIGN_EPI) { if (wr == 0) PG8_BAR; }
    PG8_BAR;
    if constexpr (Epi::AFTER_DRAIN) { E.fused(acc, cur, wr, wc, fr, fq, lds, wid, lane); S.done(cur); }
#undef PG8_SA
#undef PG8_SB
#undef PG8_STAGE
#undef PG8_LDA
#undef PG8_LDB
#undef PG8_MMA
#undef PG8_WAIT_V
#undef PG8_WAIT_L
#undef PG8_BAR
#undef PG8_SCHED
}
}
#include <hip/hip_bf16.h>
#include <cmath>
namespace attn_body {
using bf16=__hip_bfloat16;
using bf16x8=__attribute__((ext_vector_type(8)))short;
using s16x4=__attribute__((ext_vector_type(4)))short;
using f32x16=__attribute__((ext_vector_type(16)))float;
using u32x4=__attribute__((ext_vector_type(4)))unsigned;
constexpr int SEQ=2048,D=64,PQKV=5120,PO=2048;
constexpr int NW=8,QBLK=32,QB=QBLK*NW,KVBLK=64,NQB=SEQ/QB;
__device__ __forceinline__ int crow(int r,int hi){return (r&3)+8*(r>>2)+4*hi;}
#define SBAR() __builtin_amdgcn_sched_barrier(0)
__device__ __forceinline__ void cmask(f32x16&p0,f32x16&p1,int jb,int qrel,int hi){
  const float NEG=-INFINITY; int kb=64*jb+4*hi;
  #pragma unroll
  for(int r=0;r<16;++r){int kv=kb+(r&3)+8*(r>>2); if(kv>qrel)p0[r]=NEG; if(kv+32>qrel)p1[r]=NEG;}
}

constexpr int NSLOT=3, SLOTB=8192;
constexpr int LDS_K=0, LDS_V=NSLOT*SLOTB, LDS_WS=2*NSLOT*SLOTB, LDS_OST=LDS_WS+NW*64*4, LDS_V2=LDS_OST+NW*4096, LDS_BYTES=LDS_V2+NSLOT*SLOTB;
constexpr float C2=0.125f*1.4426950408889634f;
__device__ __forceinline__ void glds16s(const void*sbase,unsigned voff,unsigned lds_dst){unsigned keep;
  asm volatile("s_mov_b32 %0, m0\n\ts_mov_b32 m0, %3\n\ts_nop 0\n\tglobal_load_lds_dwordx4 %1, %2\n\ts_mov_b32 m0, %0":"=&s"(keep):"v"(voff),"s"(sbase),"s"(lds_dst):"memory");}
__device__ __forceinline__ void glds16(const void*gsrc,unsigned lds_dst){unsigned keep;
  asm volatile("s_mov_b32 %0, m0\n\ts_mov_b32 m0, %2\n\ts_nop 0\n\tglobal_load_lds_dwordx4 %1, off\n\ts_mov_b32 m0, %0":"=&s"(keep):"v"(gsrc),"s"(lds_dst):"memory");}
__device__ __forceinline__ float max3f(float a,float b,float c){float r;asm("v_max3_f32 %0, %1, %2, %3":"=v"(r):"v"(a),"v"(b),"v"(c));return r;}
__device__ __forceinline__ float max2f(float a,float b){float r;asm("v_max_f32_e32 %0, %1, %2":"=v"(r):"v"(a),"v"(b));return r;}
__device__ __forceinline__ float fadd_s(float a,float b){float r;asm("v_add_f32_e32 %0, %1, %2":"=v"(r):"v"(a),"v"(b));return r;}
__device__ __forceinline__ float fsub_s(float a,float b){float r;asm("v_sub_f32_e32 %0, %1, %2":"=v"(r):"v"(a),"v"(b));return r;}
typedef float f32x2_t __attribute__((ext_vector_type(2))); typedef __bf16 bf16x2_t __attribute__((ext_vector_type(2)));
__device__ __forceinline__ unsigned cvtpk_s(float lo,float hi){f32x2_t v={lo,hi};bf16x2_t b=__builtin_convertvector(v,bf16x2_t);return __builtin_bit_cast(unsigned,b);}
#define WAIT_BAR(N) asm volatile("s_waitcnt vmcnt(" #N ") lgkmcnt(0)\n\ts_barrier":::"memory")

__device__ __forceinline__ void qkt(f32x16&p0,f32x16&p1,const char*Kslot,const bf16x8*qr,const f32x16&negm,int r32,int hi){
  const char*kb=Kslot+hi*1024+r32*16;
  #pragma unroll
  for(int d0=0;d0<4;++d0){
    const bf16x8 b0=*reinterpret_cast<const bf16x8*>(kb+d0*2048);
    const bf16x8 b1=*reinterpret_cast<const bf16x8*>(kb+d0*2048+512);
    if(d0==0){p0=__builtin_amdgcn_mfma_f32_32x32x16_bf16(b0,qr[0],negm,0,0,0);p1=__builtin_amdgcn_mfma_f32_32x32x16_bf16(b1,qr[0],negm,0,0,0);}
    else{p0=__builtin_amdgcn_mfma_f32_32x32x16_bf16(b0,qr[d0],p0,0,0,0);p1=__builtin_amdgcn_mfma_f32_32x32x16_bf16(b1,qr[d0],p1,0,0,0);}}
}
typedef __attribute__((address_space(3))) const char* lds_cptr;
typedef short v4i16_t __attribute__((ext_vector_type(4)));
__device__ __forceinline__ void kload8(bf16x8*kf,lds_cptr kp){
  kf[0]=*(const __attribute__((address_space(3))) bf16x8*)(kp);      kf[1]=*(const __attribute__((address_space(3))) bf16x8*)(kp+512);
  kf[2]=*(const __attribute__((address_space(3))) bf16x8*)(kp+2048); kf[3]=*(const __attribute__((address_space(3))) bf16x8*)(kp+2560);
  kf[4]=*(const __attribute__((address_space(3))) bf16x8*)(kp+4096); kf[5]=*(const __attribute__((address_space(3))) bf16x8*)(kp+4608);
  kf[6]=*(const __attribute__((address_space(3))) bf16x8*)(kp+6144); kf[7]=*(const __attribute__((address_space(3))) bf16x8*)(kp+6656);
}
__device__ __forceinline__ void kload2(bf16x8*kf,lds_cptr kp,int j){ kf[2*j]=*(const __attribute__((address_space(3))) bf16x8*)(kp+j*2048); kf[2*j+1]=*(const __attribute__((address_space(3))) bf16x8*)(kp+j*2048+512); }
__device__ __forceinline__ s16x4 vtr(lds_cptr p){ return __builtin_bit_cast(s16x4,__builtin_amdgcn_ds_read_tr16_b64_v4i16((__attribute__((address_space(3))) v4i16_t*)p)); }
__device__ __forceinline__ float rowmax(const f32x16&p0,const f32x16&p1){
  float a=max3f(p0[0],p0[1],p1[0]),b=max3f(p0[2],p0[3],p1[1]);a=max3f(a,p1[2],p1[3]);
  #pragma unroll
  for(int r=4;r<16;r+=4){a=max3f(a,p0[r],p0[r+1]);b=max3f(b,p0[r+2],p0[r+3]);a=max3f(a,p1[r],p1[r+1]);b=max3f(b,p1[r+2],p1[r+3]);}
  const float m=max2f(a,b);
  auto rr=__builtin_amdgcn_permlane32_swap(__float_as_uint(m),__float_as_uint(m),false,false);
  return max2f(__uint_as_float(rr[0]),__uint_as_float(rr[1]));
}
__device__ __forceinline__ void pv(f32x16*o,int vb,bf16x8 pa0,bf16x8 pa1,bf16x8 pa2,bf16x8 pa3){
  #pragma unroll
  for(int d0=0;d0<2;++d0){s16x4 lo[4],hi[4];
    #pragma unroll
    for(int ks=0;ks<4;++ks){
      asm volatile("ds_read_b64_tr_b16 %0,%1 offset:%c2":"=&v"(lo[ks]):"v"(vb),"i"(d0*4096+ks*1024):"memory");
      asm volatile("ds_read_b64_tr_b16 %0,%1 offset:%c2":"=&v"(hi[ks]):"v"(vb),"i"(d0*4096+ks*1024+512):"memory");}
    asm volatile("s_waitcnt lgkmcnt(0)":::"memory");SBAR();
    #define PK(k) (bf16x8){lo[k][0],lo[k][1],lo[k][2],lo[k][3],hi[k][0],hi[k][1],hi[k][2],hi[k][3]}
    o[d0]=__builtin_amdgcn_mfma_f32_32x32x16_bf16(pa0,PK(0),o[d0],0,0,0);
    o[d0]=__builtin_amdgcn_mfma_f32_32x32x16_bf16(pa1,PK(1),o[d0],0,0,0);
    o[d0]=__builtin_amdgcn_mfma_f32_32x32x16_bf16(pa2,PK(2),o[d0],0,0,0);
    o[d0]=__builtin_amdgcn_mfma_f32_32x32x16_bf16(pa3,PK(3),o[d0],0,0,0);
    #undef PK
  }
}

#ifndef ATTN_STORE16
#define ATTN_STORE16(p,v) (*(u32x4*)(p)=(v))
#endif
typedef float f32x8a __attribute__((ext_vector_type(8))); typedef float f32x4a __attribute__((ext_vector_type(4)));
__device__ __forceinline__ f32x8a unpk8(u32x4 w){ f32x8a t; t[0]=__uint_as_float(w.x<<16); t[1]=__uint_as_float(w.x&0xffff0000u); t[2]=__uint_as_float(w.y<<16); t[3]=__uint_as_float(w.y&0xffff0000u);
  t[4]=__uint_as_float(w.z<<16); t[5]=__uint_as_float(w.z&0xffff0000u); t[6]=__uint_as_float(w.w<<16); t[7]=__uint_as_float(w.w&0xffff0000u); return t; }
template<int THRL,int MODE> __device__ __forceinline__ void attn_unit(int tid,int qb,const bf16*__restrict__ Qb,const bf16*__restrict__ Kh,const bf16*__restrict__ Vh,bf16*Ob,char*shm,const bf16*Ob0,float lam,const float*gsub,float dscale){
  const int lane=tid&63,r32=lane&31,hi=lane>>5; const int wid=__builtin_amdgcn_readfirstlane(tid>>6);
  const int q0=qb*QB;
  const bf16*Qw=Qb+(long)(q0+wid*QBLK)*PQKV;
  const unsigned lds0=(unsigned)(uintptr_t)shm;
  float*wsf=(float*)(shm+LDS_WS)+wid*64;
  const unsigned koff=(unsigned)(lane*PQKV+wid*8)*2u;
  const unsigned voff=(unsigned)((16*(wid&3)+(lane>>2))*PQKV+(wid>>2)*32+(lane&3)*8)*2u;
  const unsigned kdst=lds0+LDS_K+wid*1024, vdst=lds0+LDS_V+wid*1024, vdst2=lds0+LDS_V2+wid*1024;
  #define DMA_K(t,slot) glds16s(Kh+(long)(t)*KVBLK*PQKV,koff,(unsigned)__builtin_amdgcn_readfirstlane(kdst+(slot)))
  #define DMA_V(t,slot) do{ glds16s(Vh+(long)(t)*KVBLK*PQKV,voff,(unsigned)__builtin_amdgcn_readfirstlane(vdst+(slot))); glds16s(Vh+64+(long)(t)*KVBLK*PQKV,voff,(unsigned)__builtin_amdgcn_readfirstlane(vdst2+(slot))); }while(0)
  const int vb0=(int)(lds0+LDS_V)+((lane>>4)&1)*32+(lane&3)*8+(4*hi+((lane&15)>>2))*64;
  const char*Kbase=shm+LDS_K; bf16x8 kf[8];
  const lds_cptr shm3=(lds_cptr)shm; const lds_cptr kp0=shm3+LDS_K+hi*1024+r32*16; const lds_cptr vp0=shm3+LDS_V+((lane>>4)&1)*32+(lane&3)*8+(4*hi+((lane&15)>>2))*64;
  const int NT=(q0+QB)/KVBLK;
  DMA_K(0,0);DMA_V(0,0);DMA_K(1,SLOTB);
  bf16x8 qr[4];
  #pragma unroll
  for(int d0=0;d0<4;++d0)qr[d0]=*reinterpret_cast<const bf16x8*>(&Qw[(long)r32*PQKV+d0*16+hi*8]);
  float mhat=0.f,l_reg=0.f;float zz_=0.f;asm volatile("":"+v"(zz_));f32x16 o[4];f32x16 negm;
  _Pragma("unroll") for(int r=0;r<16;++r){o[0][r]=zz_;o[1][r]=zz_;o[2][r]=zz_;o[3][r]=zz_;negm[r]=zz_;} asm volatile("":"+v"(negm));
  const int qrel=wid*QBLK+r32;
  #define CMASK(P0,P1,t) do{int jb_=(t)-(NT-4); if(jb_>=0)cmask(P0,P1,jb_,qrel,hi);}while(0)
  bool resc=false;
  #define START(P0,P1) do{ const float rm=rowmax(P0,P1); resc=false; \
    { const float dl=rm; mhat=fadd_s(mhat,dl); \
      _Pragma("unroll") for(int r=0;r<16;++r){P0[r]=fsub_s(P0[r],dl);P1[r]=fsub_s(P1[r],dl);} \
      _Pragma("unroll") for(int r=0;r<16;++r)negm[r]=-mhat; asm volatile("":"+v"(negm)); } \
    _Pragma("unroll") for(int r=0;r<16;++r)P0[r]=__builtin_amdgcn_exp2f(P0[r]); }while(0)
  #define RESC() do{ if(resc){ asm volatile("s_waitcnt lgkmcnt(0)":::"memory"); \
      _Pragma("unroll") for(int d_=0;d_<4;++d_) _Pragma("unroll") for(int r=0;r<16;++r)o[d_][r]*=wsf[crow(r,hi)]; } }while(0)
  f32x16 pA0,pA1,pB0,pB1;
  int sl_prev=0,sl_cur=0,sl_next=SLOTB;
  #define ROT() do{sl_prev=sl_cur;sl_cur=sl_next;sl_next=(sl_next==(NSLOT-1)*SLOTB)?0:sl_next+SLOTB;}while(0)
  DMA_K(2,2*SLOTB);
  WAIT_BAR(4);
  qkt(pA0,pA1,Kbase,qr,negm,r32,hi);asm volatile("s_nop 15\n\ts_nop 7":"+v"(pA0),"+v"(pA1));CMASK(pA0,pA1,0);
  START(pA0,pA1);
  _Pragma("unroll") for(int r=0;r<16;++r)pA1[r]=__builtin_amdgcn_exp2f(pA1[r]);
  WAIT_BAR(0);
  DMA_K(3,0);DMA_V(1,SLOTB);
  ROT();
  kload8(kf,kp0+sl_cur);
  WAIT_BAR(3);
  s16x4 vlo[8],vhi[8]; u32x4 pw0,pw1,pw2,pw3;
  #define PKW(P,B) cvtpk_s(P[B],P[B+1])
  #define PAF(k) __builtin_bit_cast(bf16x8,pw##k)
  #define VFR(i) (bf16x8){vlo[i][0],vlo[i][1],vlo[i][2],vlo[i][3],vhi[i][0],vhi[i][1],vhi[i][2],vhi[i][3]}
  #define PIN(x) asm volatile("":"+v"(x))
  #define MX3(a,b,c) __builtin_fmaxf(__builtin_fmaxf((a),(b)),(c))
  #define GAPA(MF,A0,A1,A2,A3,W0,W1,PW) do{ MF; sacc+=A0; sacc+=A1; sacc+=A2; sacc+=A3; PIN(sacc); W0; W1; PIN(PW); SBAR(); }while(0)
  #define EX(v) __builtin_amdgcn_exp2f(v)
  #define GAPB(MF,X,B) do{ MF; X[B]=EX(X[B]); X[B+1]=EX(X[B+1]); X[B+2]=EX(X[B+2]); X[B+3]=EX(X[B+3]); PIN(X); SBAR(); }while(0)
  #define VRD(i) do{ vlo[i]=vtr(vp_+(((i)>>2)*4096+((i)&3)*1024)); vhi[i]=vtr(vp_+(((i)>>2)*4096+((i)&3)*1024+512)); }while(0)
  #define KRD(G,j) do{ if(G){ kload2(kf,kp0+sl_next,j); SBAR(); } }while(0)
  #define STEP(C0,C1,P0,P1,t,GK,GV,GL) do{ SBAR(); \
    const lds_cptr vp_=vp0+sl_prev; \
    VRD(0); SBAR(); float sacc=(P0[0]+P0[1]); \
    GAPA(C0=__builtin_amdgcn_mfma_f32_32x32x16_bf16(kf[0],qr[0],negm,0,0,0), P0[2],P0[3],P0[4],P0[5],     pw0[0]=PKW(P0,0), pw0[1]=PKW(P0,2), pw0); \
    VRD(4); SBAR(); GAPA(C1=__builtin_amdgcn_mfma_f32_32x32x16_bf16(kf[1],qr[0],negm,0,0,0), P0[6],P0[7],P0[8],P0[9],     pw0[2]=PKW(P0,4), pw0[3]=PKW(P0,6), pw0); \
    VRD(1); SBAR(); GAPA(C0=__builtin_amdgcn_mfma_f32_32x32x16_bf16(kf[2],qr[1],C0,0,0,0),   P0[10],P0[11],P0[12],P0[13], pw1[0]=PKW(P0,8), pw1[1]=PKW(P0,10), pw1); \
    VRD(5); SBAR(); GAPA(C1=__builtin_amdgcn_mfma_f32_32x32x16_bf16(kf[3],qr[1],C1,0,0,0),   P0[14],P0[15],P1[0],P1[1],   pw1[2]=PKW(P0,12),pw1[3]=PKW(P0,14), pw1); \
    VRD(2); SBAR(); GAPA(C0=__builtin_amdgcn_mfma_f32_32x32x16_bf16(kf[4],qr[2],C0,0,0,0),   P1[2],P1[3],P1[4],P1[5],     pw2[0]=PKW(P1,0), pw2[1]=PKW(P1,2), pw2); \
    VRD(6); SBAR(); GAPA(C1=__builtin_amdgcn_mfma_f32_32x32x16_bf16(kf[5],qr[2],C1,0,0,0),   P1[6],P1[7],P1[8],P1[9],     pw2[2]=PKW(P1,4), pw2[3]=PKW(P1,6), pw2); \
    VRD(3); SBAR(); GAPA(C0=__builtin_amdgcn_mfma_f32_32x32x16_bf16(kf[6],qr[3],C0,0,0,0),   P1[10],P1[11],P1[12],P1[13], pw3[0]=PKW(P1,8), pw3[1]=PKW(P1,10), pw3); \
    VRD(7); SBAR(); GAPA(C1=__builtin_amdgcn_mfma_f32_32x32x16_bf16(kf[7],qr[3],C1,0,0,0),   P1[14],P1[15],0.f,0.f,       pw3[2]=PKW(P1,12),pw3[3]=PKW(P1,14), pw3); \
    l_reg+=sacc; \
    if(GK){DMA_K((t)+3,sl_cur);} if(GV){DMA_V((t)+1,sl_next);} \
    CMASK(C0,C1,t); \
    { float a=MX3(C0[0],C0[1],C1[0]),b=MX3(C0[2],C0[3],C1[1]); a=MX3(a,C1[2],C1[3]); \
      _Pragma("unroll") for(int r=4;r<16;r+=4){a=MX3(a,C0[r],C0[r+1]);b=MX3(b,C0[r+2],C0[r+3]);a=MX3(a,C1[r],C1[r+1]);b=MX3(b,C1[r+2],C1[r+3]);} \
      float rm=__builtin_fmaxf(a,b); { auto rr=__builtin_amdgcn_permlane32_swap(__float_as_uint(rm),__float_as_uint(rm),false,false); rm=__builtin_fmaxf(__uint_as_float(rr[0]),__uint_as_float(rr[1])); } \
      resc=false; \
      if(__builtin_expect(__any(rm>(float)THRL),0)){ const float dl=__builtin_fmaxf(rm,0.f); mhat+=dl; \
        _Pragma("unroll") for(int r=0;r<16;++r){C0[r]-=dl;C1[r]-=dl;} \
        _Pragma("unroll") for(int r=0;r<16;++r)negm[r]=-mhat; asm volatile("":"+v"(negm)); \
        const float f=__builtin_amdgcn_exp2f(-dl); l_reg*=f; if(hi==0)wsf[r32]=f; resc=true; } } \
    SBAR(); \
    GAPB(o[0]=__builtin_amdgcn_mfma_f32_32x32x16_bf16(PAF(0),VFR(0),o[0],0,0,0), C0,0); \
    GAPB(o[1]=__builtin_amdgcn_mfma_f32_32x32x16_bf16(PAF(0),VFR(4),o[1],0,0,0), C0,4); \
    KRD(GL,0); GAPB(o[0]=__builtin_amdgcn_mfma_f32_32x32x16_bf16(PAF(1),VFR(1),o[0],0,0,0), C0,8); \
    KRD(GL,1); GAPB(o[1]=__builtin_amdgcn_mfma_f32_32x32x16_bf16(PAF(1),VFR(5),o[1],0,0,0), C0,12); \
    KRD(GL,2); GAPB(o[0]=__builtin_amdgcn_mfma_f32_32x32x16_bf16(PAF(2),VFR(2),o[0],0,0,0), C1,0); \
    KRD(GL,3); GAPB(o[1]=__builtin_amdgcn_mfma_f32_32x32x16_bf16(PAF(2),VFR(6),o[1],0,0,0), C1,4); \
    GAPB(o[0]=__builtin_amdgcn_mfma_f32_32x32x16_bf16(PAF(3),VFR(3),o[0],0,0,0), C1,8); \
    GAPB(o[1]=__builtin_amdgcn_mfma_f32_32x32x16_bf16(PAF(3),VFR(7),o[1],0,0,0), C1,12); \
    pv(o+2,vb0+(LDS_V2-LDS_V)+sl_prev,PAF(0),PAF(1),PAF(2),PAF(3));   \
    }while(0)
  int t=1;
  #undef CMASK
  #define CMASK(P0,P1,t) do{}while(0)
  for(;t+5<NT;t+=2){
    STEP(pB0,pB1,pA0,pA1,t,true,true,true);     WAIT_BAR(3); RESC(); ROT();
    STEP(pA0,pA1,pB0,pB1,t+1,true,true,true);   WAIT_BAR(3); RESC(); ROT();
  }
  #undef CMASK
  #define CMASK(P0,P1,t) do{int jb_=(t)-(NT-4); if(jb_>=0)cmask(P0,P1,jb_,qrel,hi);}while(0)
  #define ENDW(tt) do{ if((tt)+3<NT){WAIT_BAR(3);} else if((tt)+2<NT){WAIT_BAR(2);} else {WAIT_BAR(0);} }while(0)
  for(;t+1<NT;t+=2){
    STEP(pB0,pB1,pA0,pA1,t,(t+3<NT),(t+1<NT),(t+1<NT));       ENDW(t);   RESC(); ROT();
    STEP(pA0,pA1,pB0,pB1,t+1,(t+4<NT),(t+2<NT),(t+2<NT));     ENDW(t+1); RESC(); ROT();
  }
  STEP(pB0,pB1,pA0,pA1,NT-1,false,false,false); RESC();
  { float sacc=pB0[0]+pB0[1]; _Pragma("unroll") for(int r=2;r<16;++r)sacc+=pB0[r]; _Pragma("unroll") for(int r=0;r<16;++r)sacc+=pB1[r]; l_reg+=sacc;
    pw0=(u32x4){PKW(pB0,0),PKW(pB0,2),PKW(pB0,4),PKW(pB0,6)};pw1=(u32x4){PKW(pB0,8),PKW(pB0,10),PKW(pB0,12),PKW(pB0,14)};pw2=(u32x4){PKW(pB1,0),PKW(pB1,2),PKW(pB1,4),PKW(pB1,6)};pw3=(u32x4){PKW(pB1,8),PKW(pB1,10),PKW(pB1,12),PKW(pB1,14)};
    SBAR(); pv(o,vb0+sl_cur,PAF(0),PAF(1),PAF(2),PAF(3)); pv(o+2,vb0+(LDS_V2-LDS_V)+sl_cur,PAF(0),PAF(1),PAF(2),PAF(3)); }
  #undef PKW
  #undef PAF
  #undef VFR
  #undef PIN
  #undef MX3
  #undef GAPA
  #undef GAPB
  #undef EX
  #undef VRD
  #undef KRD
  #undef STEP
  #undef ENDW
  {auto rr=__builtin_amdgcn_permlane32_swap(__float_as_uint(l_reg),__float_as_uint(l_reg),false,false);l_reg=__uint_as_float(rr[0])+__uint_as_float(rr[1]);}
  if(hi==0)wsf[32+r32]=l_reg;asm volatile("s_waitcnt lgkmcnt(0)":::"memory");
  float rli[16];
  #pragma unroll
  for(int r=0;r<16;++r)rli[r]=__builtin_amdgcn_rcpf(wsf[32+crow(r,hi)]);
  bf16*Ow=Ob+(long)(q0+wid*QBLK)*PO;
  { bf16*stg=(bf16*)(shm+LDS_OST)+wid*2048;
    f32x8a dd[2][4];
    #pragma unroll
    for(int ph=0;ph<2;++ph){
      #pragma unroll
      for(int r=0;r<16;++r){const int orow=crow(r,hi);
        #pragma unroll
        for(int d0=0;d0<2;++d0)stg[orow*64+d0*32+r32]=__float2bfloat16(o[2*ph+d0][r]*rli[r]);}
      asm volatile("s_waitcnt lgkmcnt(0)":::"memory");
      #pragma unroll
      for(int i=0;i<4;++i){const int row=i*8+(lane>>3),ch=lane&7; const u32x4 v=*(const u32x4*)(stg+row*64+ch*8);
        if constexpr(MODE==0){ ATTN_STORE16(Ow+(long)row*PO+ph*64+ch*8,v); }
        else { const u32x4 w0=__builtin_nontemporal_load((const u32x4*)(Ob0+(long)(q0+wid*QBLK+row)*PO+ph*64+ch*8)); dd[ph][i]=unpk8(w0)-unpk8(v)*lam; } }
      asm volatile("s_waitcnt lgkmcnt(0)":::"memory"); }
    if constexpr(MODE==1){
      #pragma unroll
      for(int i=0;i<4;++i){const int row=i*8+(lane>>3),ch=lane&7; float ss=0.f;
        #pragma unroll
        for(int ph=0;ph<2;++ph){ _Pragma("unroll") for(int k=0;k<8;++k)ss+=dd[ph][i][k]*dd[ph][i][k]; }
        ss+=__shfl_xor(ss,1);ss+=__shfl_xor(ss,2);ss+=__shfl_xor(ss,4);
        const float rr=dscale/sqrtf(ss*(1.f/128.f)+1e-6f);
        #pragma unroll
        for(int ph=0;ph<2;++ph){ const float*gp=gsub+ph*64+ch*8; const f32x4a ga=*(const f32x4a*)gp, gb=*(const f32x4a*)(gp+4);
          const f32x8a d=dd[ph][i]*rr; u32x4 w; w.x=cvtpk_s(d[0]*ga[0],d[1]*ga[1]); w.y=cvtpk_s(d[2]*ga[2],d[3]*ga[3]); w.z=cvtpk_s(d[4]*gb[0],d[5]*gb[1]); w.w=cvtpk_s(d[6]*gb[2],d[7]*gb[3]);
          ATTN_STORE16(Ow+(long)row*PO+ph*64+ch*8,w); } } } }
  asm volatile("s_waitcnt lgkmcnt(0)\n\ts_barrier":::"memory");
  #undef DMA_K
  #undef DMA_V
  #undef CMASK
  #undef START
  #undef RESC
  #undef ROT
}
#undef SBAR
#undef WAIT_BAR
}
#define GAS __attribute__((address_space(1)))
#define LAS __attribute__((address_space(3)))
typedef unsigned short bfu;
typedef unsigned v4u __attribute__((ext_vector_type(4)));
typedef unsigned v2u __attribute__((ext_vector_type(2)));
typedef float f32x4 __attribute__((ext_vector_type(4)));
typedef float f32x8 __attribute__((ext_vector_type(8)));
typedef float f32x16 __attribute__((ext_vector_type(16)));
typedef short bf16x8 __attribute__((ext_vector_type(8)));
typedef short s16x4 __attribute__((ext_vector_type(4)));

constexpr int NWAVES = 8;
constexpr int NB = 8, SEQL = 2048, DMODEL = 2048, MTOK = NB * SEQL, MEML = 256, MROWS = NB * MEML;
constexpr int NIN = 5120, NKV = 1024, FFH = 5632, NGU = 2 * FFH;
constexpr int C_U = 0, C_C = 512, C_B = 1024, C_Q = 1536, C_K = 2560, C_V = 3584, C_QM = 4608;
constexpr float EPS = 1e-6f;
constexpr float LOG2E = 1.4426950408889634f;
constexpr float C2Q = 0.125f * LOG2E;
constexpr float C2M = 0.08838834764831845f * LOG2E;
constexpr float LAM_INIT = 0.2f;

constexpr size_t MiB = 1u << 20;
constexpr size_t WS_BAR = 0, BAR_ZERO_BYTES = 16384;
constexpr size_t WS_ROWSS2 = 65536 + 262144;
constexpr size_t WS_ROWSS = 65536;
constexpr size_t WS_WIN = 2 * MiB, WS_WKV = 22 * MiB, WS_WO = 26 * MiB, WS_WGU = 34 * MiB, WS_WD = 78 * MiB;
constexpr size_t WS_HB = 100 * MiB, WS_MEMN = 164 * MiB, WS_KVM = 172 * MiB, WS_VMT = 176 * MiB;
constexpr size_t WS_PROJ = 178 * MiB, WS_ODIFF = 338 * MiB, WS_MIXED = 402 * MiB, WS_OMEM = 466 * MiB, WS_END = 482 * MiB;
constexpr size_t WS_ACT = WS_PROJ;
static_assert(WS_ACT + (size_t)MTOK * FFH * 2 <= WS_MIXED, "act overlay");

constexpr int LDS_BARST = 147456 - 64;
constexpr int LDS_BYTES = 147456;

#define LDS_WAIT() asm volatile("s_waitcnt lgkmcnt(0)" ::: "memory")
__device__ __forceinline__ unsigned f2bf(float f) { unsigned u = __builtin_bit_cast(unsigned, f); return (u + 0x7fffu + ((u >> 16) & 1u)) >> 16; }
__device__ __forceinline__ unsigned pk2(float lo, float hi) { return f2bf(lo) | (f2bf(hi) << 16); }
__device__ __forceinline__ float bf_lo(unsigned w) { return __builtin_bit_cast(float, w << 16); }
__device__ __forceinline__ float bf_hi(unsigned w) { return __builtin_bit_cast(float, w & 0xffff0000u); }
__device__ __forceinline__ f32x8 unpack8(v4u w) { f32x8 t; t[0] = bf_lo(w.x); t[1] = bf_hi(w.x); t[2] = bf_lo(w.y); t[3] = bf_hi(w.y); t[4] = bf_lo(w.z); t[5] = bf_hi(w.z); t[6] = bf_lo(w.w); t[7] = bf_hi(w.w); return t; }
__device__ __forceinline__ v4u pack8(f32x8 t) { v4u w; w.x = pk2(t[0], t[1]); w.y = pk2(t[2], t[3]); w.z = pk2(t[4], t[5]); w.w = pk2(t[6], t[7]); return w; }
__device__ __forceinline__ f32x8 ld8f(const float* p) { const f32x4 a = *(const f32x4*)p, b = *(const f32x4*)(p + 4); f32x8 t; t[0] = a.x; t[1] = a.y; t[2] = a.z; t[3] = a.w; t[4] = b.x; t[5] = b.y; t[6] = b.z; t[7] = b.w; return t; }
__device__ __forceinline__ float sumsq8(f32x8 t) { return ((t[0] * t[0] + t[1] * t[1]) + (t[2] * t[2] + t[3] * t[3])) + ((t[4] * t[4] + t[5] * t[5]) + (t[6] * t[6] + t[7] * t[7])); }
__device__ __forceinline__ float wave_sum(float v) {
#pragma unroll
    for (int o = 1; o < 64; o <<= 1) v += __shfl_xor(v, o);
    return v;
}
__device__ __forceinline__ float rsq(float v) { return 1.0f / sqrtf(v); }

__device__ __forceinline__ void p0_transpose_item(const float* W, int K, int N, bfu* WT, int mode, const float* gk, LAS float* scr, int item, int lane) {
    const int nblk = N / 32, kb = item / nblk, nb = item % nblk, k0 = 64 * kb, n0 = 32 * nb;
    const int r0 = (mode == 0) ? n0 : (mode == 3) ? (256 * (n0 >> 8) + 128 * ((n0 >> 5) & 1) + 32 * ((n0 >> 6) & 3)) : (256 * (n0 >> 7) + (mode == 2 ? 128 : 0) + (n0 & 127));
#pragma unroll 8
    for (int i = 0; i < 32; ++i) { const int kk = 2 * i + (lane >> 5); scr[kk * 33 + (lane & 31)] = __builtin_nontemporal_load(W + (size_t)(k0 + kk) * N + n0 + (lane & 31)); }
    LDS_WAIT(); asm volatile("" ::: "memory");
    const int c = lane & 7;
    f32x8 gg; if (gk) gg = ld8f(gk + k0 + 8 * c); else { _Pragma("unroll") for (int i = 0; i < 8; ++i) gg[i] = 1.0f; }
    const bool pairperm = MK_FUSE_PREP && mode == 3 && n0 >= C_Q && n0 < C_V && ((n0 >> 5) & 1) == 0;
#pragma unroll
    for (int j = 0; j < 4; ++j) { const int n = (lane >> 3) + 8 * j; const LAS float* s = scr + (8 * c) * 33 + n;
        v4u o; o.x = pk2(s[0 * 33] * gg[0], s[1 * 33] * gg[1]); o.y = pk2(s[2 * 33] * gg[2], s[3 * 33] * gg[3]); o.z = pk2(s[4 * 33] * gg[4], s[5 * 33] * gg[5]); o.w = pk2(s[6 * 33] * gg[6], s[7 * 33] * gg[7]);
        const int nd = (pairperm && n < 16) ? (8 * ((n >> 2) & 1) + 4 * (n >> 3) + (n & 3)) : n;
        *(v4u*)(WT + (size_t)(r0 + nd) * K + k0 + 8 * c) = o; }
    LDS_WAIT(); asm volatile("" ::: "memory");
}
__device__ __forceinline__ void rms_row_to_bf16(const float* xrow, const float* g, bfu* orow, int lane) {
    const f32x4* xr = (const f32x4*)xrow + lane; const f32x4* gr = (const f32x4*)g + lane;
    f32x4 v[8]; float s = 0.f;
#pragma unroll
    for (int j = 0; j < 8; ++j) { v[j] = __builtin_nontemporal_load(xr + 64 * j); s += (v[j].x * v[j].x + v[j].y * v[j].y) + (v[j].z * v[j].z + v[j].w * v[j].w); }
    const float r = rsq(wave_sum(s) * (1.f / DMODEL) + EPS);
    unsigned long long* o8 = (unsigned long long*)orow + lane;
#pragma unroll
    for (int j = 0; j < 8; ++j) { const f32x4 gg = gr[64 * j]; const f32x4 o = v[j] * r * gg;
        o8[64 * j] = (unsigned long long)pk2(o.x, o.y) | ((unsigned long long)pk2(o.z, o.w) << 32); }
}

__device__ __forceinline__ void prep_phase(bfu* PROJ, bfu* DST, int dmask, const int* positions, const float* g_dq, const float* g_dk, const float* g_mq, int gw, int NGW, int lane) {
    const int sub = lane & 7;
    const f32x8 gq = ld8f(g_dq + 8 * sub), gk = ld8f(g_dk + 8 * sub), gmq = ld8f(g_mq + 8 * (lane & 15));
    constexpr double I2PI = 0.15915494309189535;
    constexpr double IF0 = 1.0 * I2PI, IF1 = 0.19392274474868576 * I2PI, IF2 = 0.03760603093086393 * I2PI, IF3 = 0.007292664737217109 * I2PI,
                     IF4 = 0.001414213562373095 * I2PI, IF5 = 0.0002742481756762073 * I2PI, IF6 = 5.318295896944988e-05 * I2PI, IF7 = 1.031338537721246e-05 * I2PI;
    v4u nx[5]; int npos = 0;
#define PREP_LOAD(mm) { const bfu* pr_ = PROJ + (size_t)(mm) * NIN; _Pragma("unroll") for (int s_ = 0; s_ < 4; ++s_) nx[s_] = *(const v4u*)(pr_ + C_Q + s_ * 512 + lane * 8); nx[4] = *(const v4u*)(pr_ + C_QM + lane * 8); npos = positions[mm]; }
    if (gw < MTOK) PREP_LOAD(gw)
    for (int m = gw; m < MTOK; m += NGW) {
        bfu* drow = DST + (size_t)(m & dmask) * NIN;
        v4u cu[5];
#pragma unroll
        for (int s_ = 0; s_ < 5; ++s_) cu[s_] = nx[s_];
        const double pos = (double)npos;
        if (m + NGW < MTOK) PREP_LOAD(m + NGW)
        f32x8 cs, sn;
#define ROPE_J(j, IFJ) { double rev = pos * (IFJ); rev -= __builtin_rint(rev); const float fr = (float)rev; cs[j] = __builtin_amdgcn_cosf(fr); sn[j] = __builtin_amdgcn_sinf(fr); }
        ROPE_J(0, IF0) ROPE_J(1, IF1) ROPE_J(2, IF2) ROPE_J(3, IF3) ROPE_J(4, IF4) ROPE_J(5, IF5) ROPE_J(6, IF6) ROPE_J(7, IF7)
#undef ROPE_J
#pragma unroll
        for (int st = 0; st < 4; ++st) {
            f32x8 t = unpack8(cu[st]);
            float ss = sumsq8(t); ss += __shfl_xor(ss, 1); ss += __shfl_xor(ss, 2); ss += __shfl_xor(ss, 4);
            const float r = rsq(ss * (1.f / 64.f) + EPS);
            const f32x8 g = (st < 2) ? gq : gk;
#pragma unroll
            for (int i = 0; i < 8; ++i) t[i] = t[i] * r * g[i];
            f32x8 o;
#pragma unroll
            for (int i = 0; i < 8; ++i) { const float other = __shfl_xor(t[i], 1);
                o[i] = (sub == 0) ? (t[i] * cs[i] - other * sn[i]) : ((sub == 1) ? (t[i] * cs[i] + other * sn[i]) : t[i]); }
            if (st < 2) {
#pragma unroll
                for (int i = 0; i < 8; ++i) o[i] *= C2Q;
            }
            *(v4u*)(drow + C_Q + st * 512 + lane * 8) = pack8(o);
        }
        {
            f32x8 t = unpack8(cu[4]);
            float ss = sumsq8(t); ss += __shfl_xor(ss, 1); ss += __shfl_xor(ss, 2); ss += __shfl_xor(ss, 4); ss += __shfl_xor(ss, 8);
            const float r = rsq(ss * (1.f / 128.f) + EPS) * C2M;
#pragma unroll
            for (int i = 0; i < 8; ++i) t[i] = t[i] * r * gmq[i];
            *(v4u*)(drow + C_QM + lane * 8) = pack8(t);
        }
    }
#undef PREP_LOAD
}

namespace memattn {
constexpr int KSTR = 272, VSTR = 520;
constexpr int LDS_KM = 0, LDS_VT = MEML * KSTR, LDS_TOTAL = LDS_VT + 128 * VSTR;
static_assert(LDS_TOTAL <= LDS_BYTES, "mem-attn LDS");
__device__ __forceinline__ int crow(int r, int hi) { return (r & 3) + 8 * (r >> 2) + 4 * hi; }
__device__ __forceinline__ unsigned cvtpk(float lo, float hi) { typedef float f2 __attribute__((ext_vector_type(2))); typedef __bf16 b2 __attribute__((ext_vector_type(2))); f2 v = {lo, hi}; b2 b = __builtin_convertvector(v, b2); return __builtin_bit_cast(unsigned, b); }
__device__ __forceinline__ bf16x8 pack_half(const f32x16& p, int s) { v4u w; w.x = cvtpk(p[8 * s], p[8 * s + 1]); w.y = cvtpk(p[8 * s + 2], p[8 * s + 3]); w.z = cvtpk(p[8 * s + 4], p[8 * s + 5]); w.w = cvtpk(p[8 * s + 6], p[8 * s + 7]); return __builtin_bit_cast(bf16x8, w); }
__device__ __forceinline__ void mem_unit(int tid, int b, int h, int qblk, const bfu* PROJ, const bfu* KVM, const float* g_mk, const float* g_mq, bfu* MIXED, float* rowss2, LAS unsigned char* lds) {
    const int lane = tid & 63, r32 = lane & 31, hi = lane >> 5; const int wid = __builtin_amdgcn_readfirstlane(tid >> 6);
    { const f32x8 gmk = ld8f(g_mk + 8 * (tid & 15));
#pragma unroll
      for (int i = 0; i < 8; ++i) { const int c = tid + 512 * i, kv = c >> 4, ch = c & 15;
        f32x8 t = unpack8(*(const v4u*)(KVM + (size_t)(b * MEML + kv) * NKV + h * 128 + ch * 8));
        float ss = sumsq8(t); ss += __shfl_xor(ss, 1); ss += __shfl_xor(ss, 2); ss += __shfl_xor(ss, 4); ss += __shfl_xor(ss, 8);
        const float r = rsq(ss * (1.f / 128.f) + EPS);
        t = t * r * gmk;
        *(LAS v4u*)(lds + LDS_KM + kv * KSTR + ch * 16) = pack8(t); } }
#pragma unroll
    for (int i = 0; i < 8; ++i) { const int c = tid + 512 * i, kv = c & 255, ch = c >> 8;
        const v4u w = *(const v4u*)(KVM + (size_t)(b * MEML + kv) * NKV + 512 + h * 128 + ch * 8);
        LAS bfu* dst = (LAS bfu*)(lds + LDS_VT + (ch * 8) * VSTR + kv * 2);
        dst[0 * (VSTR / 2)] = (bfu)(w.x & 0xffffu); dst[1 * (VSTR / 2)] = (bfu)(w.x >> 16); dst[2 * (VSTR / 2)] = (bfu)(w.y & 0xffffu); dst[3 * (VSTR / 2)] = (bfu)(w.y >> 16);
        dst[4 * (VSTR / 2)] = (bfu)(w.z & 0xffffu); dst[5 * (VSTR / 2)] = (bfu)(w.z >> 16); dst[6 * (VSTR / 2)] = (bfu)(w.w & 0xffffu); dst[7 * (VSTR / 2)] = (bfu)(w.w >> 16); }
    __syncthreads();
    const size_t row = (size_t)b * SEQL + qblk * 256 + wid * 32 + r32;
    const bfu* qrow = PROJ + row * NIN + C_QM + h * 128 + hi * 8;
    bf16x8 qf[8];
#pragma unroll
    for (int d0 = 0; d0 < 8; ++d0) qf[d0] = *(const bf16x8*)(qrow + d0 * 16);
#if MK_FUSE_PREP
    {
        float ss = 0.f;
#pragma unroll
        for (int d0 = 0; d0 < 8; ++d0) ss += sumsq8(unpack8(__builtin_bit_cast(v4u, qf[d0])));
        ss += __shfl_xor(ss, 32);
        const float r = rsq(ss * (1.f / 128.f) + EPS) * C2M;
#pragma unroll
        for (int d0 = 0; d0 < 8; ++d0) { f32x8 t = unpack8(__builtin_bit_cast(v4u, qf[d0])); const f32x8 g = ld8f(g_mq + d0 * 16 + hi * 8); t = t * r * g; qf[d0] = __builtin_bit_cast(bf16x8, pack8(t)); }
    }
#endif
    f32x16 oT[4];
#pragma unroll
    for (int dt = 0; dt < 4; ++dt)
#pragma unroll
        for (int r = 0; r < 16; ++r) oT[dt][r] = 0.f;
    float mrun = -1e30f, l = 0.f;
#pragma unroll 1
    for (int kc = 0; kc < 4; ++kc) {
        f32x16 p0, p1;
#pragma unroll
        for (int r = 0; r < 16; ++r) { p0[r] = 0.f; p1[r] = 0.f; }
        const LAS unsigned char* kb = lds + LDS_KM + (kc * 64 + r32) * KSTR + hi * 16;
#pragma unroll
        for (int d0 = 0; d0 < 8; ++d0) { const bf16x8 a0 = *(const LAS bf16x8*)(kb + d0 * 32), a1 = *(const LAS bf16x8*)(kb + 32 * KSTR + d0 * 32);
            p0 = __builtin_amdgcn_mfma_f32_32x32x16_bf16(a0, qf[d0], p0, 0, 0, 0); p1 = __builtin_amdgcn_mfma_f32_32x32x16_bf16(a1, qf[d0], p1, 0, 0, 0); }
        float mx = fmaxf(p0[0], p1[0]);
#pragma unroll
        for (int r = 1; r < 16; ++r) mx = fmaxf(mx, fmaxf(p0[r], p1[r]));
        mx = fmaxf(mx, __shfl_xor(mx, 32));
        const float mnew = fmaxf(mrun, mx), f = __builtin_amdgcn_exp2f(mrun - mnew); mrun = mnew;
        l *= f;
#pragma unroll
        for (int dt = 0; dt < 4; ++dt)
#pragma unroll
            for (int r = 0; r < 16; ++r) oT[dt][r] *= f;
        float sacc = 0.f;
#pragma unroll
        for (int r = 0; r < 16; ++r) { p0[r] = __builtin_amdgcn_exp2f(p0[r] - mnew); p1[r] = __builtin_amdgcn_exp2f(p1[r] - mnew); sacc += p0[r] + p1[r]; }
        l += sacc;
        bf16x8 pa[4]; pa[0] = pack_half(p0, 0); pa[1] = pack_half(p0, 1); pa[2] = pack_half(p1, 0); pa[3] = pack_half(p1, 1);
#pragma unroll
        for (int s = 0; s < 4; ++s)
#pragma unroll
            for (int dt = 0; dt < 4; ++dt) { const LAS unsigned char* va = lds + LDS_VT + (dt * 32 + r32) * VSTR + (kc * 64 + 16 * s + 4 * hi) * 2;
                const s16x4 lo = *(const LAS s16x4*)va, h4 = *(const LAS s16x4*)(va + 16);
                const bf16x8 a = __builtin_shufflevector(lo, h4, 0, 1, 2, 3, 4, 5, 6, 7);
                oT[dt] = __builtin_amdgcn_mfma_f32_32x32x16_bf16(a, pa[s], oT[dt], 0, 0, 0); }
    }
    l += __shfl_xor(l, 32);
    const float inv = 1.0f / l;
    bfu* orow = MIXED + row * DMODEL + 1536 + h * 128;
    { float ss = 0.f;
#pragma unroll
      for (int dt = 0; dt < 4; ++dt)
#pragma unroll
          for (int r = 0; r < 16; ++r) { const float v = oT[dt][r] * inv; ss += v * v; }
      ss += __shfl_xor(ss, 32);
      if (hi == 0) unsafeAtomicAdd(rowss2 + row, ss); }
#pragma unroll
    for (int dt = 0; dt < 4; ++dt)
#pragma unroll
        for (int g = 0; g < 4; ++g) { v2u w; w.x = pk2(oT[dt][4 * g] * inv, oT[dt][4 * g + 1] * inv); w.y = pk2(oT[dt][4 * g + 2] * inv, oT[dt][4 * g + 3] * inv);
            *(v2u*)(orow + dt * 32 + 8 * g + 4 * hi) = w; }
    __syncthreads();
}
}

__device__ __forceinline__ void conv_phase(const bfu* PROJ, bfu* MIXED, const float* conv_w, const float* g_conv_out, int gw, int NGW, int lane) {
    const f32x8 w0 = ld8f(conv_w + lane * 8), w1 = ld8f(conv_w + 512 + lane * 8), w2 = ld8f(conv_w + 1024 + lane * 8), gco = ld8f(g_conv_out + lane * 8);
    v4u nx[7];
#define CONV_LOAD(mm) { const int s_ = (mm) & (SEQL - 1); const bfu* p0_ = PROJ + (size_t)(mm) * NIN + lane * 8; const bfu* p1_ = p0_ - (s_ >= 1 ? NIN : 0); const bfu* p2_ = p0_ - (s_ >= 2 ? 2 * NIN : 0); \
        nx[0] = *(const v4u*)(p0_ + C_U); nx[1] = *(const v4u*)(p0_ + C_C); nx[2] = *(const v4u*)(p0_ + C_B); nx[3] = *(const v4u*)(p1_ + C_U); nx[4] = *(const v4u*)(p1_ + C_C); nx[5] = *(const v4u*)(p2_ + C_U); nx[6] = *(const v4u*)(p2_ + C_C); }
    if (gw < MTOK) CONV_LOAD(gw)
    for (int m = gw; m < MTOK; m += NGW) {
        const int s = m & (SEQL - 1);
        v4u cu[7];
#pragma unroll
        for (int i = 0; i < 7; ++i) cu[i] = nx[i];
        if (m + NGW < MTOK) CONV_LOAD(m + NGW)
        const f32x8 z2 = unpack8(cu[0]) * unpack8(cu[1]), bg = unpack8(cu[2]);
        const float k1 = (s >= 1) ? 1.f : 0.f, k0 = (s >= 2) ? 1.f : 0.f;
        const f32x8 z1 = unpack8(cu[3]) * unpack8(cu[4]) * k1, z0 = unpack8(cu[5]) * unpack8(cu[6]) * k0;
        f32x8 y = bg * (w0 * z0 + w1 * z1 + w2 * z2);
        const float r = rsq(wave_sum(sumsq8(y)) * (1.f / 512.f) + EPS);
        y = y * r * gco;
        *(v4u*)(MIXED + (size_t)m * DMODEL + lane * 8) = pack8(y);
    }
#undef CONV_LOAD
}
__device__ __forceinline__ void finalize_phase(const bfu* PROJ, const bfu* ODIFF, const bfu* OMEM, bfu* MIXED, const float* conv_w, const float* g_conv_out, const float* lq1, const float* lk1, const float* lq2, const float* lk2,
                                               const float* g_sub, const float* g_mem_out, int gw, int NGW, int lane) {
#if !MK_FUSE_PREP
    conv_phase(PROJ, MIXED, conv_w, g_conv_out, gw, NGW, lane);
#endif
    const f32x8 gmo = ld8f(g_mem_out + lane * 8);
    const int hd = lane >> 3, sub = lane & 7;
    const f32x8 gs0 = ld8f(g_sub + sub * 16), gs1 = ld8f(g_sub + sub * 16 + 8);
    const float lam = __expf(wave_sum(lq1[lane] * lk1[lane])) - __expf(wave_sum(lq2[lane] * lk2[lane])) + LAM_INIT;
    v4u nx[5];
#define FIN_LOAD(mm) { nx[4] = *(const v4u*)(OMEM + (size_t)(mm) * 512 + lane * 8); }
    if (gw < MTOK) FIN_LOAD(gw)
    for (int m = gw; m < MTOK; m += NGW) {
        bfu* mrow = MIXED + (size_t)m * DMODEL;
        v4u cu[5];
#pragma unroll
        for (int i = 0; i < 5; ++i) cu[i] = nx[i];
        if (m + NGW < MTOK) FIN_LOAD(m + NGW)
        {
            f32x8 t = unpack8(cu[4]);
            const float r = rsq(wave_sum(sumsq8(t)) * (1.f / 512.f) + EPS);
            t = t * r * gmo;
            *(v4u*)(mrow + 1536 + lane * 8) = pack8(t);
        }
    }
#undef FIN_LOAD
}

#define XB_TMO      128
#define XB_XCNT(j)  (256  + 64 * (j))
#define XB_XSUB(j)  (1280 + 64 * (j))
#define XB_XGEN(j)  (2304 + 64 * (j))
#define XB_TOP      3328
#define XB_TOPGEN   3392
#define XCD_BAR_WORDS 3456
#define XB_SPIN_CAP (1u << 18)

__device__ __forceinline__ unsigned xb_ld(unsigned* p)              { return __hip_atomic_load(p, __ATOMIC_RELAXED, __HIP_MEMORY_SCOPE_AGENT); }
__device__ __forceinline__ unsigned xb_add(unsigned* p, unsigned v) { return __hip_atomic_fetch_add(p, v, __ATOMIC_RELAXED, __HIP_MEMORY_SCOPE_AGENT); }
__device__ __forceinline__ unsigned xb_xcc_id() { return (unsigned)__builtin_amdgcn_s_getreg((3 << 11) | 20) & 0xFu; }
#define XB_SPIN(cond, bar) do { unsigned _sp = 0; while (cond) { __builtin_amdgcn_s_sleep(1); \
    if ((++_sp & 255u) == 0u) { if (xb_ld(&(bar)[XB_TMO])) break; if (_sp > XB_SPIN_CAP) { atomicAdd(&(bar)[XB_TMO], 1u); break; } } } } while (0)

struct XcdBarrier {
    unsigned* bar; unsigned x;
    volatile LAS unsigned* st;
};

__device__ __forceinline__ XcdBarrier xcd_barrier_post(unsigned* bar, volatile LAS unsigned* st, int tid) {
    XcdBarrier b; b.bar = bar; b.x = xb_xcc_id(); b.st = st;
    if (tid == 0) (void)xb_add(&bar[XB_XCNT(b.x)], 1u);
    return b;
}
__device__ __forceinline__ void xcd_barrier_complete(unsigned* bar, unsigned x, unsigned& nloc, unsigned& nx) {
    const unsigned G = gridDim.x * gridDim.y * gridDim.z;
    unsigned sum, cnt, mine, sp = 0u;
    for (;;) {
        sum = 0u; cnt = 0u; mine = 0u;
#pragma unroll
        for (unsigned j = 0; j < 16; ++j) { const unsigned c = xb_ld(&bar[XB_XCNT(j)]); sum += c; cnt += (c > 0u) ? 1u : 0u; mine = (j == x) ? c : mine; }
        if (sum == G) break;
        __builtin_amdgcn_s_sleep(1);
        if ((++sp & 255u) == 0u) { if (xb_ld(&bar[XB_TMO])) break; if (sp > XB_SPIN_CAP) { atomicAdd(&bar[XB_TMO], 1u); break; } }
    }
    nloc = mine > 0u ? mine : 1u; nx = cnt > 0u ? cnt : 1u;
}

__device__ __forceinline__ void xcd_barrier(const XcdBarrier& b, int tid) {
    asm volatile("s_waitcnt vmcnt(0)" ::: "memory");
    __syncthreads();
    if (tid == 0) {
        unsigned* bar = b.bar;
        __builtin_amdgcn_s_waitcnt(0);
        unsigned nloc = b.st[0], nx = b.st[1];
        if (nloc == 0u) { xcd_barrier_complete(bar, b.x, nloc, nx); b.st[0] = nloc; b.st[1] = nx; }
        const unsigned old = xb_add(&bar[XB_XSUB(b.x)], 1u);
        const unsigned gen = old / nloc;
        if (old + 1u == (gen + 1u) * nloc) {
            __builtin_amdgcn_fence(__ATOMIC_RELEASE, "agent");
            asm volatile("s_waitcnt vmcnt(0)" ::: "memory");
            const unsigned og = xb_add(&bar[XB_TOP], 1u);
            const unsigned tg = og / nx;
            if (og + 1u == (tg + 1u) * nx) xb_add(&bar[XB_TOPGEN], 1u);
            else XB_SPIN(xb_ld(&bar[XB_TOPGEN]) == tg, bar);
            __builtin_amdgcn_fence(__ATOMIC_ACQUIRE, "agent");
            xb_add(&bar[XB_XGEN(b.x)], 1u);
            asm volatile("s_waitcnt vmcnt(0)" ::: "memory");
        } else {
            XB_SPIN(xb_ld(&bar[XB_XGEN(b.x)]) == gen, bar);
            __builtin_amdgcn_fence(__ATOMIC_ACQUIRE, "agent");
            asm volatile("s_waitcnt vmcnt(0)" ::: "memory");
        }
    }
    __syncthreads();
}

__device__ __forceinline__ int fresh_tid(int wave) { unsigned z; asm volatile("s_mov_b32 %0, 0" : "=s"(z)); return wave * 64 + (int)__builtin_amdgcn_mbcnt_hi(~0u, __builtin_amdgcn_mbcnt_lo(~0u, z)); }
struct Args { const float* in[24]; float* out; unsigned char* ws; int ph_lo, ph_hi; };
constexpr int N_PHASES = 8;
__global__ void __launch_bounds__(NWAVES * 64, 2) mk_fwd(Args a) {
    extern __shared__ __attribute__((aligned(16))) unsigned char lds_raw[];
    LAS unsigned char* lds = (LAS unsigned char*)lds_raw;
    cg::grid_group grid = cg::this_grid();
    const int wave0 = __builtin_amdgcn_readfirstlane((int)threadIdx.x >> 6);
    const int G = gridDim.x, bx = blockIdx.x, vcu = (G % 8 == 0) ? (bx % 8) * (G / 8) + bx / 8 : bx;
    const int NGW = G * NWAVES;
#define LANE_VARS() const int tid_ = fresh_tid(wave0); const int lane = tid_ & 63, wave = wave0, gw = vcu * NWAVES + wave; (void)lane; (void)gw;
    typedef const __attribute__((address_space(4))) Args* kargs_t;
#define KARGS() ({ unsigned long long v_ = (unsigned long long)__builtin_amdgcn_kernarg_segment_ptr(); asm volatile("" : "+s"(v_)); (kargs_t)v_; })
#define WSP(ka, off) ((bfu*)((ka)->ws + (off)))
#define IN(k) (a.ph_lo <= (k) && (k) < a.ph_hi)
#define SEAM(k) do { if (IN(k) && IN((k) + 1)) { xcd_barrier(xbar, fresh_tid(wave0)); if (PROBE_DUP == 100) xcd_barrier(xbar, fresh_tid(wave0)); } } while (0)
    volatile LAS unsigned* xst = (volatile LAS unsigned*)(lds + LDS_BARST);
    { const int t_ = fresh_tid(wave0); if (t_ == 0) { xst[0] = 0u; xst[1] = 0u; } __syncthreads(); }
    XcdBarrier xbar; xbar.bar = (unsigned*)(a.ws + WS_BAR); xbar.x = 0; xbar.st = xst;
    if (a.ph_hi - a.ph_lo > 2) { xbar = xcd_barrier_post((unsigned*)(a.ws + WS_BAR), xst, fresh_tid(wave0)); if (PROBE_DUP == 101) grid.sync(); }

    for (int rep_ = 0; rep_ < (PROBE_DUP == 0 ? 2 : 1); ++rep_) if (IN(0)) {
        LANE_VARS(); kargs_t ka = KARGS(); const float *x = ka->in[0], *mem = ka->in[1], *g_mix = ka->in[3], *g_mem = ka->in[4], *w_in = ka->in[5], *w_mem_kv = ka->in[15], *w_o = ka->in[19], *w_gate = ka->in[21], *w_up = ka->in[22], *w_down = ka->in[23], *g_ffn = ka->in[20];
        bfu *WIN = WSP(ka, WS_WIN), *WKV = WSP(ka, WS_WKV), *WO = WSP(ka, WS_WO), *WGU = WSP(ka, WS_WGU), *WD = WSP(ka, WS_WD), *HB = WSP(ka, WS_HB), *MEMN = WSP(ka, WS_MEMN);
        LAS float* scr = (LAS float*)(lds + wave * 16384);
        constexpr int I_IN = (DMODEL / 64) * (NIN / 32), I_KV = (DMODEL / 64) * (NKV / 32), I_O = (DMODEL / 64) * (DMODEL / 32), I_G = (DMODEL / 64) * (FFH / 32), I_D = (FFH / 64) * (DMODEL / 32);
        constexpr int NITEMS = I_IN + I_KV + (MK_FUSE_PREP ? 0 : 2 * I_G);
        for (int it = gw; it < NITEMS; it += NGW) {
            int r = it;
            if (r < I_IN) { p0_transpose_item(w_in, DMODEL, NIN, WIN, 3, nullptr, scr, r, lane); continue; } r -= I_IN;
            if (r < I_KV) { p0_transpose_item(w_mem_kv, DMODEL, NKV, WKV, 0, nullptr, scr, r, lane); continue; } r -= I_KV;
            if (r < I_G) { p0_transpose_item(w_gate, DMODEL, FFH, WGU, 1, g_ffn, scr, r, lane); continue; } r -= I_G;
            p0_transpose_item(w_up, DMODEL, FFH, WGU, 2, g_ffn, scr, r, lane);
        }
        { float* rowss = (float*)(ka->ws + WS_ROWSS); float* rowss2 = (float*)(ka->ws + WS_ROWSS2); for (int i = gw * 64 + lane; i < MTOK; i += NGW * 64) { rowss[i] = 0.f; rowss2[i] = 0.f; } }
        for (int m = gw; m < MTOK; m += NGW) rms_row_to_bf16(x + (size_t)m * DMODEL, g_mix, HB + (size_t)m * DMODEL, lane);
        for (int m = gw; m < MROWS; m += NGW) rms_row_to_bf16(mem + (size_t)m * DMODEL, g_mem, MEMN + (size_t)m * DMODEL, lane);
        __syncthreads();
    }
    SEAM(0);
    for (int rep_ = 0; rep_ < (PROBE_DUP == 1 ? 2 : 1); ++rep_) if (IN(1)) {
        kargs_t ka = KARGS(); bfu *WIN = WSP(ka, WS_WIN), *HB = WSP(ka, WS_HB), *PROJ = WSP(ka, WS_PROJ);
        { pg8::Gemm g{HB, WIN, MTOK, NIN, DMODEL}; pg8::StaticOrder S; S.init(MTOK, NIN, G, bx); pg8::EpiProj<MK_FUSE_PREP != 0> E{PROJ, NIN, (const int*)ka->in[2], ka->in[8], ka->in[9], C2Q, EPS};
          pg8::gemm_phase<pg8::EpiProj<MK_FUSE_PREP != 0>, pg8::StaticOrder, true, true>(fresh_tid(wave0), lds, g, S, E); }
    }
    SEAM(1);
    for (int rep_ = 0; rep_ < (PROBE_DUP == 2 ? 2 : 1); ++rep_) if (IN(2)) {
        constexpr int NGEMM = 32; const bool split = G >= 2 * NGEMM;
        if (!split || bx < NGEMM) { kargs_t ka = KARGS(); pg8::Gemm g{WSP(ka, WS_MEMN), WSP(ka, WS_WKV), MROWS, NKV, DMODEL}; pg8::StaticOrder S; S.init(MROWS, NKV, split ? NGEMM : G, bx); pg8::EpiStoreBf16 E{WSP(ka, WS_KVM), NKV};
            pg8::gemm_phase<pg8::EpiStoreBf16, pg8::StaticOrder, true, true>(fresh_tid(wave0), lds, g, S, E); }
        if (!split || bx >= NGEMM) { LANE_VARS(); kargs_t ka = KARGS(); const int ci = split ? bx - NGEMM : bx, ncu = split ? G - NGEMM : G;
#if !MK_FUSE_PREP
            prep_phase(WSP(ka, WS_PROJ), WSP(ka, WS_PROJ), 0xffffff, (const int*)ka->in[2], ka->in[8], ka->in[9], ka->in[16], ci * NWAVES + wave, ncu * NWAVES, lane);
#else
            conv_phase(WSP(ka, WS_PROJ), WSP(ka, WS_MIXED), ka->in[6], ka->in[7], ci * NWAVES + wave, ncu * NWAVES, lane);
#endif
            { constexpr int I_O = (DMODEL / 64) * (DMODEL / 32), I_D = (FFH / 64) * (DMODEL / 32), I_G = MK_FUSE_PREP ? (DMODEL / 64) * (FFH / 32) : 0; LAS float* scr = (LAS float*)(lds + wave * 16384);
              const float *w_o = ka->in[19], *w_down = ka->in[23]; bfu *WO = WSP(ka, WS_WO), *WD = WSP(ka, WS_WD);
              for (int it = ci * NWAVES + wave; it < I_O + I_D + 2 * I_G; it += ncu * NWAVES) { int r = it;
                  if (r < I_O) { p0_transpose_item(w_o, DMODEL, DMODEL, WO, 0, (64 * (r / (DMODEL / 32)) >= 1536) ? ka->in[18] - 1536 : nullptr, scr, r, lane); continue; } r -= I_O;
                  if (r < I_D) { p0_transpose_item(w_down, FFH, DMODEL, WD, 0, nullptr, scr, r, lane); continue; } r -= I_D;
                  if (r < I_G) { p0_transpose_item(ka->in[21], DMODEL, FFH, WSP(ka, WS_WGU), 1, ka->in[20], scr, r, lane); continue; } r -= I_G;
                  p0_transpose_item(ka->in[22], DMODEL, FFH, WSP(ka, WS_WGU), 2, ka->in[20], scr, r, lane); }
              __syncthreads(); } }
    }
    SEAM(2);
    for (int rep_ = 0; rep_ < (PROBE_DUP == 3 ? 2 : 1); ++rep_) if (IN(3)) {
        kargs_t ka = KARGS(); bfu *PROJ = WSP(ka, WS_PROJ), *ODIFF = WSP(ka, WS_ODIFF), *KVM = WSP(ka, WS_KVM);
        for (int s = vcu; s < NB * 32; s += G) {
            const int pr = s & 3, h = (s >> 2) & 7, b = s >> 5;
            const attn_body::bf16* base = (const attn_body::bf16*)PROJ + (size_t)b * SEQL * NIN;
            const attn_body::bf16* Q0 = base + C_Q + h * 128; const attn_body::bf16* K0 = base + C_K + h * 128; const attn_body::bf16* Vh = base + C_V + h * 128;
            attn_body::bf16* Opark = (attn_body::bf16*)ODIFF + (size_t)b * SEQL * DMODEL + h * 256;
            attn_body::bf16* Omix = (attn_body::bf16*)WSP(ka, WS_MIXED) + (size_t)b * SEQL * DMODEL + 512 + h * 128;
            float lam; { LANE_VARS(); lam = __expf(wave_sum(ka->in[10][lane] * ka->in[11][lane])) - __expf(wave_sum(ka->in[12][lane] * ka->in[13][lane])) + LAM_INIT; }
            const float* gsub = ka->in[14];
#define AU2_(q) do { attn_body::attn_unit<8, 0>(fresh_tid(wave0), (q), Q0, K0, Vh, Opark, (char*)lds_raw, nullptr, 0.f, nullptr, 0.f); \
                     attn_body::attn_unit<8, 1>(fresh_tid(wave0), (q), Q0 + 64, K0 + 64, Vh, Omix, (char*)lds_raw, Opark, lam, gsub, 1.0f - LAM_INIT); } while (0)
            if (pr == 0) { AU2_(7); AU2_(0); } else if (pr == 1) { AU2_(6); AU2_(1); } else if (pr == 2) { AU2_(5); AU2_(2); } else { AU2_(4); AU2_(3); }
#undef AU2_
        }
        for (int mrep_ = 0; mrep_ < (PROBE_DUP == 103 ? 2 : 1); ++mrep_)
        for (int u = vcu; u < NB * 4 * 8; u += G) memattn::mem_unit(fresh_tid(wave0), u >> 5, (u >> 3) & 3, u & 7, PROJ, KVM, ka->in[17], ka->in[16], WSP(ka, WS_MIXED), (float*)(ka->ws + WS_ROWSS2), lds);
    }
    SEAM(3);
    for (int rep_ = 0; rep_ < (PROBE_DUP == 5 ? 2 : 1); ++rep_) if (IN(5)) { kargs_t ka = KARGS(); const float* x = ka->in[0]; bfu *MIXED = WSP(ka, WS_MIXED), *WO = WSP(ka, WS_WO);
        pg8::Gemm g{MIXED, WO, MTOK, DMODEL, DMODEL}; pg8::StaticOrder S; S.init(MTOK, DMODEL, G, bx); pg8::EpiResNormMid E{x, DMODEL, WSP(ka, WS_HB), (float*)(ka->ws + WS_ROWSS + (rep_ == 0 ? 0 : 131072)), (const float*)(ka->ws + WS_ROWSS2), 1.0f / 512.0f, EPS};
        pg8::gemm_phase<pg8::EpiResNormMid, pg8::StaticOrder, true, true>(fresh_tid(wave0), lds, g, S, E); }
    SEAM(5);
    for (int rep_ = 0; rep_ < (PROBE_DUP == 6 ? 2 : 1); ++rep_) if (IN(6)) { kargs_t ka = KARGS(); bfu *HB = WSP(ka, WS_HB), *WGU = WSP(ka, WS_WGU), *ACT = WSP(ka, WS_ACT);
        pg8::Gemm g{HB, WGU, MTOK, NGU, DMODEL}; pg8::StaticOrder S; S.init(MTOK, NGU, G, bx); pg8::EpiSwiGLU E{ACT, FFH, (const float*)(ka->ws + WS_ROWSS), 1.0f / DMODEL, EPS};
        pg8::gemm_phase<pg8::EpiSwiGLU, pg8::StaticOrder, true, true>(fresh_tid(wave0), lds, g, S, E); }
    SEAM(6);
    for (int rep_ = 0; rep_ < (PROBE_DUP == 7 ? 2 : 1); ++rep_) if (IN(7)) { kargs_t ka = KARGS(); float* out = ka->out; bfu *ACT = WSP(ka, WS_ACT), *WD = WSP(ka, WS_WD);
        pg8::Gemm g{ACT, WD, MTOK, DMODEL, FFH}; pg8::StaticOrder S; S.init(MTOK, DMODEL, G, bx); pg8::EpiResBf16 E{WSP(ka, WS_HB), out, DMODEL};
        pg8::gemm_phase<pg8::EpiResBf16, pg8::StaticOrder, true, true>(fresh_tid(wave0), lds, g, S, E); }
#undef IN
#undef SEAM
#undef KARGS
#undef LANE_VARS
#undef WSP
}

extern "C" void kernel_launch(void* const* d_in, const int* in_sizes, int n_in, void* d_out, int out_size, void* d_ws, size_t ws_size, hipStream_t stream) {
    static int grid = 0;
    if (grid == 0) {
        if (n_in != 24 || in_sizes[0] != MTOK * DMODEL || out_size != MTOK * DMODEL || ws_size < WS_END) {
            fprintf(stderr, "kernel_launch: unexpected shapes (n_in %d, in0 %d, out %d, ws %zu); nothing launched\n", n_in, n_in > 0 ? in_sizes[0] : -1, out_size, ws_size); grid = -1; return; }
        int dev = 0, cus = 0, per_cu = 0;
        if (hipGetDevice(&dev) != hipSuccess || hipDeviceGetAttribute(&cus, hipDeviceAttributeMultiprocessorCount, dev) != hipSuccess) { fprintf(stderr, "kernel_launch: device query failed\n"); grid = -1; return; }
        if (hipFuncSetAttribute((const void*)mk_fwd, hipFuncAttributeMaxDynamicSharedMemorySize, LDS_BYTES) != hipSuccess) { fprintf(stderr, "kernel_launch: hipFuncSetAttribute failed\n"); grid = -1; return; }
        if (hipOccupancyMaxActiveBlocksPerMultiprocessor(&per_cu, (const void*)mk_fwd, NWAVES * 64, LDS_BYTES) != hipSuccess || per_cu < 1) { fprintf(stderr, "kernel_launch: occupancy query reports %d workgroups per CU\n", per_cu); (void)hipGetLastError(); grid = -1; return; }
        grid = cus;
    }
    if (grid < 0) return;
    if (hipMemsetAsync((char*)d_ws + WS_BAR, 0, BAR_ZERO_BYTES, stream) != hipSuccess) { fprintf(stderr, "kernel_launch: hipMemsetAsync of the barrier words failed\n"); return; }
    Args a{};
    for (int i = 0; i < 24; ++i) a.in[i] = (const float*)d_in[i];
    a.out = (float*)d_out; a.ws = (unsigned char*)d_ws;
#if MK_MULTI
    for (int p = 0; p < N_PHASES; ++p) { a.ph_lo = p; a.ph_hi = p + 1; hipLaunchKernelGGL(mk_fwd, dim3(grid), dim3(NWAVES * 64), LDS_BYTES, stream, a); }
#else
    a.ph_lo = 0; a.ph_hi = N_PHASES;
    void* args[] = {&a};
    const hipError_t e = hipLaunchCooperativeKernel((const void*)mk_fwd, dim3(grid), dim3(NWAVES * 64), args, LDS_BYTES, stream);
    if (e != hipSuccess) fprintf(stderr, "kernel_launch: cooperative launch failed: %s (grid %d)\n", hipGetErrorString(e), grid);
#endif
}
```

```cpp
#include <hip/hip_runtime.h>
#include <hip/hip_cooperative_groups.h>
#include <cstdio>
#include <cstdint>
namespace cg = cooperative_groups;
#ifndef MK_MULTI
#define MK_MULTI 0
#endif
#ifndef PROBE_DUP
#define PROBE_DUP -1
#endif
#ifndef MK_FUSE_PREP
#define MK_FUSE_PREP 1
#endif
namespace pg8 {
#define PG8_LAS __attribute__((address_space(3)))
typedef unsigned short bf16_t;
typedef short bf16x8 __attribute__((ext_vector_type(8)));
typedef float f32x4 __attribute__((ext_vector_type(4)));
typedef unsigned u32x4 __attribute__((ext_vector_type(4)));
constexpr int BM = 256, BK = 64, HALF = 128, HTB = HALF * BK * 2  , STAGE_BYTES = 8 * HTB, NXCD = 8, WGM = 8;

__host__ __device__ __forceinline__ int lds_byte(int r, int c) { const int st = (r >> 4) * 2 + (c >> 5), rr = r & 15, cc = c & 31, ob = rr * 64 + cc * 2; return st * 1024 + (ob ^ (((ob >> 9) & 1) << 5)); }
__host__ __device__ __forceinline__ void stage_rc(int b, int& R, int& C) { const int st = b / 1024, sb = b % 1024, swz = sb ^ (((sb >> 9) & 1) << 5); R = (st >> 1) * 16 + swz / 64; C = (st & 1) * 32 + (swz % 64) / 2; }
__host__ __device__ __forceinline__ int perm32(int rho) { const int n = rho >> 4, i = rho & 15; return 8 * (i >> 2) + 4 * n + (i & 3); }

struct Unit { int pm, pn; };
struct Gemm { const bf16_t* A; const bf16_t* Bt; int M, N, K; };

struct StaticOrder {
    int nM, nN, nwg, G, c;
    __host__ __device__ void init(int M, int N, int G_, int c_) { nM = M / BM; nN = N / BM; nwg = nM * nN; G = G_; c = c_; }
    __host__ __device__ bool next(int i, Unit& u) const {
        const long L = (long)i * G + c; if (L >= nwg) return false;
        int wgid = (int)L; { const int q = nwg / NXCD, r = nwg % NXCD, xcd = wgid % NXCD, off = wgid / NXCD; wgid = (xcd < r ? xcd * (q + 1) : r * (q + 1) + (xcd - r) * q) + off; }
        const int nig = WGM * nN, gid = wgid / nig, fm = gid * WGM, gsz = (nM - fm) < WGM ? (nM - fm) : WGM;
        u.pm = fm + ((wgid % nig) % gsz); u.pn = (wgid % nig) / gsz; return true;
    }
    __device__ __forceinline__ void a_ready(const Unit&) const {}
    __device__ __forceinline__ void done(const Unit&) const {}
};
__device__ __forceinline__ unsigned cvt_pk_bf16(float lo, float hi) { unsigned r; asm volatile("v_cvt_pk_bf16_f32 %0, %1, %2" : "=v"(r) : "v"(lo), "v"(hi)); return r; }
typedef unsigned u32x2 __attribute__((ext_vector_type(2)));
template <bool FUSE> struct EpiProj {
    static constexpr bool PERM = true, AFTER_DRAIN = false; static constexpr int MID_T = -1;
    bf16_t* O; int ldc; const int* positions; const float* g_dq; const float* g_dk; float qscale, eps;
    __device__ __forceinline__ void operator()(const f32x4 (&acc)[2][2][4][2], const Unit& u, int wr, int wc, int fr, int fq) const {
        const int row0 = u.pm * BM + wr * 64 + fr, col0 = u.pn * BM + wc * 64 + 8 * fq;
        const bool qk = FUSE && u.pn >= 6 && u.pn < 14;
        if (!qk) {
#pragma unroll
            for (int ai = 0; ai < 2; ++ai)
#pragma unroll
                for (int m = 0; m < 4; ++m) { bf16_t* rowp = O + (size_t)(row0 + ai * HALF + m * 16) * ldc + col0;
#pragma unroll
                    for (int bj = 0; bj < 2; ++bj) { const f32x4 v0 = acc[ai][bj][m][0], v1 = acc[ai][bj][m][1];
                        u32x4 w; w.x = cvt_pk_bf16(v0[0], v0[1]); w.y = cvt_pk_bf16(v0[2], v0[3]); w.z = cvt_pk_bf16(v1[0], v1[1]); w.w = cvt_pk_bf16(v1[2], v1[3]);
                        *(u32x4*)(rowp + bj * 32) = w; } }
        } else {
            const bool isq = u.pn < 10, lo = fq < 2;
            const float* gb = isq ? g_dq : g_dk;
            const int d00 = lo ? 4 * fq : 8 * fq, d01 = lo ? 8 + 4 * fq : 8 * fq + 4;
            f32x4 gv[2][2];
            gv[0][0] = *(const f32x4*)(gb + d00); gv[0][1] = *(const f32x4*)(gb + d01);
            gv[1][0] = *(const f32x4*)(gb + 32 + 8 * fq); gv[1][1] = *(const f32x4*)(gb + 32 + 8 * fq + 4);
            const float sc = isq ? qscale : 1.0f;
            constexpr double I2PI = 0.15915494309189535;
            constexpr double IFR[8] = {1.0 * I2PI, 0.19392274474868576 * I2PI, 0.03760603093086393 * I2PI, 0.007292664737217109 * I2PI,
                                       0.001414213562373095 * I2PI, 0.0002742481756762073 * I2PI, 5.318295896944988e-05 * I2PI, 1.031338537721246e-05 * I2PI};
            const bool hi4 = (fq & 1) != 0;
            const double if0 = hi4 ? IFR[4] : IFR[0], if1 = hi4 ? IFR[5] : IFR[1], if2 = hi4 ? IFR[6] : IFR[2], if3 = hi4 ? IFR[7] : IFR[3];
            int posr[2][4]; float ssr[2][4];
#pragma unroll
            for (int ai = 0; ai < 2; ++ai)
#pragma unroll
                for (int m = 0; m < 4; ++m) { posr[ai][m] = positions[row0 + ai * HALF + m * 16]; float s = 0.f;
#pragma unroll
                    for (int bj = 0; bj < 2; ++bj)
#pragma unroll
                        for (int n = 0; n < 2; ++n) { const f32x4 x = acc[ai][bj][m][n]; s += (x[0] * x[0] + x[1] * x[1]) + (x[2] * x[2] + x[3] * x[3]); }
                    ssr[ai][m] = s; }
#pragma unroll
            for (int ai = 0; ai < 2; ++ai)
#pragma unroll
                for (int m = 0; m < 4; ++m) ssr[ai][m] += __shfl_xor(ssr[ai][m], 16);
#pragma unroll
            for (int ai = 0; ai < 2; ++ai)
#pragma unroll
                for (int m = 0; m < 4; ++m) ssr[ai][m] += __shfl_xor(ssr[ai][m], 32);
#pragma unroll
            for (int ai = 0; ai < 2; ++ai)
#pragma unroll
                for (int m = 0; m < 4; ++m) { bf16_t* rowp = O + (size_t)(row0 + ai * HALF + m * 16) * ldc + u.pn * BM + wc * 64;
                    const double pos = (double)posr[ai][m];
                    f32x4 cs, sn;
#define PG8_ROPE(i, IFJ) { double rev = pos * (IFJ); rev -= __builtin_rint(rev); const float frv = (float)rev; cs[i] = __builtin_amdgcn_cosf(frv); sn[i] = __builtin_amdgcn_sinf(frv); }
                    PG8_ROPE(0, if0) PG8_ROPE(1, if1) PG8_ROPE(2, if2) PG8_ROPE(3, if3)
#undef PG8_ROPE
                    const float r = 1.0f / sqrtf(ssr[ai][m] * (1.0f / 64.0f) + eps);
                    f32x4 t[2][2];
#pragma unroll
                    for (int bj = 0; bj < 2; ++bj)
#pragma unroll
                        for (int n = 0; n < 2; ++n) t[bj][n] = acc[ai][bj][m][n] * r * gv[bj][n];
                    if (lo) { const f32x4 a = t[0][0], b = t[0][1]; t[0][0] = a * cs - b * sn; t[0][1] = b * cs + a * sn; }
                    { const f32x4 v0 = t[0][0] * sc, v1 = t[0][1] * sc; u32x2 w0, w1; w0.x = cvt_pk_bf16(v0[0], v0[1]); w0.y = cvt_pk_bf16(v0[2], v0[3]); w1.x = cvt_pk_bf16(v1[0], v1[1]); w1.y = cvt_pk_bf16(v1[2], v1[3]);
                      *(u32x2*)(rowp + d00) = w0; *(u32x2*)(rowp + d01) = w1; }
                    { const f32x4 v0 = t[1][0] * sc, v1 = t[1][1] * sc; u32x4 w; w.x = cvt_pk_bf16(v0[0], v0[1]); w.y = cvt_pk_bf16(v0[2], v0[3]); w.z = cvt_pk_bf16(v1[0], v1[1]); w.w = cvt_pk_bf16(v1[2], v1[3]);
                      *(u32x4*)(rowp + 32 + 8 * fq) = w; } }
        }
    }
};
struct EpiStoreBf16 {
    static constexpr bool PERM = true, AFTER_DRAIN = false; static constexpr int MID_T = -1;
    bf16_t* O; int ldc;
    __device__ __forceinline__ void operator()(const f32x4 (&acc)[2][2][4][2], const Unit& u, int wr, int wc, int fr, int fq) const {
        const int row0 = u.pm * BM + wr * 64 + fr, col0 = u.pn * BM + wc * 32 + 8 * fq;
#pragma unroll
        for (int ai = 0; ai < 2; ++ai)
#pragma unroll
            for (int m = 0; m < 4; ++m) { bf16_t* rowp = O + (size_t)(row0 + ai * HALF + m * 16) * ldc + col0;
#pragma unroll
                for (int bj = 0; bj < 2; ++bj) { const f32x4 v0 = acc[ai][bj][m][0], v1 = acc[ai][bj][m][1];
                    u32x4 w; w.x = cvt_pk_bf16(v0[0], v0[1]); w.y = cvt_pk_bf16(v0[2], v0[3]); w.z = cvt_pk_bf16(v1[0], v1[1]); w.w = cvt_pk_bf16(v1[2], v1[3]);
                    *(u32x4*)(rowp + bj * HALF) = w; } }
    }
};
#define PG8_EPI_SB() __builtin_amdgcn_sched_barrier(0)
#define PG8_ROWB(g, mm) (bo + (unsigned)((((g) >> 1) * HALF + (2 * ((g) & 1) + (mm)) * 16) * ldc) * 4u)
#define PG8_LDRES(B, g) _Pragma("unroll") for (int mm = 0; mm < 2; ++mm) { const unsigned rb = PG8_ROWB(g, mm); \
            _Pragma("unroll") for (int bj = 0; bj < 2; ++bj) _Pragma("unroll") for (int n = 0; n < 2; ++n) B[mm][bj][n] = __builtin_nontemporal_load((const f32x4*)((const char*)base + (rb + (unsigned)(bj * HALF + 4 * n) * 4u))); }
#define PG8_ADDRES(B, g) _Pragma("unroll") for (int mm = 0; mm < 2; ++mm) _Pragma("unroll") for (int bj = 0; bj < 2; ++bj) _Pragma("unroll") for (int n = 0; n < 2; ++n) acc[(g) >> 1][bj][2 * ((g) & 1) + mm][n] += B[mm][bj][n];
struct EpiResF32 {
    static constexpr bool PERM = true, AFTER_DRAIN = false; static constexpr int MID_T = -1;
    const float* base; float* out; int ldc;
    __device__ __forceinline__ void operator()(f32x4 (&acc)[2][2][4][2], const Unit& u, int wr, int wc, int fr, int fq) const {
        const int row0 = u.pm * BM + wr * 64 + fr, col0 = u.pn * BM + wc * 32 + 8 * fq; const unsigned bo = (unsigned)(row0 * ldc + col0) * 4u;
        f32x4 ba[2][2][2], bb[2][2][2];
#define PG8_STRES(g) _Pragma("unroll") for (int mm = 0; mm < 2; ++mm) { const unsigned rb = PG8_ROWB(g, mm); \
            _Pragma("unroll") for (int bj = 0; bj < 2; ++bj) _Pragma("unroll") for (int n = 0; n < 2; ++n) *(f32x4*)((char*)out + (rb + (unsigned)(bj * HALF + 4 * n) * 4u)) = acc[(g) >> 1][bj][2 * ((g) & 1) + mm][n]; }
        PG8_LDRES(ba, 0) PG8_LDRES(bb, 1) PG8_EPI_SB(); PG8_ADDRES(ba, 0) PG8_EPI_SB(); PG8_LDRES(ba, 2) PG8_EPI_SB(); PG8_ADDRES(bb, 1) PG8_EPI_SB();
        PG8_STRES(0) PG8_STRES(1) PG8_EPI_SB(); PG8_LDRES(bb, 3) PG8_EPI_SB(); PG8_ADDRES(ba, 2) PG8_STRES(2) PG8_EPI_SB(); PG8_ADDRES(bb, 3) PG8_STRES(3)
#undef PG8_STRES
    }
};
struct EpiResNorm {
    static constexpr bool PERM = true, AFTER_DRAIN = false; static constexpr int MID_T = -1;
    const float* base; int ldc; bf16_t* XG; float* rowss;
    __device__ __forceinline__ void operator()(f32x4 (&acc)[2][2][4][2], const Unit& u, int wr, int wc, int fr, int fq) const {
        const int row0 = u.pm * BM + wr * 64 + fr, col0 = u.pn * BM + wc * 32 + 8 * fq; const unsigned bo = (unsigned)(row0 * ldc + col0) * 4u;
        f32x4 ba[2][2][2], bb[2][2][2];
#define PG8_STNORM(g) _Pragma("unroll") for (int mm = 0; mm < 2; ++mm) { const int m = 2 * ((g) & 1) + mm, row = row0 + ((g) >> 1) * HALF + m * 16; const unsigned rb = PG8_ROWB(g, mm); float ss = 0.f; \
            _Pragma("unroll") for (int bj = 0; bj < 2; ++bj) { const unsigned p = rb + (unsigned)(bj * HALF) * 4u; const f32x4 v0 = acc[(g) >> 1][bj][m][0], v1 = acc[(g) >> 1][bj][m][1]; \
                ss += ((v0[0] * v0[0] + v0[1] * v0[1]) + (v0[2] * v0[2] + v0[3] * v0[3])) + ((v1[0] * v1[0] + v1[1] * v1[1]) + (v1[2] * v1[2] + v1[3] * v1[3])); \
                u32x4 w; w.x = cvt_pk_bf16(v0[0], v0[1]); w.y = cvt_pk_bf16(v0[2], v0[3]); w.z = cvt_pk_bf16(v1[0], v1[1]); w.w = cvt_pk_bf16(v1[2], v1[3]); \
                *(u32x4*)((char*)XG + (p >> 1)) = w; } \
            ss += __shfl_xor(ss, 16); ss += __shfl_xor(ss, 32); \
            if (fq == 0) unsafeAtomicAdd(rowss + row, ss); }
        PG8_LDRES(ba, 0) PG8_LDRES(bb, 1) PG8_EPI_SB(); PG8_ADDRES(ba, 0) PG8_EPI_SB(); PG8_LDRES(ba, 2) PG8_EPI_SB(); PG8_ADDRES(bb, 1) PG8_EPI_SB();
        PG8_STNORM(0) PG8_STNORM(1) PG8_EPI_SB(); PG8_LDRES(bb, 3) PG8_EPI_SB(); PG8_ADDRES(ba, 2) PG8_STNORM(2) PG8_EPI_SB(); PG8_ADDRES(bb, 3) PG8_STNORM(3)
#undef PG8_STNORM
    }
};
#undef PG8_LDRES
#undef PG8_ADDRES
#undef PG8_ROWB
struct EpiResNormMid {
    static constexpr bool PERM = true, AFTER_DRAIN = false; static constexpr int MID_T = 24;
    const float* base; int ldc; bf16_t* XG; float* rowss; const float* rowss2; float inv_n2, eps;
    __device__ __forceinline__ void load_scale(const Unit& u, int wr, int fr, float (&rs)[2][4]) const {
        const unsigned rb = (unsigned)(u.pm * BM + wr * 64 + fr) * 4u;
#pragma unroll
        for (int ai = 0; ai < 2; ++ai)
#pragma unroll
            for (int m = 0; m < 4; ++m) rs[ai][m] = sqrtf(*(const float*)((const char*)rowss2 + (rb + (unsigned)(ai * HALF + m * 16) * 4u)) * inv_n2 + eps);
#pragma unroll
        for (int ai = 0; ai < 2; ++ai)
#pragma unroll
            for (int m = 0; m < 4; ++m) asm volatile("" : "+v"(rs[ai][m]));
    }
    __device__ __forceinline__ void operator()(f32x4 (&acc)[2][2][4][2], const Unit& u, int wr, int wc, int fr, int fq) const {
        float rs[2][4]; load_scale(u, wr, fr, rs);
#pragma unroll
        for (int ai = 0; ai < 2; ++ai)
#pragma unroll
            for (int m = 0; m < 4; ++m) { const float r = 1.0f / rs[ai][m];
#pragma unroll
                for (int bj = 0; bj < 2; ++bj)
#pragma unroll
                    for (int n = 0; n < 2; ++n) acc[ai][bj][m][n] *= r; }
        EpiResNorm{base, ldc, XG, rowss}(acc, u, wr, wc, fr, fq);
    }
};
struct EpiResBf16 {
    static constexpr bool PERM = true, AFTER_DRAIN = false; static constexpr int MID_T = -1;
    const bf16_t* resid; float* out; int ldc;
    __device__ __forceinline__ void operator()(f32x4 (&acc)[2][2][4][2], const Unit& u, int wr, int wc, int fr, int fq) const {
        const int row0 = u.pm * BM + wr * 64 + fr, col0 = u.pn * BM + wc * 32 + 8 * fq; const unsigned bo = (unsigned)(row0 * ldc + col0) * 4u;
        u32x4 rb[2][4][2];
#pragma unroll
        for (int ai = 0; ai < 2; ++ai)
#pragma unroll
            for (int m = 0; m < 4; ++m)
#pragma unroll
                for (int bj = 0; bj < 2; ++bj) rb[ai][m][bj] = *(const u32x4*)((const char*)resid + ((bo + (unsigned)((ai * HALF + m * 16) * ldc + bj * HALF) * 4u) >> 1));
        PG8_EPI_SB();
#pragma unroll
        for (int ai = 0; ai < 2; ++ai)
#pragma unroll
            for (int m = 0; m < 4; ++m)
#pragma unroll
                for (int bj = 0; bj < 2; ++bj) { const unsigned p = bo + (unsigned)((ai * HALF + m * 16) * ldc + bj * HALF) * 4u; const u32x4 w = rb[ai][m][bj];
                    f32x4 r0, r1; r0[0] = __uint_as_float(w.x << 16); r0[1] = __uint_as_float(w.x & 0xffff0000u); r0[2] = __uint_as_float(w.y << 16); r0[3] = __uint_as_float(w.y & 0xffff0000u);
                    r1[0] = __uint_as_float(w.z << 16); r1[1] = __uint_as_float(w.z & 0xffff0000u); r1[2] = __uint_as_float(w.w << 16); r1[3] = __uint_as_float(w.w & 0xffff0000u);
                    *(f32x4*)((char*)out + p) = r0 + acc[ai][bj][m][0]; *(f32x4*)((char*)out + (p + 16u)) = r1 + acc[ai][bj][m][1]; }
    }
};
typedef float f32x2 __attribute__((ext_vector_type(2)));
__device__ __forceinline__ f32x2 swiglu_pk(f32x2 g, f32x2 u, float rl, float r2) {
    const f32x2 t = g * rl; f32x2 e; e.x = __builtin_amdgcn_exp2f(t.x); e.y = __builtin_amdgcn_exp2f(t.y);
    const f32x2 d = e + 1.0f; f32x2 q; q.x = __builtin_amdgcn_rcpf(d.x); q.y = __builtin_amdgcn_rcpf(d.y);
    return (g * u) * (q * r2);
}
struct EpiSwiGLU {
    static constexpr bool PERM = true, AFTER_DRAIN = false; static constexpr int MID_T = -1;
    bf16_t* O; int ldc; const float* rowss; float inv_n, eps;
    __device__ __forceinline__ void operator()(const f32x4 (&acc)[2][2][4][2], const Unit& u, int wr, int wc, int fr, int fq) const {
        const int row0 = u.pm * BM + wr * 64 + fr, col0 = u.pn * HALF + wc * 32 + 8 * fq;
        float rs[2][4];
#pragma unroll
        for (int ai = 0; ai < 2; ++ai)
#pragma unroll
            for (int m = 0; m < 4; ++m) rs[ai][m] = rowss[row0 + ai * HALF + m * 16];
#pragma unroll
        for (int ai = 0; ai < 2; ++ai)
#pragma unroll
            for (int m = 0; m < 4; ++m) { const int row = row0 + ai * HALF + m * 16; bf16_t* rowp = O + (size_t)row * ldc + col0;
                const float r = 1.0f / sqrtf(rs[ai][m] * inv_n + eps), rl = -1.4426950408889634f * r, r2 = r * r;
                const f32x4 g0 = acc[ai][0][m][0], g1 = acc[ai][0][m][1], u0 = acc[ai][1][m][0], u1 = acc[ai][1][m][1];
                const f32x2 a = swiglu_pk((f32x2){g0[0], g0[1]}, (f32x2){u0[0], u0[1]}, rl, r2), b = swiglu_pk((f32x2){g0[2], g0[3]}, (f32x2){u0[2], u0[3]}, rl, r2);
                const f32x2 c = swiglu_pk((f32x2){g1[0], g1[1]}, (f32x2){u1[0], u1[1]}, rl, r2), d = swiglu_pk((f32x2){g1[2], g1[3]}, (f32x2){u1[2], u1[3]}, rl, r2);
                u32x4 w; w.x = cvt_pk_bf16(a.x, a.y); w.y = cvt_pk_bf16(b.x, b.y); w.z = cvt_pk_bf16(c.x, c.y); w.w = cvt_pk_bf16(d.x, d.y);
                *(u32x4*)rowp = w; }
    }
};

template <class Epi, class Sched, bool ALIGN_EPI = false, bool SP2 = false>
__device__ __forceinline__ void gemm_phase(const int tid, PG8_LAS unsigned char* lds, const Gemm g, const Sched& S, const Epi& E) {
    const int wid = __builtin_amdgcn_readfirstlane(tid >> 6), lane = tid & 63, wr = wid >> 2, wc = wid & 3, fr = lane & 15, fq = lane >> 4;
    const int K = g.K, nt = K / BK;
    unsigned voffA[2], voffB[2];
#pragma unroll
    for (int i = 0; i < 2; ++i) { int R, C; stage_rc(tid * 16 + i * 8192, R, C); const int Rb = Epi::PERM ? ((R & ~31) + perm32(R & 31)) : R;
        voffA[i] = (unsigned)(R * K + C) * 2u; voffB[i] = (unsigned)(Rb * K + C) * 2u; }
    const size_t kstep = (size_t)(BK * 2);
    const size_t hstep = (size_t)HALF * K * 2;
    const size_t tstep = 2 * hstep;
    const unsigned ldsw = (unsigned)wid * 1024u;
    const int aoff = lds_byte(wr * 64 + fr, fq * 8), boff = lds_byte(wc * 32 + fr, fq * 8);
#define PG8_SA(b, h) (((b) * 2 + (h)) * HTB)
#define PG8_SB(b, h) ((4 + (b) * 2 + (h)) * HTB)
#define PG8_STAGE(bufoff, gbase, voff) do { _Pragma("unroll") for (int _i = 0; _i < 2; ++_i) \
        __builtin_amdgcn_global_load_lds((const unsigned*)((const char*)(gbase) + (voff)[_i]), (PG8_LAS unsigned*)(lds + (bufoff) + ldsw + _i * 8192), 16, 0, 0); } while (0)
#define PG8_LDA(dst, b, h) do { _Pragma("unroll") for (int m = 0; m < 4; ++m) _Pragma("unroll") for (int k = 0; k < 2; ++k) dst[m][k] = *(const PG8_LAS bf16x8*)(lds + PG8_SA(b, h) + aoff + m * 2048 + k * 1024); } while (0)
#define PG8_LDB(dst, b, h) do { _Pragma("unroll") for (int n = 0; n < 2; ++n) _Pragma("unroll") for (int k = 0; k < 2; ++k) dst[n][k] = *(const PG8_LAS bf16x8*)(lds + PG8_SB(b, h) + boff + n * 2048 + k * 1024); } while (0)
#define PG8_MMA(ai, bj, At, Bt) do { __builtin_amdgcn_s_setprio(1); _Pragma("unroll") for (int m = 0; m < 4; ++m) _Pragma("unroll") for (int n = 0; n < 2; ++n) _Pragma("unroll") for (int k = 0; k < 2; ++k) \
        acc[ai][bj][m][n] = __builtin_amdgcn_mfma_f32_16x16x32_bf16(Bt[n][k], At[m][k], acc[ai][bj][m][n], 0, 0, 0); __builtin_amdgcn_s_setprio(0); } while (0)
#define PG8_WAIT_V(n) asm volatile("s_waitcnt vmcnt(" #n ")" ::: "memory")
#define PG8_WAIT_L(n) asm volatile("s_waitcnt lgkmcnt(" #n ")" ::: "memory")
#define PG8_BAR __builtin_amdgcn_s_barrier()
#define PG8_SCHED __builtin_amdgcn_sched_barrier(0)
    Unit cur, nxt; int ui = 0;
    if (!S.next(0, cur)) return;
    f32x4 acc[2][2][4][2];
#pragma unroll
    for (int a = 0; a < 2; ++a)
#pragma unroll
        for (int b = 0; b < 2; ++b)
#pragma unroll
            for (int m = 0; m < 4; ++m)
#pragma unroll
                for (int n = 0; n < 2; ++n) acc[a][b][m][n] = (f32x4){0.f, 0.f, 0.f, 0.f};
    bf16x8 At[4][2], B0[2][2], B1[2][2];
    const char* cA = (const char*)g.A + (size_t)cur.pm * tstep; const char* cB = (const char*)g.Bt + (size_t)cur.pn * tstep;
    S.a_ready(cur);
    if constexpr (SP2) {
        PG8_STAGE(PG8_SB(0, 0), cB, voffB); PG8_STAGE(PG8_SB(0, 1), cB + hstep, voffB); PG8_STAGE(PG8_SA(0, 0), cA, voffA); PG8_STAGE(PG8_SA(0, 1), cA + hstep, voffA);
        if (wr == 1) PG8_BAR;
        PG8_WAIT_V(2); PG8_BAR;
        PG8_STAGE(PG8_SB(1, 0), cB + kstep, voffB); PG8_STAGE(PG8_SA(1, 0), cA + kstep, voffA); PG8_STAGE(PG8_SB(1, 1), cB + hstep + kstep, voffB);
        PG8_WAIT_V(6); PG8_BAR;
    } else {
        PG8_STAGE(PG8_SB(0, 0), cB, voffB); PG8_STAGE(PG8_SA(0, 0), cA, voffA); PG8_STAGE(PG8_SB(0, 1), cB + hstep, voffB); PG8_STAGE(PG8_SA(0, 1), cA + hstep, voffA);
        if (wr == 1) PG8_BAR;
        PG8_WAIT_V(4); PG8_BAR;
        PG8_STAGE(PG8_SB(1, 0), cB + kstep, voffB); PG8_STAGE(PG8_SA(1, 0), cA + kstep, voffA); PG8_STAGE(PG8_SB(1, 1), cB + hstep + kstep, voffB);
        PG8_WAIT_V(6); PG8_BAR;
    }
    for (;;) {
        const bool has_next = S.next(ui + 1, nxt);
        const char* nA = has_next ? (const char*)g.A + (size_t)nxt.pm * tstep : cA; const char* nB = has_next ? (const char*)g.Bt + (size_t)nxt.pn * tstep : cB;
        for (int t = 0; t < nt; t += 2) {
            const bool last = (t == nt - 2);
            if constexpr (Epi::MID_T >= 0) { if (t == Epi::MID_T) { float rs[2][4]; E.load_scale(cur, wr, fr, rs);
                _Pragma("unroll") for (int a_ = 0; a_ < 2; ++a_) _Pragma("unroll") for (int m_ = 0; m_ < 4; ++m_) _Pragma("unroll") for (int b_ = 0; b_ < 2; ++b_) _Pragma("unroll") for (int n_ = 0; n_ < 2; ++n_) acc[a_][b_][m_][n_] *= rs[a_][m_]; } }
            const char* a1 = cA + (size_t)(t + 1) * kstep;
            const char* a2 = last ? nA : cA + (size_t)(t + 2) * kstep; const char* b2 = last ? nB : cB + (size_t)(t + 2) * kstep;
            const char* a3 = a2 + kstep; const char* b3 = b2 + kstep;
            if (last && has_next) S.a_ready(nxt);
            if constexpr (SP2) {
            PG8_LDB(B0, 0, 0); PG8_LDB(B1, 0, 1); PG8_SCHED; PG8_LDA(At, 0, 0); PG8_STAGE(PG8_SA(1, 1), a1 + hstep, voffA);
            PG8_WAIT_V(8); PG8_WAIT_L(0); PG8_BAR; PG8_MMA(0, 0, At, B0); PG8_MMA(0, 1, At, B1); PG8_BAR; PG8_SCHED;
            PG8_LDA(At, 0, 1); PG8_STAGE(PG8_SB(0, 0), b2, voffB); PG8_STAGE(PG8_SB(0, 1), b2 + hstep, voffB); PG8_STAGE(PG8_SA(0, 0), a2, voffA);
            PG8_WAIT_V(8); PG8_WAIT_L(0); PG8_BAR; PG8_MMA(1, 0, At, B0); PG8_MMA(1, 1, At, B1); PG8_BAR; PG8_SCHED;
            PG8_LDB(B0, 1, 0); PG8_LDB(B1, 1, 1); PG8_SCHED; PG8_LDA(At, 1, 0); PG8_STAGE(PG8_SA(0, 1), a2 + hstep, voffA);
            PG8_WAIT_V(8); PG8_WAIT_L(0); PG8_BAR; PG8_MMA(0, 0, At, B0); PG8_MMA(0, 1, At, B1); PG8_BAR; PG8_SCHED;
            PG8_LDA(At, 1, 1); PG8_STAGE(PG8_SB(1, 0), b3, voffB); PG8_STAGE(PG8_SB(1, 1), b3 + hstep, voffB); PG8_STAGE(PG8_SA(1, 0), a3, voffA);
            PG8_WAIT_V(8); PG8_WAIT_L(0); PG8_BAR; PG8_MMA(1, 0, At, B0); PG8_MMA(1, 1, At, B1); PG8_BAR; PG8_SCHED;
            } else {
            PG8_LDB(B0, 0, 0); PG8_SCHED; PG8_LDA(At, 0, 0); PG8_STAGE(PG8_SA(1, 1), a1 + hstep, voffA);
            PG8_WAIT_L(8); PG8_BAR; PG8_WAIT_L(0); PG8_MMA(0, 0, At, B0); PG8_BAR; PG8_SCHED;
            PG8_LDB(B1, 0, 1); PG8_STAGE(PG8_SB(0, 0), b2, voffB);
            PG8_BAR; PG8_WAIT_L(0); PG8_MMA(0, 1, At, B1); PG8_BAR;
            PG8_LDA(At, 0, 1); PG8_STAGE(PG8_SA(0, 0), a2, voffA);
            PG8_BAR; PG8_WAIT_L(0); PG8_MMA(1, 0, At, B0); PG8_BAR; PG8_SCHED;
            PG8_STAGE(PG8_SB(0, 1), b2 + hstep, voffB);
            PG8_WAIT_V(6); PG8_BAR; PG8_MMA(1, 1, At, B1); PG8_BAR;
            PG8_LDB(B0, 1, 0); PG8_SCHED; PG8_LDA(At, 1, 0); PG8_STAGE(PG8_SA(0, 1), a2 + hstep, voffA);
            PG8_WAIT_L(8); PG8_BAR; PG8_WAIT_L(0); PG8_MMA(0, 0, At, B0); PG8_BAR; PG8_SCHED;
            PG8_LDB(B1, 1, 1); PG8_STAGE(PG8_SB(1, 0), b3, voffB);
            PG8_BAR; PG8_WAIT_L(0); PG8_MMA(0, 1, At, B1); PG8_BAR;
            PG8_LDA(At, 1, 1); PG8_STAGE(PG8_SA(1, 0), a3, voffA);
            PG8_BAR; PG8_WAIT_L(0); PG8_MMA(1, 0, At, B0); PG8_BAR; PG8_SCHED;
            PG8_STAGE(PG8_SB(1, 1), b3 + hstep, voffB);
            PG8_WAIT_V(6); PG8_BAR; PG8_MMA(1, 1, At, B1); PG8_BAR;
            }
        }
        if constexpr (ALIGN_EPI) { if (wr == 0) PG8_BAR; }
        if constexpr (!Epi::AFTER_DRAIN) { E(acc, cur, wr, wc, fr, fq); S.done(cur); }
        if (!has_next) break;
#pragma unroll
        for (int a = 0; a < 2; ++a)
#pragma unroll
            for (int b = 0; b < 2; ++b)
#pragma unroll
                for (int m = 0; m < 4; ++m)
#pragma unroll
                    for (int n = 0; n < 2; ++n) acc[a][b][m][n] = (f32x4){0.f, 0.f, 0.f, 0.f};
        cur = nxt; cA = nA; cB = nB; ++ui;
        if constexpr (ALIGN_EPI) { if (wr == 1) PG8_BAR; }
    }
    PG8_WAIT_V(0);
    if constexpr (!ALIGN_EPI) { if (wr == 0) PG8_BAR; }
    PG8_BAR;
    if constexpr (Epi::AFTER_DRAIN) { E.fused(acc, cur, wr, wc, fr, fq, lds, wid, lane); S.done(cur); }
#undef PG8_SA
#undef PG8_SB
#undef PG8_STAGE
#undef PG8_LDA
#undef PG8_LDB
#undef PG8_MMA
#undef PG8_WAIT_V
#undef PG8_WAIT_L
#undef PG8_BAR
#undef PG8_SCHED
}
}
#include <hip/hip_bf16.h>
#include <cmath>
namespace attn_body {
using bf16=__hip_bfloat16;
using bf16x8=__attribute__((ext_vector_type(8)))short;
using s16x4=__attribute__((ext_vector_type(4)))short;
using f32x16=__attribute__((ext_vector_type(16)))float;
using u32x4=__attribute__((ext_vector_type(4)))unsigned;
constexpr int SEQ=2048,D=64,PQKV=5120,PO=2048;
constexpr int NW=8,QBLK=32,QB=QBLK*NW,KVBLK=64,NQB=SEQ/QB;
__device__ __forceinline__ int crow(int r,int hi){return (r&3)+8*(r>>2)+4*hi;}
#define SBAR() __builtin_amdgcn_sched_barrier(0)
__device__ __forceinline__ void cmask(f32x16&p0,f32x16&p1,int jb,int qrel,int hi){
  const float NEG=-INFINITY; int kb=64*jb+4*hi;
  #pragma unroll
  for(int r=0;r<16;++r){int kv=kb+(r&3)+8*(r>>2); if(kv>qrel)p0[r]=NEG; if(kv+32>qrel)p1[r]=NEG;}
}

constexpr int NSLOT=3, SLOTB=8192;
constexpr int LDS_K=0, LDS_V=NSLOT*SLOTB, LDS_WS=2*NSLOT*SLOTB, LDS_OST=LDS_WS+NW*64*4, LDS_V2=LDS_OST+NW*4096, LDS_BYTES=LDS_V2+NSLOT*SLOTB;
constexpr float C2=0.125f*1.4426950408889634f;
__device__ __forceinline__ void glds16s(const void*sbase,unsigned voff,unsigned lds_dst){unsigned keep;
  asm volatile("s_mov_b32 %0, m0\n\ts_mov_b32 m0, %3\n\ts_nop 0\n\tglobal_load_lds_dwordx4 %1, %2\n\ts_mov_b32 m0, %0":"=&s"(keep):"v"(voff),"s"(sbase),"s"(lds_dst):"memory");}
__device__ __forceinline__ void glds16(const void*gsrc,unsigned lds_dst){unsigned keep;
  asm volatile("s_mov_b32 %0, m0\n\ts_mov_b32 m0, %2\n\ts_nop 0\n\tglobal_load_lds_dwordx4 %1, off\n\ts_mov_b32 m0, %0":"=&s"(keep):"v"(gsrc),"s"(lds_dst):"memory");}
__device__ __forceinline__ float max3f(float a,float b,float c){float r;asm("v_max3_f32 %0, %1, %2, %3":"=v"(r):"v"(a),"v"(b),"v"(c));return r;}
__device__ __forceinline__ float max2f(float a,float b){float r;asm("v_max_f32_e32 %0, %1, %2":"=v"(r):"v"(a),"v"(b));return r;}
__device__ __forceinline__ float fadd_s(float a,float b){float r;asm("v_add_f32_e32 %0, %1, %2":"=v"(r):"v"(a),"v"(b));return r;}
__device__ __forceinline__ float fsub_s(float a,float b){float r;asm("v_sub_f32_e32 %0, %1, %2":"=v"(r):"v"(a),"v"(b));return r;}
typedef float f32x2_t __attribute__((ext_vector_type(2))); typedef __bf16 bf16x2_t __attribute__((ext_vector_type(2)));
__device__ __forceinline__ unsigned cvtpk_s(float lo,float hi){f32x2_t v={lo,hi};bf16x2_t b=__builtin_convertvector(v,bf16x2_t);return __builtin_bit_cast(unsigned,b);}
#define WAIT_BAR(N) asm volatile("s_waitcnt vmcnt(" #N ") lgkmcnt(0)\n\ts_barrier":::"memory")

__device__ __forceinline__ void qkt(f32x16&p0,f32x16&p1,const char*Kslot,const bf16x8*qr,const f32x16&negm,int r32,int hi){
  const char*kb=Kslot+hi*1024+r32*16;
  #pragma unroll
  for(int d0=0;d0<4;++d0){
    const bf16x8 b0=*reinterpret_cast<const bf16x8*>(kb+d0*2048);
    const bf16x8 b1=*reinterpret_cast<const bf16x8*>(kb+d0*2048+512);
    if(d0==0){p0=__builtin_amdgcn_mfma_f32_32x32x16_bf16(b0,qr[0],negm,0,0,0);p1=__builtin_amdgcn_mfma_f32_32x32x16_bf16(b1,qr[0],negm,0,0,0);}
    else{p0=__builtin_amdgcn_mfma_f32_32x32x16_bf16(b0,qr[d0],p0,0,0,0);p1=__builtin_amdgcn_mfma_f32_32x32x16_bf16(b1,qr[d0],p1,0,0,0);}}
}
typedef __attribute__((address_space(3))) const char* lds_cptr;
typedef short v4i16_t __attribute__((ext_vector_type(4)));
__device__ __forceinline__ void kload8(bf16x8*kf,lds_cptr kp){
  kf[0]=*(const __attribute__((address_space(3))) bf16x8*)(kp);      kf[1]=*(const __attribute__((address_space(3))) bf16x8*)(kp+512);
  kf[2]=*(const __attribute__((address_space(3))) bf16x8*)(kp+2048); kf[3]=*(const __attribute__((address_space(3))) bf16x8*)(kp+2560);
  kf[4]=*(const __attribute__((address_space(3))) bf16x8*)(kp+4096); kf[5]=*(const __attribute__((address_space(3))) bf16x8*)(kp+4608);
  kf[6]=*(const __attribute__((address_space(3))) bf16x8*)(kp+6144); kf[7]=*(const __attribute__((address_space(3))) bf16x8*)(kp+6656);
}
__device__ __forceinline__ void kload2(bf16x8*kf,lds_cptr kp,int j){ kf[2*j]=*(const __attribute__((address_space(3))) bf16x8*)(kp+j*2048); kf[2*j+1]=*(const __attribute__((address_space(3))) bf16x8*)(kp+j*2048+512); }
__device__ __forceinline__ s16x4 vtr(lds_cptr p){ return __builtin_bit_cast(s16x4,__builtin_amdgcn_ds_read_tr16_b64_v4i16((__attribute__((address_space(3))) v4i16_t*)p)); }
__device__ __forceinline__ float rowmax(const f32x16&p0,const f32x16&p1){
  float a=max3f(p0[0],p0[1],p1[0]),b=max3f(p0[2],p0[3],p1[1]);a=max3f(a,p1[2],p1[3]);
  #pragma unroll
  for(int r=4;r<16;r+=4){a=max3f(a,p0[r],p0[r+1]);b=max3f(b,p0[r+2],p0[r+3]);a=max3f(a,p1[r],p1[r+1]);b=max3f(b,p1[r+2],p1[r+3]);}
  const float m=max2f(a,b);
  auto rr=__builtin_amdgcn_permlane32_swap(__float_as_uint(m),__float_as_uint(m),false,false);
  return max2f(__uint_as_float(rr[0]),__uint_as_float(rr[1]));
}
__device__ __forceinline__ void pv(f32x16*o,int vb,bf16x8 pa0,bf16x8 pa1,bf16x8 pa2,bf16x8 pa3){
  #pragma unroll
  for(int d0=0;d0<2;++d0){s16x4 lo[4],hi[4];
    #pragma unroll
    for(int ks=0;ks<4;++ks){
      asm volatile("ds_read_b64_tr_b16 %0,%1 offset:%c2":"=&v"(lo[ks]):"v"(vb),"i"(d0*4096+ks*1024):"memory");
      asm volatile("ds_read_b64_tr_b16 %0,%1 offset:%c2":"=&v"(hi[ks]):"v"(vb),"i"(d0*4096+ks*1024+512):"memory");}
    asm volatile("s_waitcnt lgkmcnt(0)":::"memory");SBAR();
    #define PK(k) (bf16x8){lo[k][0],lo[k][1],lo[k][2],lo[k][3],hi[k][0],hi[k][1],hi[k][2],hi[k][3]}
    o[d0]=__builtin_amdgcn_mfma_f32_32x32x16_bf16(pa0,PK(0),o[d0],0,0,0);
    o[d0]=__builtin_amdgcn_mfma_f32_32x32x16_bf16(pa1,PK(1),o[d0],0,0,0);
    o[d0]=__builtin_amdgcn_mfma_f32_32x32x16_bf16(pa2,PK(2),o[d0],0,0,0);
    o[d0]=__builtin_amdgcn_mfma_f32_32x32x16_bf16(pa3,PK(3),o[d0],0,0,0);
    #undef PK
  }
}

#ifndef ATTN_STORE16
#define ATTN_STORE16(p,v) (*(u32x4*)(p)=(v))
#endif
typedef float f32x8a __attribute__((ext_vector_type(8))); typedef float f32x4a __attribute__((ext_vector_type(4)));
__device__ __forceinline__ f32x8a unpk8(u32x4 w){ f32x8a t; t[0]=__uint_as_float(w.x<<16); t[1]=__uint_as_float(w.x&0xffff0000u); t[2]=__uint_as_float(w.y<<16); t[3]=__uint_as_float(w.y&0xffff0000u);
  t[4]=__uint_as_float(w.z<<16); t[5]=__uint_as_float(w.z&0xffff0000u); t[6]=__uint_as_float(w.w<<16); t[7]=__uint_as_float(w.w&0xffff0000u); return t; }
template<int THRL,int MODE> __device__ __forceinline__ void attn_unit(int tid,int qb,const bf16*__restrict__ Qb,const bf16*__restrict__ Kh,const bf16*__restrict__ Vh,bf16*Ob,char*shm,const bf16*Ob0,float lam,const float*gsub,float dscale){
  const int lane=tid&63,r32=lane&31,hi=lane>>5; const int wid=__builtin_amdgcn_readfirstlane(tid>>6);
  const int q0=qb*QB;
  const bf16*Qw=Qb+(long)(q0+wid*QBLK)*PQKV;
  const unsigned lds0=(unsigned)(uintptr_t)shm;
  float*wsf=(float*)(shm+LDS_WS)+wid*64;
  const unsigned koff=(unsigned)(lane*PQKV+wid*8)*2u;
  const unsigned voff=(unsigned)((16*(wid&3)+(lane>>2))*PQKV+(wid>>2)*32+(lane&3)*8)*2u;
  const unsigned kdst=lds0+LDS_K+wid*1024, vdst=lds0+LDS_V+wid*1024, vdst2=lds0+LDS_V2+wid*1024;
  #define DMA_K(t,slot) glds16s(Kh+(long)(t)*KVBLK*PQKV,koff,(unsigned)__builtin_amdgcn_readfirstlane(kdst+(slot)))
  #define DMA_V(t,slot) do{ glds16s(Vh+(long)(t)*KVBLK*PQKV,voff,(unsigned)__builtin_amdgcn_readfirstlane(vdst+(slot))); glds16s(Vh+64+(long)(t)*KVBLK*PQKV,voff,(unsigned)__builtin_amdgcn_readfirstlane(vdst2+(slot))); }while(0)
  const int vb0=(int)(lds0+LDS_V)+((lane>>4)&1)*32+(lane&3)*8+(4*hi+((lane&15)>>2))*64;
  const char*Kbase=shm+LDS_K; bf16x8 kf[8];
  const lds_cptr shm3=(lds_cptr)shm; const lds_cptr kp0=shm3+LDS_K+hi*1024+r32*16; const lds_cptr vp0=shm3+LDS_V+((lane>>4)&1)*32+(lane&3)*8+(4*hi+((lane&15)>>2))*64;
  const int NT=(q0+QB)/KVBLK;
  DMA_K(0,0);DMA_V(0,0);DMA_K(1,SLOTB);
  bf16x8 qr[4];
  #pragma unroll
  for(int d0=0;d0<4;++d0)qr[d0]=*reinterpret_cast<const bf16x8*>(&Qw[(long)r32*PQKV+d0*16+hi*8]);
  float mhat=0.f,l_reg=0.f;float zz_=0.f;asm volatile("":"+v"(zz_));f32x16 o[4];f32x16 negm;
  _Pragma("unroll") for(int r=0;r<16;++r){o[0][r]=zz_;o[1][r]=zz_;o[2][r]=zz_;o[3][r]=zz_;negm[r]=zz_;} asm volatile("":"+v"(negm));
  const int qrel=wid*QBLK+r32;
  #define CMASK(P0,P1,t) do{int jb_=(t)-(NT-4); if(jb_>=0)cmask(P0,P1,jb_,qrel,hi);}while(0)
  bool resc=false;
  #define START(P0,P1) do{ const float rm=rowmax(P0,P1); resc=false; \
    { const float dl=rm; mhat=fadd_s(mhat,dl); \
      _Pragma("unroll") for(int r=0;r<16;++r){P0[r]=fsub_s(P0[r],dl);P1[r]=fsub_s(P1[r],dl);} \
      _Pragma("unroll") for(int r=0;r<16;++r)negm[r]=-mhat; asm volatile("":"+v"(negm)); } \
    _Pragma("unroll") for(int r=0;r<16;++r)P0[r]=__builtin_amdgcn_exp2f(P0[r]); }while(0)
  #define RESC() do{ if(resc){ asm volatile("s_waitcnt lgkmcnt(0)":::"memory"); \
      _Pragma("unroll") for(int d_=0;d_<4;++d_) _Pragma("unroll") for(int r=0;r<16;++r)o[d_][r]*=wsf[crow(r,hi)]; } }while(0)
  f32x16 pA0,pA1,pB0,pB1;
  int sl_prev=0,sl_cur=0,sl_next=SLOTB;
  #define ROT() do{sl_prev=sl_cur;sl_cur=sl_next;sl_next=(sl_next==(NSLOT-1)*SLOTB)?0:sl_next+SLOTB;}while(0)
  DMA_K(2,2*SLOTB);
  WAIT_BAR(4);
  qkt(pA0,pA1,Kbase,qr,negm,r32,hi);asm volatile("s_nop 15\n\ts_nop 7":"+v"(pA0),"+v"(pA1));CMASK(pA0,pA1,0);
  START(pA0,pA1);
  _Pragma("unroll") for(int r=0;r<16;++r)pA1[r]=__builtin_amdgcn_exp2f(pA1[r]);
  WAIT_BAR(0);
  DMA_K(3,0);DMA_V(1,SLOTB);
  ROT();
  kload8(kf,kp0+sl_cur);
  WAIT_BAR(3);
  s16x4 vlo[8],vhi[8]; u32x4 pw0,pw1,pw2,pw3;
  #define PKW(P,B) cvtpk_s(P[B],P[B+1])
  #define PAF(k) __builtin_bit_cast(bf16x8,pw##k)
  #define VFR(i) (bf16x8){vlo[i][0],vlo[i][1],vlo[i][2],vlo[i][3],vhi[i][0],vhi[i][1],vhi[i][2],vhi[i][3]}
  #define PIN(x) asm volatile("":"+v"(x))
  #define MX3(a,b,c) __builtin_fmaxf(__builtin_fmaxf((a),(b)),(c))
  #define GAPA(MF,A0,A1,A2,A3,W0,W1,PW) do{ MF; sacc+=A0; sacc+=A1; sacc+=A2; sacc+=A3; PIN(sacc); W0; W1; PIN(PW); SBAR(); }while(0)
  #define EX(v) __builtin_amdgcn_exp2f(v)
  #define GAPB(MF,X,B) do{ MF; X[B]=EX(X[B]); X[B+1]=EX(X[B+1]); X[B+2]=EX(X[B+2]); X[B+3]=EX(X[B+3]); PIN(X); SBAR(); }while(0)
  #define VRD(i) do{ vlo[i]=vtr(vp_+(((i)>>2)*4096+((i)&3)*1024)); vhi[i]=vtr(vp_+(((i)>>2)*4096+((i)&3)*1024+512)); }while(0)
  #define KRD(G,j) do{ if(G){ kload2(kf,kp0+sl_next,j); SBAR(); } }while(0)
  #define STEP(C0,C1,P0,P1,t,GK,GV,GL) do{ SBAR(); \
    const lds_cptr vp_=vp0+sl_prev; \
    VRD(0); SBAR(); float sacc=(P0[0]+P0[1]); \
    GAPA(C0=__builtin_amdgcn_mfma_f32_32x32x16_bf16(kf[0],qr[0],negm,0,0,0), P0[2],P0[3],P0[4],P0[5],     pw0[0]=PKW(P0,0), pw0[1]=PKW(P0,2), pw0); \
    VRD(4); SBAR(); GAPA(C1=__builtin_amdgcn_mfma_f32_32x32x16_bf16(kf[1],qr[0],negm,0,0,0), P0[6],P0[7],P0[8],P0[9],     pw0[2]=PKW(P0,4), pw0[3]=PKW(P0,6), pw0); \
    VRD(1); SBAR(); GAPA(C0=__builtin_amdgcn_mfma_f32_32x32x16_bf16(kf[2],qr[1],C0,0,0,0),   P0[10],P0[11],P0[12],P0[13], pw1[0]=PKW(P0,8), pw1[1]=PKW(P0,10), pw1); \
    VRD(5); SBAR(); GAPA(C1=__builtin_amdgcn_mfma_f32_32x32x16_bf16(kf[3],qr[1],C1,0,0,0),   P0[14],P0[15],P1[0],P1[1],   pw1[2]=PKW(P0,12),pw1[3]=PKW(P0,14), pw1); \
    VRD(2); SBAR(); GAPA(C0=__builtin_amdgcn_mfma_f32_32x32x16_bf16(kf[4],qr[2],C0,0,0,0),   P1[2],P1[3],P1[4],P1[5],     pw2[0]=PKW(P1,0), pw2[1]=PKW(P1,2), pw2); \
    VRD(6); SBAR(); GAPA(C1=__builtin_amdgcn_mfma_f32_32x32x16_bf16(kf[5],qr[2],C1,0,0,0),   P1[6],P1[7],P1[8],P1[9],     pw2[2]=PKW(P1,4), pw2[3]=PKW(P1,6), pw2); \
    VRD(3); SBAR(); GAPA(C0=__builtin_amdgcn_mfma_f32_32x32x16_bf16(kf[6],qr[3],C0,0,0,0),   P1[10],P1[11],P1[12],P1[13], pw3[0]=PKW(P1,8), pw3[1]=PKW(P1,10), pw3); \
    VRD(7); SBAR(); GAPA(C1=__builtin_amdgcn_mfma_f32_32x32x16_bf16(kf[7],qr[3],C1,0,0,0),   P1[14],P1[15],0.f,0.f,       pw3[2]=PKW(P1,12),pw3[3]=PKW(P1,14), pw3); \
    l_reg+=sacc; \
    if(GK){DMA_K((t)+3,sl_cur);} if(GV){DMA_V((t)+1,sl_next);} \
    CMASK(C0,C1,t); \
    { float a=MX3(C0[0],C0[1],C1[0]),b=MX3(C0[2],C0[3],C1[1]); a=MX3(a,C1[2],C1[3]); \
      _Pragma("unroll") for(int r=4;r<16;r+=4){a=MX3(a,C0[r],C0[r+1]);b=MX3(b,C0[r+2],C0[r+3]);a=MX3(a,C1[r],C1[r+1]);b=MX3(b,C1[r+2],C1[r+3]);} \
      float rm=__builtin_fmaxf(a,b); { auto rr=__builtin_amdgcn_permlane32_swap(__float_as_uint(rm),__float_as_uint(rm),false,false); rm=__builtin_fmaxf(__uint_as_float(rr[0]),__uint_as_float(rr[1])); } \
      resc=false; \
      if(__builtin_expect(__any(rm>(float)THRL),0)){ const float dl=__builtin_fmaxf(rm,0.f); mhat+=dl; \
        _Pragma("unroll") for(int r=0;r<16;++r){C0[r]-=dl;C1[r]-=dl;} \
        _Pragma("unroll") for(int r=0;r<16;++r)negm[r]=-mhat; asm volatile("":"+v"(negm)); \
        const float f=__builtin_amdgcn_exp2f(-dl); l_reg*=f; if(hi==0)wsf[r32]=f; resc=true; } } \
    SBAR(); \
    GAPB(o[0]=__builtin_amdgcn_mfma_f32_32x32x16_bf16(PAF(0),VFR(0),o[0],0,0,0), C0,0); \
    GAPB(o[1]=__builtin_amdgcn_mfma_f32_32x32x16_bf16(PAF(0),VFR(4),o[1],0,0,0), C0,4); \
    KRD(GL,0); GAPB(o[0]=__builtin_amdgcn_mfma_f32_32x32x16_bf16(PAF(1),VFR(1),o[0],0,0,0), C0,8); \
    KRD(GL,1); GAPB(o[1]=__builtin_amdgcn_mfma_f32_32x32x16_bf16(PAF(1),VFR(5),o[1],0,0,0), C0,12); \
    KRD(GL,2); GAPB(o[0]=__builtin_amdgcn_mfma_f32_32x32x16_bf16(PAF(2),VFR(2),o[0],0,0,0), C1,0); \
    KRD(GL,3); GAPB(o[1]=__builtin_amdgcn_mfma_f32_32x32x16_bf16(PAF(2),VFR(6),o[1],0,0,0), C1,4); \
    GAPB(o[0]=__builtin_amdgcn_mfma_f32_32x32x16_bf16(PAF(3),VFR(3),o[0],0,0,0), C1,8); \
    GAPB(o[1]=__builtin_amdgcn_mfma_f32_32x32x16_bf16(PAF(3),VFR(7),o[1],0,0,0), C1,12); \
    pv(o+2,vb0+(LDS_V2-LDS_V)+sl_prev,PAF(0),PAF(1),PAF(2),PAF(3));   \
    }while(0)
  int t=1;
  #undef CMASK
  #define CMASK(P0,P1,t) do{}while(0)
  for(;t+5<NT;t+=2){
    STEP(pB0,pB1,pA0,pA1,t,true,true,true);     WAIT_BAR(3); RESC(); ROT();
    STEP(pA0,pA1,pB0,pB1,t+1,true,true,true);   WAIT_BAR(3); RESC(); ROT();
  }
  #undef CMASK
  #define CMASK(P0,P1,t) do{int jb_=(t)-(NT-4); if(jb_>=0)cmask(P0,P1,jb_,qrel,hi);}while(0)
  #define ENDW(tt) do{ if((tt)+3<NT){WAIT_BAR(3);} else if((tt)+2<NT){WAIT_BAR(2);} else {WAIT_BAR(0);} }while(0)
  for(;t+1<NT;t+=2){
    STEP(pB0,pB1,pA0,pA1,t,(t+3<NT),(t+1<NT),(t+1<NT));       ENDW(t);   RESC(); ROT();
    STEP(pA0,pA1,pB0,pB1,t+1,(t+4<NT),(t+2<NT),(t+2<NT));     ENDW(t+1); RESC(); ROT();
  }
  STEP(pB0,pB1,pA0,pA1,NT-1,false,false,false); RESC();
  { float sacc=pB0[0]+pB0[1]; _Pragma("unroll") for(int r=2;r<16;++r)sacc+=pB0[r]; _Pragma("unroll") for(int r=0;r<16;++r)sacc+=pB1[r]; l_reg+=sacc;
    pw0=(u32x4){PKW(pB0,0),PKW(pB0,2),PKW(pB0,4),PKW(pB0,6)};pw1=(u32x4){PKW(pB0,8),PKW(pB0,10),PKW(pB0,12),PKW(pB0,14)};pw2=(u32x4){PKW(pB1,0),PKW(pB1,2),PKW(pB1,4),PKW(pB1,6)};pw3=(u32x4){PKW(pB1,8),PKW(pB1,10),PKW(pB1,12),PKW(pB1,14)};
    SBAR(); pv(o,vb0+sl_cur,PAF(0),PAF(1),PAF(2),PAF(3)); pv(o+2,vb0+(LDS_V2-LDS_V)+sl_cur,PAF(0),PAF(1),PAF(2),PAF(3)); }
  #undef PKW
  #undef PAF
  #undef VFR
  #undef PIN
  #undef MX3
  #undef GAPA
  #undef GAPB
  #undef EX
  #undef VRD
  #undef KRD
  #undef STEP
  #undef ENDW
  {auto rr=__builtin_amdgcn_permlane32_swap(__float_as_uint(l_reg),__float_as_uint(l_reg),false,false);l_reg=__uint_as_float(rr[0])+__uint_as_float(rr[1]);}
  if(hi==0)wsf[32+r32]=l_reg;asm volatile("s_waitcnt lgkmcnt(0)":::"memory");
  float rli[16];
  #pragma unroll
  for(int r=0;r<16;++r)rli[r]=__builtin_amdgcn_rcpf(wsf[32+crow(r,hi)]);
  bf16*Ow=Ob+(long)(q0+wid*QBLK)*PO;
  { bf16*stg=(bf16*)(shm+LDS_OST)+wid*2048;
    f32x8a dd[2][4];
    #pragma unroll
    for(int ph=0;ph<2;++ph){
      #pragma unroll
      for(int r=0;r<16;++r){const int orow=crow(r,hi);
        #pragma unroll
        for(int d0=0;d0<2;++d0)stg[orow*64+d0*32+r32]=__float2bfloat16(o[2*ph+d0][r]*rli[r]);}
      asm volatile("s_waitcnt lgkmcnt(0)":::"memory");
      #pragma unroll
      for(int i=0;i<4;++i){const int row=i*8+(lane>>3),ch=lane&7; const u32x4 v=*(const u32x4*)(stg+row*64+ch*8);
        if constexpr(MODE==0){ ATTN_STORE16(Ow+(long)row*PO+ph*64+ch*8,v); }
        else { const u32x4 w0=__builtin_nontemporal_load((const u32x4*)(Ob0+(long)(q0+wid*QBLK+row)*PO+ph*64+ch*8)); dd[ph][i]=unpk8(w0)-unpk8(v)*lam; } }
      asm volatile("s_waitcnt lgkmcnt(0)":::"memory"); }
    if constexpr(MODE==1){
      #pragma unroll
      for(int i=0;i<4;++i){const int row=i*8+(lane>>3),ch=lane&7; float ss=0.f;
        #pragma unroll
        for(int ph=0;ph<2;++ph){ _Pragma("unroll") for(int k=0;k<8;++k)ss+=dd[ph][i][k]*dd[ph][i][k]; }
        ss+=__shfl_xor(ss,1);ss+=__shfl_xor(ss,2);ss+=__shfl_xor(ss,4);
        const float rr=dscale/sqrtf(ss*(1.f/128.f)+1e-6f);
        #pragma unroll
        for(int ph=0;ph<2;++ph){ const float*gp=gsub+ph*64+ch*8; const f32x4a ga=*(const f32x4a*)gp, gb=*(const f32x4a*)(gp+4);
          const f32x8a d=dd[ph][i]*rr; u32x4 w; w.x=cvtpk_s(d[0]*ga[0],d[1]*ga[1]); w.y=cvtpk_s(d[2]*ga[2],d[3]*ga[3]); w.z=cvtpk_s(d[4]*gb[0],d[5]*gb[1]); w.w=cvtpk_s(d[6]*gb[2],d[7]*gb[3]);
          ATTN_STORE16(Ow+(long)row*PO+ph*64+ch*8,w); } } } }
  asm volatile("s_waitcnt lgkmcnt(0)\n\ts_barrier":::"memory");
  #undef DMA_K
  #undef DMA_V
  #undef CMASK
  #undef START
  #undef RESC
  #undef ROT
}
#undef SBAR
#undef WAIT_BAR
}
#define GAS __attribute__((address_space(1)))
#define LAS __attribute__((address_space(3)))
typedef unsigned short bfu;
typedef unsigned v4u __attribute__((ext_vector_type(4)));
typedef unsigned v2u __attribute__((ext_vector_type(2)));
typedef float f32x4 __attribute__((ext_vector_type(4)));
typedef float f32x8 __attribute__((ext_vector_type(8)));
typedef float f32x16 __attribute__((ext_vector_type(16)));
typedef short bf16x8 __attribute__((ext_vector_type(8)));
typedef short s16x4 __attribute__((ext_vector_type(4)));

constexpr int NWAVES = 8;
constexpr int NB = 8, SEQL = 2048, DMODEL = 2048, MTOK = NB * SEQL, MEML = 256, MROWS = NB * MEML;
constexpr int NIN = 5120, NKV = 1024, FFH = 5632, NGU = 2 * FFH;
constexpr int C_U = 0, C_C = 512, C_B = 1024, C_Q = 1536, C_K = 2560, C_V = 3584, C_QM = 4608;
constexpr float EPS = 1e-6f;
constexpr float LOG2E = 1.4426950408889634f;
constexpr float C2Q = 0.125f * LOG2E;
constexpr float C2M = 0.08838834764831845f * LOG2E;
constexpr float LAM_INIT = 0.2f;

constexpr size_t MiB = 1u << 20;
constexpr size_t WS_BAR = 0, BAR_ZERO_BYTES = 16384;
constexpr size_t WS_ROWSS2 = 65536 + 262144;
constexpr size_t WS_ROWSS = 65536;
constexpr size_t WS_WIN = 2 * MiB, WS_WKV = 22 * MiB, WS_WO = 26 * MiB, WS_WGU = 34 * MiB, WS_WD = 78 * MiB;
constexpr size_t WS_HB = 100 * MiB, WS_MEMN = 164 * MiB, WS_KVM = 172 * MiB, WS_VMT = 176 * MiB;
constexpr size_t WS_PROJ = 178 * MiB, WS_ODIFF = 338 * MiB, WS_MIXED = 402 * MiB, WS_OMEM = 466 * MiB, WS_END = 482 * MiB;
constexpr size_t WS_ACT = WS_PROJ;
static_assert(WS_ACT + (size_t)MTOK * FFH * 2 <= WS_MIXED, "act overlay");

constexpr int LDS_BARST = 147456 - 64;
constexpr int LDS_BYTES = 147456;

#define LDS_WAIT() asm volatile("s_waitcnt lgkmcnt(0)" ::: "memory")
__device__ __forceinline__ unsigned f2bf(float f) { unsigned u = __builtin_bit_cast(unsigned, f); return (u + 0x7fffu + ((u >> 16) & 1u)) >> 16; }
__device__ __forceinline__ unsigned pk2(float lo, float hi) { return f2bf(lo) | (f2bf(hi) << 16); }
__device__ __forceinline__ float bf_lo(unsigned w) { return __builtin_bit_cast(float, w << 16); }
__device__ __forceinline__ float bf_hi(unsigned w) { return __builtin_bit_cast(float, w & 0xffff0000u); }
__device__ __forceinline__ f32x8 unpack8(v4u w) { f32x8 t; t[0] = bf_lo(w.x); t[1] = bf_hi(w.x); t[2] = bf_lo(w.y); t[3] = bf_hi(w.y); t[4] = bf_lo(w.z); t[5] = bf_hi(w.z); t[6] = bf_lo(w.w); t[7] = bf_hi(w.w); return t; }
__device__ __forceinline__ v4u pack8(f32x8 t) { v4u w; w.x = pk2(t[0], t[1]); w.y = pk2(t[2], t[3]); w.z = pk2(t[4], t[5]); w.w = pk2(t[6], t[7]); return w; }
__device__ __forceinline__ f32x8 ld8f(const float* p) { const f32x4 a = *(const f32x4*)p, b = *(const f32x4*)(p + 4); f32x8 t; t[0] = a.x; t[1] = a.y; t[2] = a.z; t[3] = a.w; t[4] = b.x; t[5] = b.y; t[6] = b.z; t[7] = b.w; return t; }
__device__ __forceinline__ float sumsq8(f32x8 t) { return ((t[0] * t[0] + t[1] * t[1]) + (t[2] * t[2] + t[3] * t[3])) + ((t[4] * t[4] + t[5] * t[5]) + (t[6] * t[6] + t[7] * t[7])); }
__device__ __forceinline__ float wave_sum(float v) {
#pragma unroll
    for (int o = 1; o < 64; o <<= 1) v += __shfl_xor(v, o);
    return v;
}
__device__ __forceinline__ float rsq(float v) { return 1.0f / sqrtf(v); }

__device__ __forceinline__ void p0_transpose_item(const float* W, int K, int N, bfu* WT, int mode, const float* gk, LAS float* scr, int item, int lane) {
    const int nblk = N / 32, kb = item / nblk, nb = item % nblk, k0 = 64 * kb, n0 = 32 * nb;
    const int r0 = (mode == 0) ? n0 : (mode == 3) ? (256 * (n0 >> 8) + 128 * ((n0 >> 5) & 1) + 32 * ((n0 >> 6) & 3)) : (256 * (n0 >> 7) + (mode == 2 ? 128 : 0) + (n0 & 127));
#pragma unroll 8
    for (int i = 0; i < 32; ++i) { const int kk = 2 * i + (lane >> 5); scr[kk * 33 + (lane & 31)] = __builtin_nontemporal_load(W + (size_t)(k0 + kk) * N + n0 + (lane & 31)); }
    LDS_WAIT(); asm volatile("" ::: "memory");
    const int c = lane & 7;
    f32x8 gg; if (gk) gg = ld8f(gk + k0 + 8 * c); else { _Pragma("unroll") for (int i = 0; i < 8; ++i) gg[i] = 1.0f; }
    const bool pairperm = MK_FUSE_PREP && mode == 3 && n0 >= C_Q && n0 < C_V && ((n0 >> 5) & 1) == 0;
#pragma unroll
    for (int j = 0; j < 4; ++j) { const int n = (lane >> 3) + 8 * j; const LAS float* s = scr + (8 * c) * 33 + n;
        v4u o; o.x = pk2(s[0 * 33] * gg[0], s[1 * 33] * gg[1]); o.y = pk2(s[2 * 33] * gg[2], s[3 * 33] * gg[3]); o.z = pk2(s[4 * 33] * gg[4], s[5 * 33] * gg[5]); o.w = pk2(s[6 * 33] * gg[6], s[7 * 33] * gg[7]);
        const int nd = (pairperm && n < 16) ? (8 * ((n >> 2) & 1) + 4 * (n >> 3) + (n & 3)) : n;
        *(v4u*)(WT + (size_t)(r0 + nd) * K + k0 + 8 * c) = o; }
    LDS_WAIT(); asm volatile("" ::: "memory");
}
__device__ __forceinline__ void rms_row_to_bf16(const float* xrow, const float* g, bfu* orow, int lane) {
    const f32x4* xr = (const f32x4*)xrow + lane; const f32x4* gr = (const f32x4*)g + lane;
    f32x4 v[8]; float s = 0.f;
#pragma unroll
    for (int j = 0; j < 8; ++j) { v[j] = __builtin_nontemporal_load(xr + 64 * j); s += (v[j].x * v[j].x + v[j].y * v[j].y) + (v[j].z * v[j].z + v[j].w * v[j].w); }
    const float r = rsq(wave_sum(s) * (1.f / DMODEL) + EPS);
    unsigned long long* o8 = (unsigned long long*)orow + lane;
#pragma unroll
    for (int j = 0; j < 8; ++j) { const f32x4 gg = gr[64 * j]; const f32x4 o = v[j] * r * gg;
        o8[64 * j] = (unsigned long long)pk2(o.x, o.y) | ((unsigned long long)pk2(o.z, o.w) << 32); }
}

__device__ __forceinline__ void prep_phase(bfu* PROJ, bfu* DST, int dmask, const int* positions, const float* g_dq, const float* g_dk, const float* g_mq, int gw, int NGW, int lane) {
    const int sub = lane & 7;
    const f32x8 gq = ld8f(g_dq + 8 * sub), gk = ld8f(g_dk + 8 * sub), gmq = ld8f(g_mq + 8 * (lane & 15));
    constexpr double I2PI = 0.15915494309189535;
    constexpr double IF0 = 1.0 * I2PI, IF1 = 0.19392274474868576 * I2PI, IF2 = 0.03760603093086393 * I2PI, IF3 = 0.007292664737217109 * I2PI,
                     IF4 = 0.001414213562373095 * I2PI, IF5 = 0.0002742481756762073 * I2PI, IF6 = 5.318295896944988e-05 * I2PI, IF7 = 1.031338537721246e-05 * I2PI;
    v4u nx[5]; int npos = 0;
#define PREP_LOAD(mm) { const bfu* pr_ = PROJ + (size_t)(mm) * NIN; _Pragma("unroll") for (int s_ = 0; s_ < 4; ++s_) nx[s_] = *(const v4u*)(pr_ + C_Q + s_ * 512 + lane * 8); nx[4] = *(const v4u*)(pr_ + C_QM + lane * 8); npos = positions[mm]; }
    if (gw < MTOK) PREP_LOAD(gw)
    for (int m = gw; m < MTOK; m += NGW) {
        bfu* drow = DST + (size_t)(m & dmask) * NIN;
        v4u cu[5];
#pragma unroll
        for (int s_ = 0; s_ < 5; ++s_) cu[s_] = nx[s_];
        const double pos = (double)npos;
        if (m + NGW < MTOK) PREP_LOAD(m + NGW)
        f32x8 cs, sn;
#define ROPE_J(j, IFJ) { double rev = pos * (IFJ); rev -= __builtin_rint(rev); const float fr = (float)rev; cs[j] = __builtin_amdgcn_cosf(fr); sn[j] = __builtin_amdgcn_sinf(fr); }
        ROPE_J(0, IF0) ROPE_J(1, IF1) ROPE_J(2, IF2) ROPE_J(3, IF3) ROPE_J(4, IF4) ROPE_J(5, IF5) ROPE_J(6, IF6) ROPE_J(7, IF7)
#undef ROPE_J
#pragma unroll
        for (int st = 0; st < 4; ++st) {
            f32x8 t = unpack8(cu[st]);
            float ss = sumsq8(t); ss += __shfl_xor(ss, 1); ss += __shfl_xor(ss, 2); ss += __shfl_xor(ss, 4);
            const float r = rsq(ss * (1.f / 64.f) + EPS);
            const f32x8 g = (st < 2) ? gq : gk;
#pragma unroll
            for (int i = 0; i < 8; ++i) t[i] = t[i] * r * g[i];
            f32x8 o;
#pragma unroll
            for (int i = 0; i < 8; ++i) { const float other = __shfl_xor(t[i], 1);
                o[i] = (sub == 0) ? (t[i] * cs[i] - other * sn[i]) : ((sub == 1) ? (t[i] * cs[i] + other * sn[i]) : t[i]); }
            if (st < 2) {
#pragma unroll
                for (int i = 0; i < 8; ++i) o[i] *= C2Q;
            }
            *(v4u*)(drow + C_Q + st * 512 + lane * 8) = pack8(o);
        }
        {
            f32x8 t = unpack8(cu[4]);
            float ss = sumsq8(t); ss += __shfl_xor(ss, 1); ss += __shfl_xor(ss, 2); ss += __shfl_xor(ss, 4); ss += __shfl_xor(ss, 8);
            const float r = rsq(ss * (1.f / 128.f) + EPS) * C2M;
#pragma unroll
            for (int i = 0; i < 8; ++i) t[i] = t[i] * r * gmq[i];
            *(v4u*)(drow + C_QM + lane * 8) = pack8(t);
        }
    }
#undef PREP_LOAD
}

namespace memattn {
constexpr int KSTR = 272, VSTR = 520;
constexpr int LDS_KM = 0, LDS_VT = MEML * KSTR, LDS_TOTAL = LDS_VT + 128 * VSTR;
static_assert(LDS_TOTAL <= LDS_BYTES, "mem-attn LDS");
__device__ __forceinline__ int crow(int r, int hi) { return (r & 3) + 8 * (r >> 2) + 4 * hi; }
__device__ __forceinline__ unsigned cvtpk(float lo, float hi) { typedef float f2 __attribute__((ext_vector_type(2))); typedef __bf16 b2 __attribute__((ext_vector_type(2))); f2 v = {lo, hi}; b2 b = __builtin_convertvector(v, b2); return __builtin_bit_cast(unsigned, b); }
__device__ __forceinline__ bf16x8 pack_half(const f32x16& p, int s) { v4u w; w.x = cvtpk(p[8 * s], p[8 * s + 1]); w.y = cvtpk(p[8 * s + 2], p[8 * s + 3]); w.z = cvtpk(p[8 * s + 4], p[8 * s + 5]); w.w = cvtpk(p[8 * s + 6], p[8 * s + 7]); return __builtin_bit_cast(bf16x8, w); }
__device__ __forceinline__ void mem_unit(int tid, int b, int h, int qblk, const bfu* PROJ, const bfu* KVM, const float* g_mk, const float* g_mq, bfu* MIXED, float* rowss2, LAS unsigned char* lds) {
    const int lane = tid & 63, r32 = lane & 31, hi = lane >> 5; const int wid = __builtin_amdgcn_readfirstlane(tid >> 6);
    { const f32x8 gmk = ld8f(g_mk + 8 * (tid & 15));
#pragma unroll
      for (int i = 0; i < 8; ++i) { const int c = tid + 512 * i, kv = c >> 4, ch = c & 15;
        f32x8 t = unpack8(*(const v4u*)(KVM + (size_t)(b * MEML + kv) * NKV + h * 128 + ch * 8));
        float ss = sumsq8(t); ss += __shfl_xor(ss, 1); ss += __shfl_xor(ss, 2); ss += __shfl_xor(ss, 4); ss += __shfl_xor(ss, 8);
        const float r = rsq(ss * (1.f / 128.f) + EPS);
        t = t * r * gmk;
        *(LAS v4u*)(lds + LDS_KM + kv * KSTR + ch * 16) = pack8(t); } }
#pragma unroll
    for (int i = 0; i < 8; ++i) { const int c = tid + 512 * i, kv = c & 255, ch = c >> 8;
        const v4u w = *(const v4u*)(KVM + (size_t)(b * MEML + kv) * NKV + 512 + h * 128 + ch * 8);
        LAS bfu* dst = (LAS bfu*)(lds + LDS_VT + (ch * 8) * VSTR + kv * 2);
        dst[0 * (VSTR / 2)] = (bfu)(w.x & 0xffffu); dst[1 * (VSTR / 2)] = (bfu)(w.x >> 16); dst[2 * (VSTR / 2)] = (bfu)(w.y & 0xffffu); dst[3 * (VSTR / 2)] = (bfu)(w.y >> 16);
        dst[4 * (VSTR / 2)] = (bfu)(w.z & 0xffffu); dst[5 * (VSTR / 2)] = (bfu)(w.z >> 16); dst[6 * (VSTR / 2)] = (bfu)(w.w & 0xffffu); dst[7 * (VSTR / 2)] = (bfu)(w.w >> 16); }
    __syncthreads();
    const size_t row = (size_t)b * SEQL + qblk * 256 + wid * 32 + r32;
    const bfu* qrow = PROJ + row * NIN + C_QM + h * 128 + hi * 8;
    bf16x8 qf[8];
#pragma unroll
    for (int d0 = 0; d0 < 8; ++d0) qf[d0] = *(const bf16x8*)(qrow + d0 * 16);
#if MK_FUSE_PREP
    {
        float ss = 0.f;
#pragma unroll
        for (int d0 = 0; d0 < 8; ++d0) ss += sumsq8(unpack8(__builtin_bit_cast(v4u, qf[d0])));
        ss += __shfl_xor(ss, 32);
        const float r = rsq(ss * (1.f / 128.f) + EPS) * C2M;
#pragma unroll
        for (int d0 = 0; d0 < 8; ++d0) { f32x8 t = unpack8(__builtin_bit_cast(v4u, qf[d0])); const f32x8 g = ld8f(g_mq + d0 * 16 + hi * 8); t = t * r * g; qf[d0] = __builtin_bit_cast(bf16x8, pack8(t)); }
    }
#endif
    f32x16 oT[4];
#pragma unroll
    for (int dt = 0; dt < 4; ++dt)
#pragma unroll
        for (int r = 0; r < 16; ++r) oT[dt][r] = 0.f;
    float mrun = -1e30f, l = 0.f;
#pragma unroll 1
    for (int kc = 0; kc < 4; ++kc) {
        f32x16 p0, p1;
#pragma unroll
        for (int r = 0; r < 16; ++r) { p0[r] = 0.f; p1[r] = 0.f; }
        const LAS unsigned char* kb = lds + LDS_KM + (kc * 64 + r32) * KSTR + hi * 16;
#pragma unroll
        for (int d0 = 0; d0 < 8; ++d0) { const bf16x8 a0 = *(const LAS bf16x8*)(kb + d0 * 32), a1 = *(const LAS bf16x8*)(kb + 32 * KSTR + d0 * 32);
            p0 = __builtin_amdgcn_mfma_f32_32x32x16_bf16(a0, qf[d0], p0, 0, 0, 0); p1 = __builtin_amdgcn_mfma_f32_32x32x16_bf16(a1, qf[d0], p1, 0, 0, 0); }
        float mx = fmaxf(p0[0], p1[0]);
#pragma unroll
        for (int r = 1; r < 16; ++r) mx = fmaxf(mx, fmaxf(p0[r], p1[r]));
        mx = fmaxf(mx, __shfl_xor(mx, 32));
        const float mnew = fmaxf(mrun, mx), f = __builtin_amdgcn_exp2f(mrun - mnew); mrun = mnew;
        l *= f;
#pragma unroll
        for (int dt = 0; dt < 4; ++dt)
#pragma unroll
            for (int r = 0; r < 16; ++r) oT[dt][r] *= f;
        float sacc = 0.f;
#pragma unroll
        for (int r = 0; r < 16; ++r) { p0[r] = __builtin_amdgcn_exp2f(p0[r] - mnew); p1[r] = __builtin_amdgcn_exp2f(p1[r] - mnew); sacc += p0[r] + p1[r]; }
        l += sacc;
        bf16x8 pa[4]; pa[0] = pack_half(p0, 0); pa[1] = pack_half(p0, 1); pa[2] = pack_half(p1, 0); pa[3] = pack_half(p1, 1);
#pragma unroll
        for (int s = 0; s < 4; ++s)
#pragma unroll
            for (int dt = 0; dt < 4; ++dt) { const LAS unsigned char* va = lds + LDS_VT + (dt * 32 + r32) * VSTR + (kc * 64 + 16 * s + 4 * hi) * 2;
                const s16x4 lo = *(const LAS s16x4*)va, h4 = *(const LAS s16x4*)(va + 16);
                const bf16x8 a = __builtin_shufflevector(lo, h4, 0, 1, 2, 3, 4, 5, 6, 7);
                oT[dt] = __builtin_amdgcn_mfma_f32_32x32x16_bf16(a, pa[s], oT[dt], 0, 0, 0); }
    }
    l += __shfl_xor(l, 32);
    const float inv = 1.0f / l;
    bfu* orow = MIXED + row * DMODEL + 1536 + h * 128;
    { float ss = 0.f;
#pragma unroll
      for (int dt = 0; dt < 4; ++dt)
#pragma unroll
          for (int r = 0; r < 16; ++r) { const float v = oT[dt][r] * inv; ss += v * v; }
      ss += __shfl_xor(ss, 32);
      if (hi == 0) unsafeAtomicAdd(rowss2 + row, ss); }
#pragma unroll
    for (int dt = 0; dt < 4; ++dt)
#pragma unroll
        for (int g = 0; g < 4; ++g) { v2u w; w.x = pk2(oT[dt][4 * g] * inv, oT[dt][4 * g + 1] * inv); w.y = pk2(oT[dt][4 * g + 2] * inv, oT[dt][4 * g + 3] * inv);
            *(v2u*)(orow + dt * 32 + 8 * g + 4 * hi) = w; }
    __syncthreads();
}
}

__device__ __forceinline__ void conv_phase(const bfu* PROJ, bfu* MIXED, const float* conv_w, const float* g_conv_out, int gw, int NGW, int lane) {
    const f32x8 w0 = ld8f(conv_w + lane * 8), w1 = ld8f(conv_w + 512 + lane * 8), w2 = ld8f(conv_w + 1024 + lane * 8), gco = ld8f(g_conv_out + lane * 8);
    v4u nx[7];
#define CONV_LOAD(mm) { const int s_ = (mm) & (SEQL - 1); const bfu* p0_ = PROJ + (size_t)(mm) * NIN + lane * 8; const bfu* p1_ = p0_ - (s_ >= 1 ? NIN : 0); const bfu* p2_ = p0_ - (s_ >= 2 ? 2 * NIN : 0); \
        nx[0] = *(const v4u*)(p0_ + C_U); nx[1] = *(const v4u*)(p0_ + C_C); nx[2] = *(const v4u*)(p0_ + C_B); nx[3] = *(const v4u*)(p1_ + C_U); nx[4] = *(const v4u*)(p1_ + C_C); nx[5] = *(const v4u*)(p2_ + C_U); nx[6] = *(const v4u*)(p2_ + C_C); }
    if (gw < MTOK) CONV_LOAD(gw)
    for (int m = gw; m < MTOK; m += NGW) {
        const int s = m & (SEQL - 1);
        v4u cu[7];
#pragma unroll
        for (int i = 0; i < 7; ++i) cu[i] = nx[i];
        if (m + NGW < MTOK) CONV_LOAD(m + NGW)
        const f32x8 z2 = unpack8(cu[0]) * unpack8(cu[1]), bg = unpack8(cu[2]);
        const float k1 = (s >= 1) ? 1.f : 0.f, k0 = (s >= 2) ? 1.f : 0.f;
        const f32x8 z1 = unpack8(cu[3]) * unpack8(cu[4]) * k1, z0 = unpack8(cu[5]) * unpack8(cu[6]) * k0;
        f32x8 y = bg * (w0 * z0 + w1 * z1 + w2 * z2);
        const float r = rsq(wave_sum(sumsq8(y)) * (1.f / 512.f) + EPS);
        y = y * r * gco;
        *(v4u*)(MIXED + (size_t)m * DMODEL + lane * 8) = pack8(y);
    }
#undef CONV_LOAD
}
__device__ __forceinline__ void finalize_phase(const bfu* PROJ, const bfu* ODIFF, const bfu* OMEM, bfu* MIXED, const float* conv_w, const float* g_conv_out, const float* lq1, const float* lk1, const float* lq2, const float* lk2,
                                               const float* g_sub, const float* g_mem_out, int gw, int NGW, int lane) {
#if !MK_FUSE_PREP
    conv_phase(PROJ, MIXED, conv_w, g_conv_out, gw, NGW, lane);
#endif
    const f32x8 gmo = ld8f(g_mem_out + lane * 8);
    const int hd = lane >> 3, sub = lane & 7;
    const f32x8 gs0 = ld8f(g_sub + sub * 16), gs1 = ld8f(g_sub + sub * 16 + 8);
    const float lam = __expf(wave_sum(lq1[lane] * lk1[lane])) - __expf(wave_sum(lq2[lane] * lk2[lane])) + LAM_INIT;
    v4u nx[5];
#define FIN_LOAD(mm) { nx[4] = *(const v4u*)(OMEM + (size_t)(mm) * 512 + lane * 8); }
    if (gw < MTOK) FIN_LOAD(gw)
    for (int m = gw; m < MTOK; m += NGW) {
        bfu* mrow = MIXED + (size_t)m * DMODEL;
        v4u cu[5];
#pragma unroll
        for (int i = 0; i < 5; ++i) cu[i] = nx[i];
        if (m + NGW < MTOK) FIN_LOAD(m + NGW)
        {
            f32x8 t = unpack8(cu[4]);
            const float r = rsq(wave_sum(sumsq8(t)) * (1.f / 512.f) + EPS);
            t = t * r * gmo;
            *(v4u*)(mrow + 1536 + lane * 8) = pack8(t);
        }
    }
#undef FIN_LOAD
}

#define XB_TMO      128
#define XB_XCNT(j)  (256  + 64 * (j))
#define XB_XSUB(j)  (1280 + 64 * (j))
#define XB_XGEN(j)  (2304 + 64 * (j))
#define XB_TOP      3328
#define XB_TOPGEN   3392
#define XCD_BAR_WORDS 3456
#define XB_SPIN_CAP (1u << 18)

__device__ __forceinline__ unsigned xb_ld(unsigned* p)              { return __hip_atomic_load(p, __ATOMIC_RELAXED, __HIP_MEMORY_SCOPE_AGENT); }
__device__ __forceinline__ unsigned xb_add(unsigned* p, unsigned v) { return __hip_atomic_fetch_add(p, v, __ATOMIC_RELAXED, __HIP_MEMORY_SCOPE_AGENT); }
__device__ __forceinline__ unsigned xb_xcc_id() { return (unsigned)__builtin_amdgcn_s_getreg((3 << 11) | 20) & 0xFu; }
#define XB_SPIN(cond, bar) do { unsigned _sp = 0; while (cond) { __builtin_amdgcn_s_sleep(1); \
    if ((++_sp & 255u) == 0u) { if (xb_ld(&(bar)[XB_TMO])) break; if (_sp > XB_SPIN_CAP) { atomicAdd(&(bar)[XB_TMO], 1u); break; } } } } while (0)

struct XcdBarrier {
    unsigned* bar; unsigned x;
    volatile LAS unsigned* st;
};

__device__ __forceinline__ XcdBarrier xcd_barrier_post(unsigned* bar, volatile LAS unsigned* st, int tid) {
    XcdBarrier b; b.bar = bar; b.x = xb_xcc_id(); b.st = st;
    if (tid == 0) (void)xb_add(&bar[XB_XCNT(b.x)], 1u);
    return b;
}
__device__ __forceinline__ void xcd_barrier_complete(unsigned* bar, unsigned x, unsigned& nloc, unsigned& nx) {
    const unsigned G = gridDim.x * gridDim.y * gridDim.z;
    unsigned sum, cnt, mine, sp = 0u;
    for (;;) {
        sum = 0u; cnt = 0u; mine = 0u;
#pragma unroll
        for (unsigned j = 0; j < 16; ++j) { const unsigned c = xb_ld(&bar[XB_XCNT(j)]); sum += c; cnt += (c > 0u) ? 1u : 0u; mine = (j == x) ? c : mine; }
        if (sum == G) break;
        __builtin_amdgcn_s_sleep(1);
        if ((++sp & 255u) == 0u) { if (xb_ld(&bar[XB_TMO])) break; if (sp > XB_SPIN_CAP) { atomicAdd(&bar[XB_TMO], 1u); break; } }
    }
    nloc = mine > 0u ? mine : 1u; nx = cnt > 0u ? cnt : 1u;
}

__device__ __forceinline__ void xcd_barrier(const XcdBarrier& b, int tid) {
    asm volatile("s_waitcnt vmcnt(0)" ::: "memory");
    __syncthreads();
    if (tid == 0) {
        unsigned* bar = b.bar;
        __builtin_amdgcn_s_waitcnt(0);
        unsigned nloc = b.st[0], nx = b.st[1];
        if (nloc == 0u) { xcd_barrier_complete(bar, b.x, nloc, nx); b.st[0] = nloc; b.st[1] = nx; }
        const unsigned old = xb_add(&bar[XB_XSUB(b.x)], 1u);
        const unsigned gen = old / nloc;
        if (old + 1u == (gen + 1u) * nloc) {
            __builtin_amdgcn_fence(__ATOMIC_RELEASE, "agent");
            asm volatile("s_waitcnt vmcnt(0)" ::: "memory");
            const unsigned og = xb_add(&bar[XB_TOP], 1u);
            const unsigned tg = og / nx;
            if (og + 1u == (tg + 1u) * nx) xb_add(&bar[XB_TOPGEN], 1u);
            else XB_SPIN(xb_ld(&bar[XB_TOPGEN]) == tg, bar);
            __builtin_amdgcn_fence(__ATOMIC_ACQUIRE, "agent");
            xb_add(&bar[XB_XGEN(b.x)], 1u);
            asm volatile("s_waitcnt vmcnt(0)" ::: "memory");
        } else {
            XB_SPIN(xb_ld(&bar[XB_XGEN(b.x)]) == gen, bar);
            __builtin_amdgcn_fence(__ATOMIC_ACQUIRE, "agent");
            asm volatile("s_waitcnt vmcnt(0)" ::: "memory");
        }
    }
    __syncthreads();
}

__device__ __forceinline__ int fresh_tid(int wave) { unsigned z; asm volatile("s_mov_b32 %0, 0" : "=s"(z)); return wave * 64 + (int)__builtin_amdgcn_mbcnt_hi(~0u, __builtin_amdgcn_mbcnt_lo(~0u, z)); }
struct Args { const float* in[24]; float* out; unsigned char* ws; int ph_lo, ph_hi; };
constexpr int N_PHASES = 8;
__global__ void __launch_bounds__(NWAVES * 64, 2) mk_fwd(Args a) {
    extern __shared__ __attribute__((aligned(16))) unsigned char lds_raw[];
    LAS unsigned char* lds = (LAS unsigned char*)lds_raw;
    cg::grid_group grid = cg::this_grid();
    const int wave0 = __builtin_amdgcn_readfirstlane((int)threadIdx.x >> 6);
    const int G = gridDim.x, bx = blockIdx.x, vcu = (G % 8 == 0) ? (bx % 8) * (G / 8) + bx / 8 : bx;
    const int NGW = G * NWAVES;
#define LANE_VARS() const int tid_ = fresh_tid(wave0); const int lane = tid_ & 63, wave = wave0, gw = vcu * NWAVES + wave; (void)lane; (void)gw;
    typedef const __attribute__((address_space(4))) Args* kargs_t;
#define KARGS() ({ unsigned long long v_ = (unsigned long long)__builtin_amdgcn_kernarg_segment_ptr(); asm volatile("" : "+s"(v_)); (kargs_t)v_; })
#define WSP(ka, off) ((bfu*)((ka)->ws + (off)))
#define IN(k) (a.ph_lo <= (k) && (k) < a.ph_hi)
#define SEAM(k) do { if (IN(k) && IN((k) + 1)) { xcd_barrier(xbar, fresh_tid(wave0)); if (PROBE_DUP == 100) xcd_barrier(xbar, fresh_tid(wave0)); } } while (0)
    volatile LAS unsigned* xst = (volatile LAS unsigned*)(lds + LDS_BARST);
    { const int t_ = fresh_tid(wave0); if (t_ == 0) { xst[0] = 0u; xst[1] = 0u; } __syncthreads(); }
    XcdBarrier xbar; xbar.bar = (unsigned*)(a.ws + WS_BAR); xbar.x = 0; xbar.st = xst;
    if (a.ph_hi - a.ph_lo > 2) { xbar = xcd_barrier_post((unsigned*)(a.ws + WS_BAR), xst, fresh_tid(wave0)); if (PROBE_DUP == 101) grid.sync(); }

    for (int rep_ = 0; rep_ < (PROBE_DUP == 0 ? 2 : 1); ++rep_) if (IN(0)) {
        LANE_VARS(); kargs_t ka = KARGS(); const float *x = ka->in[0], *mem = ka->in[1], *g_mix = ka->in[3], *g_mem = ka->in[4], *w_in = ka->in[5], *w_mem_kv = ka->in[15], *w_o = ka->in[19], *w_gate = ka->in[21], *w_up = ka->in[22], *w_down = ka->in[23], *g_ffn = ka->in[20];
        bfu *WIN = WSP(ka, WS_WIN), *WKV = WSP(ka, WS_WKV), *WO = WSP(ka, WS_WO), *WGU = WSP(ka, WS_WGU), *WD = WSP(ka, WS_WD), *HB = WSP(ka, WS_HB), *MEMN = WSP(ka, WS_MEMN);
        LAS float* scr = (LAS float*)(lds + wave * 16384);
        constexpr int I_IN = (DMODEL / 64) * (NIN / 32), I_KV = (DMODEL / 64) * (NKV / 32), I_O = (DMODEL / 64) * (DMODEL / 32), I_G = (DMODEL / 64) * (FFH / 32), I_D = (FFH / 64) * (DMODEL / 32);
        constexpr int NITEMS = I_IN + I_KV + (MK_FUSE_PREP ? 0 : 2 * I_G);
        for (int it = gw; it < NITEMS; it += NGW) {
            int r = it;
            if (r < I_IN) { p0_transpose_item(w_in, DMODEL, NIN, WIN, 3, nullptr, scr, r, lane); continue; } r -= I_IN;
            if (r < I_KV) { p0_transpose_item(w_mem_kv, DMODEL, NKV, WKV, 0, nullptr, scr, r, lane); continue; } r -= I_KV;
            if (r < I_G) { p0_transpose_item(w_gate, DMODEL, FFH, WGU, 1, g_ffn, scr, r, lane); continue; } r -= I_G;
            p0_transpose_item(w_up, DMODEL, FFH, WGU, 2, g_ffn, scr, r, lane);
        }
        { float* rowss = (float*)(ka->ws + WS_ROWSS); float* rowss2 = (float*)(ka->ws + WS_ROWSS2); for (int i = gw * 64 + lane; i < MTOK; i += NGW * 64) { rowss[i] = 0.f; rowss2[i] = 0.f; } }
        for (int m = gw; m < MTOK; m += NGW) rms_row_to_bf16(x + (size_t)m * DMODEL, g_mix, HB + (size_t)m * DMODEL, lane);
        for (int m = gw; m < MROWS; m += NGW) rms_row_to_bf16(mem + (size_t)m * DMODEL, g_mem, MEMN + (size_t)m * DMODEL, lane);
        __syncthreads();
    }
    SEAM(0);
    for (int rep_ = 0; rep_ < (PROBE_DUP == 1 ? 2 : 1); ++rep_) if (IN(1)) {
        kargs_t ka = KARGS(); bfu *WIN = WSP(ka, WS_WIN), *HB = WSP(ka, WS_HB), *PROJ = WSP(ka, WS_PROJ);
        { pg8::Gemm g{HB, WIN, MTOK, NIN, DMODEL}; pg8::StaticOrder S; S.init(MTOK, NIN, G, bx); pg8::EpiProj<MK_FUSE_PREP != 0> E{PROJ, NIN, (const int*)ka->in[2], ka->in[8], ka->in[9], C2Q, EPS};
          pg8::gemm_phase<pg8::EpiProj<MK_FUSE_PREP != 0>, pg8::StaticOrder, true, true>(fresh_tid(wave0), lds, g, S, E); }
    }
    SEAM(1);
    for (int rep_ = 0; rep_ < (PROBE_DUP == 2 ? 2 : 1); ++rep_) if (IN(2)) {
        constexpr int NGEMM = 32; const bool split = G >= 2 * NGEMM;
        if (!split || bx < NGEMM) { kargs_t ka = KARGS(); pg8::Gemm g{WSP(ka, WS_MEMN), WSP(ka, WS_WKV), MROWS, NKV, DMODEL}; pg8::StaticOrder S; S.init(MROWS, NKV, split ? NGEMM : G, bx); pg8::EpiStoreBf16 E{WSP(ka, WS_KVM), NKV};
            pg8::gemm_phase<pg8::EpiStoreBf16, pg8::StaticOrder, true, true>(fresh_tid(wave0), lds, g, S, E); }
        if (!split || bx >= NGEMM) { LANE_VARS(); kargs_t ka = KARGS(); const int ci = split ? bx - NGEMM : bx, ncu = split ? G - NGEMM : G;
#if !MK_FUSE_PREP
            prep_phase(WSP(ka, WS_PROJ), WSP(ka, WS_PROJ), 0xffffff, (const int*)ka->in[2], ka->in[8], ka->in[9], ka->in[16], ci * NWAVES + wave, ncu * NWAVES, lane);
#else
            conv_phase(WSP(ka, WS_PROJ), WSP(ka, WS_MIXED), ka->in[6], ka->in[7], ci * NWAVES + wave, ncu * NWAVES, lane);
#endif
            { constexpr int I_O = (DMODEL / 64) * (DMODEL / 32), I_D = (FFH / 64) * (DMODEL / 32), I_G = MK_FUSE_PREP ? (DMODEL / 64) * (FFH / 32) : 0; LAS float* scr = (LAS float*)(lds + wave * 16384);
              const float *w_o = ka->in[19], *w_down = ka->in[23]; bfu *WO = WSP(ka, WS_WO), *WD = WSP(ka, WS_WD);
              for (int it = ci * NWAVES + wave; it < I_O + I_D + 2 * I_G; it += ncu * NWAVES) { int r = it;
                  if (r < I_O) { p0_transpose_item(w_o, DMODEL, DMODEL, WO, 0, (64 * (r / (DMODEL / 32)) >= 1536) ? ka->in[18] - 1536 : nullptr, scr, r, lane); continue; } r -= I_O;
                  if (r < I_D) { p0_transpose_item(w_down, FFH, DMODEL, WD, 0, nullptr, scr, r, lane); continue; } r -= I_D;
                  if (r < I_G) { p0_transpose_item(ka->in[21], DMODEL, FFH, WSP(ka, WS_WGU), 1, ka->in[20], scr, r, lane); continue; } r -= I_G;
                  p0_transpose_item(ka->in[22], DMODEL, FFH, WSP(ka, WS_WGU), 2, ka->in[20], scr, r, lane); }
              __syncthreads(); } }
    }
    SEAM(2);
    for (int rep_ = 0; rep_ < (PROBE_DUP == 3 ? 2 : 1); ++rep_) if (IN(3)) {
        kargs_t ka = KARGS(); bfu *PROJ = WSP(ka, WS_PROJ), *ODIFF = WSP(ka, WS_ODIFF), *KVM = WSP(ka, WS_KVM);
        for (int s = vcu; s < NB * 32; s += G) {
            const int pr = s & 3, h = (s >> 2) & 7, b = s >> 5;
            const attn_body::bf16* base = (const attn_body::bf16*)PROJ + (size_t)b * SEQL * NIN;
            const attn_body::bf16* Q0 = base + C_Q + h * 128; const attn_body::bf16* K0 = base + C_K + h * 128; const attn_body::bf16* Vh = base + C_V + h * 128;
            attn_body::bf16* Opark = (attn_body::bf16*)ODIFF + (size_t)b * SEQL * DMODEL + h * 256;
            attn_body::bf16* Omix = (attn_body::bf16*)WSP(ka, WS_MIXED) + (size_t)b * SEQL * DMODEL + 512 + h * 128;
            float lam; { LANE_VARS(); lam = __expf(wave_sum(ka->in[10][lane] * ka->in[11][lane])) - __expf(wave_sum(ka->in[12][lane] * ka->in[13][lane])) + LAM_INIT; }
            const float* gsub = ka->in[14];
#define AU2_(q) do { attn_body::attn_unit<8, 0>(fresh_tid(wave0), (q), Q0, K0, Vh, Opark, (char*)lds_raw, nullptr, 0.f, nullptr, 0.f); \
                     attn_body::attn_unit<8, 1>(fresh_tid(wave0), (q), Q0 + 64, K0 + 64, Vh, Omix, (char*)lds_raw, Opark, lam, gsub, 1.0f - LAM_INIT); } while (0)
            if (pr == 0) { AU2_(7); AU2_(0); } else if (pr == 1) { AU2_(6); AU2_(1); } else if (pr == 2) { AU2_(5); AU2_(2); } else { AU2_(4); AU2_(3); }
#undef AU2_
        }
        for (int mrep_ = 0; mrep_ < (PROBE_DUP == 103 ? 2 : 1); ++mrep_)
        for (int u = vcu; u < NB * 4 * 8; u += G) memattn::mem_unit(fresh_tid(wave0), u >> 5, (u >> 3) & 3, u & 7, PROJ, KVM, ka->in[17], ka->in[16], WSP(ka, WS_MIXED), (float*)(ka->ws + WS_ROWSS2), lds);
    }
    SEAM(3);
    for (int rep_ = 0; rep_ < (PROBE_DUP == 5 ? 2 : 1); ++rep_) if (IN(5)) { kargs_t ka = KARGS(); const float* x = ka->in[0]; bfu *MIXED = WSP(ka, WS_MIXED), *WO = WSP(ka, WS_WO);
        pg8::Gemm g{MIXED, WO, MTOK, DMODEL, DMODEL}; pg8::StaticOrder S; S.init(MTOK, DMODEL, G, bx); pg8::EpiResNormMid E{x, DMODEL, WSP(ka, WS_HB), (float*)(ka->ws + WS_ROWSS + (rep_ == 0 ? 0 : 131072)), (const float*)(ka->ws + WS_ROWSS2), 1.0f / 512.0f, EPS};
        pg8::gemm_phase<pg8::EpiResNormMid, pg8::StaticOrder, true, true>(fresh_tid(wave0), lds, g, S, E); }
    SEAM(5);
    for (int rep_ = 0; rep_ < (PROBE_DUP == 6 ? 2 : 1); ++rep_) if (IN(6)) { kargs_t ka = KARGS(); bfu *HB = WSP(ka, WS_HB), *WGU = WSP(ka, WS_WGU), *ACT = WSP(ka, WS_ACT);
        pg8::Gemm g{HB, WGU, MTOK, NGU, DMODEL}; pg8::StaticOrder S; S.init(MTOK, NGU, G, bx); pg8::EpiSwiGLU E{ACT, FFH, (const float*)(ka->ws + WS_ROWSS), 1.0f / DMODEL, EPS};
        pg8::gemm_phase<pg8::EpiSwiGLU, pg8::StaticOrder, true, true>(fresh_tid(wave0), lds, g, S, E); }
    SEAM(6);
    for (int rep_ = 0; rep_ < (PROBE_DUP == 7 ? 2 : 1); ++rep_) if (IN(7)) { kargs_t ka = KARGS(); float* out = ka->out; bfu *ACT = WSP(ka, WS_ACT), *WD = WSP(ka, WS_WD);
        pg8::Gemm g{ACT, WD, MTOK, DMODEL, FFH}; pg8::StaticOrder S; S.init(MTOK, DMODEL, G, bx); pg8::EpiResBf16 E{WSP(ka, WS_HB), out, DMODEL};
        pg8::gemm_phase<pg8::EpiResBf16, pg8::StaticOrder, true, true>(fresh_tid(wave0), lds, g, S, E); }
#undef IN
#undef SEAM
#undef KARGS
#undef LANE_VARS
#undef WSP
}

extern "C" void kernel_launch(void* const* d_in, const int* in_sizes, int n_in, void* d_out, int out_size, void* d_ws, size_t ws_size, hipStream_t stream) {
    static int grid = 0;
    if (grid == 0) {
        if (n_in != 24 || in_sizes[0] != MTOK * DMODEL || out_size != MTOK * DMODEL || ws_size < WS_END) {
            fprintf(stderr, "kernel_launch: unexpected shapes (n_in %d, in0 %d, out %d, ws %zu); nothing launched\n", n_in, n_in > 0 ? in_sizes[0] : -1, out_size, ws_size); grid = -1; return; }
        int dev = 0, cus = 0, per_cu = 0;
        if (hipGetDevice(&dev) != hipSuccess || hipDeviceGetAttribute(&cus, hipDeviceAttributeMultiprocessorCount, dev) != hipSuccess) { fprintf(stderr, "kernel_launch: device query failed\n"); grid = -1; return; }
        if (hipFuncSetAttribute((const void*)mk_fwd, hipFuncAttributeMaxDynamicSharedMemorySize, LDS_BYTES) != hipSuccess) { fprintf(stderr, "kernel_launch: hipFuncSetAttribute failed\n"); grid = -1; return; }
        if (hipOccupancyMaxActiveBlocksPerMultiprocessor(&per_cu, (const void*)mk_fwd, NWAVES * 64, LDS_BYTES) != hipSuccess || per_cu < 1) { fprintf(stderr, "kernel_launch: occupancy query reports %d workgroups per CU\n", per_cu); (void)hipGetLastError(); grid = -1; return; }
        grid = cus;
    }
    if (grid < 0) return;
    if (hipMemsetAsync((char*)d_ws + WS_BAR, 0, BAR_ZERO_BYTES, stream) != hipSuccess) { fprintf(stderr, "kernel_launch: hipMemsetAsync of the barrier words failed\n"); return; }
    Args a{};
    for (int i = 0; i < 24; ++i) a.in[i] = (const float*)d_in[i];
    a.out = (float*)d_out; a.ws = (unsigned char*)d_ws;
#if MK_MULTI
    for (int p = 0; p < N_PHASES; ++p) { a.ph_lo = p; a.ph_hi = p + 1; hipLaunchKernelGGL(mk_fwd, dim3(grid), dim3(NWAVES * 64), LDS_BYTES, stream, a); }
#else
    a.ph_lo = 0; a.ph_hi = N_PHASES;
    void* args[] = {&a};
    const hipError_t e = hipLaunchCooperativeKernel((const void*)mk_fwd, dim3(grid), dim3(NWAVES * 64), args, LDS_BYTES, stream);
    if (e != hipSuccess) fprintf(stderr, "kernel_launch: cooperative launch failed: %s (grid %d)\n", hipGetErrorString(e), grid);
#endif
}
```

```cpp
#include <hip/hip_runtime.h>
#include <hip/hip_cooperative_groups.h>
#include <cstdio>
#include <cstdint>
namespace cg = cooperative_groups;
#ifndef MK_MULTI
#define MK_MULTI 0
#endif
#ifndef PROBE_DUP
#define PROBE_DUP -1
#endif
#ifndef MK_FUSE_PREP
#define MK_FUSE_PREP 1
#endif
namespace pg8 {
#define PG8_LAS __attribute__((address_space(3)))
typedef unsigned short bf16_t;
typedef short bf16x8 __attribute__((ext_vector_type(8)));
typedef float f32x4 __attribute__((ext_vector_type(4)));
typedef unsigned u32x4 __attribute__((ext_vector_type(4)));
constexpr int BM = 256, BK = 64, HALF = 128, HTB = HALF * BK * 2  , STAGE_BYTES = 8 * HTB, NXCD = 8, WGM = 8;

__host__ __device__ __forceinline__ int lds_byte(int r, int c) { const int st = (r >> 4) * 2 + (c >> 5), rr = r & 15, cc = c & 31, ob = rr * 64 + cc * 2; return st * 1024 + (ob ^ (((ob >> 9) & 1) << 5)); }
__host__ __device__ __forceinline__ void stage_rc(int b, int& R, int& C) { const int st = b / 1024, sb = b % 1024, swz = sb ^ (((sb >> 9) & 1) << 5); R = (st >> 1) * 16 + swz / 64; C = (st & 1) * 32 + (swz % 64) / 2; }
__host__ __device__ __forceinline__ int perm32(int rho) { const int n = rho >> 4, i = rho & 15; return 8 * (i >> 2) + 4 * n + (i & 3); }

struct Unit { int pm, pn; };
struct Gemm { const bf16_t* A; const bf16_t* Bt; int M, N, K; };

struct StaticOrder {
    int nM, nN, nwg, G, c;
    __host__ __device__ void init(int M, int N, int G_, int c_) { nM = M / BM; nN = N / BM; nwg = nM * nN; G = G_; c = c_; }
    __host__ __device__ bool next(int i, Unit& u) const {
        const long L = (long)i * G + c; if (L >= nwg) return false;
        int wgid = (int)L; { const int q = nwg / NXCD, r = nwg % NXCD, xcd = wgid % NXCD, off = wgid / NXCD; wgid = (xcd < r ? xcd * (q + 1) : r * (q + 1) + (xcd - r) * q) + off; }
        const int nig = WGM * nN, gid = wgid / nig, fm = gid * WGM, gsz = (nM - fm) < WGM ? (nM - fm) : WGM;
        u.pm = fm + ((wgid % nig) % gsz); u.pn = (wgid % nig) / gsz; return true;
    }
    __device__ __forceinline__ void a_ready(const Unit&) const {}
    __device__ __forceinline__ void done(const Unit&) const {}
};
__device__ __forceinline__ unsigned cvt_pk_bf16(float lo, float hi) { unsigned r; asm volatile("v_cvt_pk_bf16_f32 %0, %1, %2" : "=v"(r) : "v"(lo), "v"(hi)); return r; }
typedef unsigned u32x2 __attribute__((ext_vector_type(2)));
template <bool FUSE> struct EpiProj {
    static constexpr bool PERM = true, AFTER_DRAIN = false; static constexpr int MID_T = -1;
    bf16_t* O; int ldc; const int* positions; const float* g_dq; const float* g_dk; float qscale, eps;
    __device__ __forceinline__ void operator()(const f32x4 (&acc)[2][2][4][2], const Unit& u, int wr, int wc, int fr, int fq) const {
        const int row0 = u.pm * BM + wr * 64 + fr, col0 = u.pn * BM + wc * 64 + 8 * fq;
        const bool qk = FUSE && u.pn >= 6 && u.pn < 14;
        if (!qk) {
#pragma unroll
            for (int ai = 0; ai < 2; ++ai)
#pragma unroll
                for (int m = 0; m < 4; ++m) { bf16_t* rowp = O + (size_t)(row0 + ai * HALF + m * 16) * ldc + col0;
#pragma unroll
                    for (int bj = 0; bj < 2; ++bj) { const f32x4 v0 = acc[ai][bj][m][0], v1 = acc[ai][bj][m][1];
                        u32x4 w; w.x = cvt_pk_bf16(v0[0], v0[1]); w.y = cvt_pk_bf16(v0[2], v0[3]); w.z = cvt_pk_bf16(v1[0], v1[1]); w.w = cvt_pk_bf16(v1[2], v1[3]);
                        *(u32x4*)(rowp + bj * 32) = w; } }
        } else {
            const bool isq = u.pn < 10, lo = fq < 2;
            const float* gb = isq ? g_dq : g_dk;
            const int d00 = lo ? 4 * fq : 8 * fq, d01 = lo ? 8 + 4 * fq : 8 * fq + 4;
            f32x4 gv[2][2];
            gv[0][0] = *(const f32x4*)(gb + d00); gv[0][1] = *(const f32x4*)(gb + d01);
            gv[1][0] = *(const f32x4*)(gb + 32 + 8 * fq); gv[1][1] = *(const f32x4*)(gb + 32 + 8 * fq + 4);
            const float sc = isq ? qscale : 1.0f;
            constexpr double I2PI = 0.15915494309189535;
            constexpr double IFR[8] = {1.0 * I2PI, 0.19392274474868576 * I2PI, 0.03760603093086393 * I2PI, 0.007292664737217109 * I2PI,
                                       0.001414213562373095 * I2PI, 0.0002742481756762073 * I2PI, 5.318295896944988e-05 * I2PI, 1.031338537721246e-05 * I2PI};
            const bool hi4 = (fq & 1) != 0;
            const double if0 = hi4 ? IFR[4] : IFR[0], if1 = hi4 ? IFR[5] : IFR[1], if2 = hi4 ? IFR[6] : IFR[2], if3 = hi4 ? IFR[7] : IFR[3];
            int posr[2][4]; float ssr[2][4];
#pragma unroll
            for (int ai = 0; ai < 2; ++ai)
#pragma unroll
                for (int m = 0; m < 4; ++m) { posr[ai][m] = positions[row0 + ai * HALF + m * 16]; float s = 0.f;
#pragma unroll
                    for (int bj = 0; bj < 2; ++bj)
#pragma unroll
                        for (int n = 0; n < 2; ++n) { const f32x4 x = acc[ai][bj][m][n]; s += (x[0] * x[0] + x[1] * x[1]) + (x[2] * x[2] + x[3] * x[3]); }
                    ssr[ai][m] = s; }
#pragma unroll
            for (int ai = 0; ai < 2; ++ai)
#pragma unroll
                for (int m = 0; m < 4; ++m) ssr[ai][m] += __shfl_xor(ssr[ai][m], 16);
#pragma unroll
            for (int ai = 0; ai < 2; ++ai)
#pragma unroll
                for (int m = 0; m < 4; ++m) ssr[ai][m] += __shfl_xor(ssr[ai][m], 32);
#pragma unroll
            for (int ai = 0; ai < 2; ++ai)
#pragma unroll
                for (int m = 0; m < 4; ++m) { bf16_t* rowp = O + (size_t)(row0 + ai * HALF + m * 16) * ldc + u.pn * BM + wc * 64;
                    const double pos = (double)posr[ai][m];
                    f32x4 cs, sn;
#define PG8_ROPE(i, IFJ) { double rev = pos * (IFJ); rev -= __builtin_rint(rev); const float frv = (float)rev; cs[i] = __builtin_amdgcn_cosf(frv); sn[i] = __builtin_amdgcn_sinf(frv); }
                    PG8_ROPE(0, if0) PG8_ROPE(1, if1) PG8_ROPE(2, if2) PG8_ROPE(3, if3)
#undef PG8_ROPE
                    const float r = 1.0f / sqrtf(ssr[ai][m] * (1.0f / 64.0f) + eps);
                    f32x4 t[2][2];
#pragma unroll
                    for (int bj = 0; bj < 2; ++bj)
#pragma unroll
                        for (int n = 0; n < 2; ++n) t[bj][n] = acc[ai][bj][m][n] * r * gv[bj][n];
                    if (lo) { const f32x4 a = t[0][0], b = t[0][1]; t[0][0] = a * cs - b * sn; t[0][1] = b * cs + a * sn; }
                    { const f32x4 v0 = t[0][0] * sc, v1 = t[0][1] * sc; u32x2 w0, w1; w0.x = cvt_pk_bf16(v0[0], v0[1]); w0.y = cvt_pk_bf16(v0[2], v0[3]); w1.x = cvt_pk_bf16(v1[0], v1[1]); w1.y = cvt_pk_bf16(v1[2], v1[3]);
                      *(u32x2*)(rowp + d00) = w0; *(u32x2*)(rowp + d01) = w1; }
                    { const f32x4 v0 = t[1][0] * sc, v1 = t[1][1] * sc; u32x4 w; w.x = cvt_pk_bf16(v0[0], v0[1]); w.y = cvt_pk_bf16(v0[2], v0[3]); w.z = cvt_pk_bf16(v1[0], v1[1]); w.w = cvt_pk_bf16(v1[2], v1[3]);
                      *(u32x4*)(rowp + 32 + 8 * fq) = w; } }
        }
    }
};
struct EpiStoreBf16 {
    static constexpr bool PERM = true, AFTER_DRAIN = false; static constexpr int MID_T = -1;
    bf16_t* O; int ldc;
    __device__ __forceinline__ void operator()(const f32x4 (&acc)[2][2][4][2], const Unit& u, int wr, int wc, int fr, int fq) const {
        const int row0 = u.pm * BM + wr * 64 + fr, col0 = u.pn * BM + wc * 32 + 8 * fq;
#pragma unroll
        for (int ai = 0; ai < 2; ++ai)
#pragma unroll
            for (int m = 0; m < 4; ++m) { bf16_t* rowp = O + (size_t)(row0 + ai * HALF + m * 16) * ldc + col0;
#pragma unroll
                for (int bj = 0; bj < 2; ++bj) { const f32x4 v0 = acc[ai][bj][m][0], v1 = acc[ai][bj][m][1];
                    u32x4 w; w.x = cvt_pk_bf16(v0[0], v0[1]); w.y = cvt_pk_bf16(v0[2], v0[3]); w.z = cvt_pk_bf16(v1[0], v1[1]); w.w = cvt_pk_bf16(v1[2], v1[3]);
                    *(u32x4*)(rowp + bj * HALF) = w; } }
    }
};
#define PG8_EPI_SB() __builtin_amdgcn_sched_barrier(0)
#define PG8_ROWB(g, mm) (bo + (unsigned)((((g) >> 1) * HALF + (2 * ((g) & 1) + (mm)) * 16) * ldc) * 4u)
#define PG8_LDRES(B, g) _Pragma("unroll") for (int mm = 0; mm < 2; ++mm) { const unsigned rb = PG8_ROWB(g, mm); \
            _Pragma("unroll") for (int bj = 0; bj < 2; ++bj) _Pragma("unroll") for (int n = 0; n < 2; ++n) B[mm][bj][n] = __builtin_nontemporal_load((const f32x4*)((const char*)base + (rb + (unsigned)(bj * HALF + 4 * n) * 4u))); }
#define PG8_ADDRES(B, g) _Pragma("unroll") for (int mm = 0; mm < 2; ++mm) _Pragma("unroll") for (int bj = 0; bj < 2; ++bj) _Pragma("unroll") for (int n = 0; n < 2; ++n) acc[(g) >> 1][bj][2 * ((g) & 1) + mm][n] += B[mm][bj][n];
struct EpiResF32 {
    static constexpr bool PERM = true, AFTER_DRAIN = false; static constexpr int MID_T = -1;
    const float* base; float* out; int ldc;
    __device__ __forceinline__ void operator()(f32x4 (&acc)[2][2][4][2], const Unit& u, int wr, int wc, int fr, int fq) const {
        const int row0 = u.pm * BM + wr * 64 + fr, col0 = u.pn * BM + wc * 32 + 8 * fq; const unsigned bo = (unsigned)(row0 * ldc + col0) * 4u;
        f32x4 ba[2][2][2], bb[2][2][2];
#define PG8_STRES(g) _Pragma("unroll") for (int mm = 0; mm < 2; ++mm) { const unsigned rb = PG8_ROWB(g, mm); \
            _Pragma("unroll") for (int bj = 0; bj < 2; ++bj) _Pragma("unroll") for (int n = 0; n < 2; ++n) *(f32x4*)((char*)out + (rb + (unsigned)(bj * HALF + 4 * n) * 4u)) = acc[(g) >> 1][bj][2 * ((g) & 1) + mm][n]; }
        PG8_LDRES(ba, 0) PG8_LDRES(bb, 1) PG8_EPI_SB(); PG8_ADDRES(ba, 0) PG8_EPI_SB(); PG8_LDRES(ba, 2) PG8_EPI_SB(); PG8_ADDRES(bb, 1) PG8_EPI_SB();
        PG8_STRES(0) PG8_STRES(1) PG8_EPI_SB(); PG8_LDRES(bb, 3) PG8_EPI_SB(); PG8_ADDRES(ba, 2) PG8_STRES(2) PG8_EPI_SB(); PG8_ADDRES(bb, 3) PG8_STRES(3)
#undef PG8_STRES
    }
};
struct EpiResNorm {
    static constexpr bool PERM = true, AFTER_DRAIN = false; static constexpr int MID_T = -1;
    const float* base; int ldc; bf16_t* XG; float* rowss;
    __device__ __forceinline__ void operator()(f32x4 (&acc)[2][2][4][2], const Unit& u, int wr, int wc, int fr, int fq) const {
        const int row0 = u.pm * BM + wr * 64 + fr, col0 = u.pn * BM + wc * 32 + 8 * fq; const unsigned bo = (unsigned)(row0 * ldc + col0) * 4u;
        f32x4 ba[2][2][2], bb[2][2][2];
#define PG8_STNORM(g) _Pragma("unroll") for (int mm = 0; mm < 2; ++mm) { const int m = 2 * ((g) & 1) + mm, row = row0 + ((g) >> 1) * HALF + m * 16; const unsigned rb = PG8_ROWB(g, mm); float ss = 0.f; \
            _Pragma("unroll") for (int bj = 0; bj < 2; ++bj) { const unsigned p = rb + (unsigned)(bj * HALF) * 4u; const f32x4 v0 = acc[(g) >> 1][bj][m][0], v1 = acc[(g) >> 1][bj][m][1]; \
                ss += ((v0[0] * v0[0] + v0[1] * v0[1]) + (v0[2] * v0[2] + v0[3] * v0[3])) + ((v1[0] * v1[0] + v1[1] * v1[1]) + (v1[2] * v1[2] + v1[3] * v1[3])); \
                u32x4 w; w.x = cvt_pk_bf16(v0[0], v0[1]); w.y = cvt_pk_bf16(v0[2], v0[3]); w.z = cvt_pk_bf16(v1[0], v1[1]); w.w = cvt_pk_bf16(v1[2], v1[3]); \
                *(u32x4*)((char*)XG + (p >> 1)) = w; } \
            ss += __shfl_xor(ss, 16); ss += __shfl_xor(ss, 32); \
            if (fq == 0) unsafeAtomicAdd(rowss + row, ss); }
        PG8_LDRES(ba, 0) PG8_LDRES(bb, 1) PG8_EPI_SB(); PG8_ADDRES(ba, 0) PG8_EPI_SB(); PG8_LDRES(ba, 2) PG8_EPI_SB(); PG8_ADDRES(bb, 1) PG8_EPI_SB();
        PG8_STNORM(0) PG8_STNORM(1) PG8_EPI_SB(); PG8_LDRES(bb, 3) PG8_EPI_SB(); PG8_ADDRES(ba, 2) PG8_STNORM(2) PG8_EPI_SB(); PG8_ADDRES(bb, 3) PG8_STNORM(3)
#undef PG8_STNORM
    }
};
#undef PG8_LDRES
#undef PG8_ADDRES
#undef PG8_ROWB
struct EpiResNormMid {
    static constexpr bool PERM = true, AFTER_DRAIN = false; static constexpr int MID_T = 24;
    const float* base; int ldc; bf16_t* XG; float* rowss; const float* rowss2; float inv_n2, eps;
    __device__ __forceinline__ void load_scale(const Unit& u, int wr, int fr, float (&rs)[2][4]) const {
        const unsigned rb = (unsigned)(u.pm * BM + wr * 64 + fr) * 4u;
#pragma unroll
        for (int ai = 0; ai < 2; ++ai)
#pragma unroll
            for (int m = 0; m < 4; ++m) rs[ai][m] = sqrtf(*(const float*)((const char*)rowss2 + (rb + (unsigned)(ai * HALF + m * 16) * 4u)) * inv_n2 + eps);
#pragma unroll
        for (int ai = 0; ai < 2; ++ai)
#pragma unroll
            for (int m = 0; m < 4; ++m) asm volatile("" : "+v"(rs[ai][m]));
    }
    __device__ __forceinline__ void operator()(f32x4 (&acc)[2][2][4][2], const Unit& u, int wr, int wc, int fr, int fq) const {
        float rs[2][4]; load_scale(u, wr, fr, rs);
#pragma unroll
        for (int ai = 0; ai < 2; ++ai)
#pragma unroll
            for (int m = 0; m < 4; ++m) { const float r = 1.0f / rs[ai][m];
#pragma unroll
                for (int bj = 0; bj < 2; ++bj)
#pragma unroll
                    for (int n = 0; n < 2; ++n) acc[ai][bj][m][n] *= r; }
        EpiResNorm{base, ldc, XG, rowss}(acc, u, wr, wc, fr, fq);
    }
};
struct EpiResBf16 {
    static constexpr bool PERM = true, AFTER_DRAIN = false; static constexpr int MID_T = -1;
    const bf16_t* resid; float* out; int ldc;
    __device__ __forceinline__ void operator()(f32x4 (&acc)[2][2][4][2], const Unit& u, int wr, int wc, int fr, int fq) const {
        const int row0 = u.pm * BM + wr * 64 + fr, col0 = u.pn * BM + wc * 32 + 8 * fq; const unsigned bo = (unsigned)(row0 * ldc + col0) * 4u;
        u32x4 rb[2][4][2];
#pragma unroll
        for (int ai = 0; ai < 2; ++ai)
#pragma unroll
            for (int m = 0; m < 4; ++m)
#pragma unroll
                for (int bj = 0; bj < 2; ++bj) rb[ai][m][bj] = __builtin_nontemporal_load((const u32x4*)((const char*)resid + ((bo + (unsigned)((ai * HALF + m * 16) * ldc + bj * HALF) * 4u) >> 1)));
        PG8_EPI_SB();
#pragma unroll
        for (int ai = 0; ai < 2; ++ai)
#pragma unroll
            for (int m = 0; m < 4; ++m)
#pragma unroll
                for (int bj = 0; bj < 2; ++bj) { const unsigned p = bo + (unsigned)((ai * HALF + m * 16) * ldc + bj * HALF) * 4u; const u32x4 w = rb[ai][m][bj];
                    f32x4 r0, r1; r0[0] = __uint_as_float(w.x << 16); r0[1] = __uint_as_float(w.x & 0xffff0000u); r0[2] = __uint_as_float(w.y << 16); r0[3] = __uint_as_float(w.y & 0xffff0000u);
                    r1[0] = __uint_as_float(w.z << 16); r1[1] = __uint_as_float(w.z & 0xffff0000u); r1[2] = __uint_as_float(w.w << 16); r1[3] = __uint_as_float(w.w & 0xffff0000u);
                    *(f32x4*)((char*)out + p) = r0 + acc[ai][bj][m][0]; *(f32x4*)((char*)out + (p + 16u)) = r1 + acc[ai][bj][m][1]; }
    }
};
typedef float f32x2 __attribute__((ext_vector_type(2)));
__device__ __forceinline__ f32x2 swiglu_pk(f32x2 g, f32x2 u, float rl, float r2) {
    const f32x2 t = g * rl; f32x2 e; e.x = __builtin_amdgcn_exp2f(t.x); e.y = __builtin_amdgcn_exp2f(t.y);
    const f32x2 d = e + 1.0f; f32x2 q; q.x = __builtin_amdgcn_rcpf(d.x); q.y = __builtin_amdgcn_rcpf(d.y);
    return (g * u) * (q * r2);
}
struct EpiSwiGLU {
    static constexpr bool PERM = true, AFTER_DRAIN = false; static constexpr int MID_T = -1;
    bf16_t* O; int ldc; const float* rowss; float inv_n, eps;
    __device__ __forceinline__ void operator()(const f32x4 (&acc)[2][2][4][2], const Unit& u, int wr, int wc, int fr, int fq) const {
        const int row0 = u.pm * BM + wr * 64 + fr, col0 = u.pn * HALF + wc * 32 + 8 * fq;
        float rs[2][4];
#pragma unroll
        for (int ai = 0; ai < 2; ++ai)
#pragma unroll
            for (int m = 0; m < 4; ++m) rs[ai][m] = rowss[row0 + ai * HALF + m * 16];
#pragma unroll
        for (int ai = 0; ai < 2; ++ai)
#pragma unroll
            for (int m = 0; m < 4; ++m) { const int row = row0 + ai * HALF + m * 16; bf16_t* rowp = O + (size_t)row * ldc + col0;
                const float r = 1.0f / sqrtf(rs[ai][m] * inv_n + eps), rl = -1.4426950408889634f * r, r2 = r * r;
                const f32x4 g0 = acc[ai][0][m][0], g1 = acc[ai][0][m][1], u0 = acc[ai][1][m][0], u1 = acc[ai][1][m][1];
                const f32x2 a = swiglu_pk((f32x2){g0[0], g0[1]}, (f32x2){u0[0], u0[1]}, rl, r2), b = swiglu_pk((f32x2){g0[2], g0[3]}, (f32x2){u0[2], u0[3]}, rl, r2);
                const f32x2 c = swiglu_pk((f32x2){g1[0], g1[1]}, (f32x2){u1[0], u1[1]}, rl, r2), d = swiglu_pk((f32x2){g1[2], g1[3]}, (f32x2){u1[2], u1[3]}, rl, r2);
                u32x4 w; w.x = cvt_pk_bf16(a.x, a.y); w.y = cvt_pk_bf16(b.x, b.y); w.z = cvt_pk_bf16(c.x, c.y); w.w = cvt_pk_bf16(d.x, d.y);
                *(u32x4*)rowp = w; }
    }
};

template <class Epi, class Sched, bool ALIGN_EPI = false, bool SP2 = false>
__device__ __forceinline__ void gemm_phase(const int tid, PG8_LAS unsigned char* lds, const Gemm g, const Sched& S, const Epi& E) {
    const int wid = __builtin_amdgcn_readfirstlane(tid >> 6), lane = tid & 63, wr = wid >> 2, wc = wid & 3, fr = lane & 15, fq = lane >> 4;
    const int K = g.K, nt = K / BK;
    unsigned voffA[2], voffB[2];
#pragma unroll
    for (int i = 0; i < 2; ++i) { int R, C; stage_rc(tid * 16 + i * 8192, R, C); const int Rb = Epi::PERM ? ((R & ~31) + perm32(R & 31)) : R;
        voffA[i] = (unsigned)(R * K + C) * 2u; voffB[i] = (unsigned)(Rb * K + C) * 2u; }
    const size_t kstep = (size_t)(BK * 2);
    const size_t hstep = (size_t)HALF * K * 2;
    const size_t tstep = 2 * hstep;
    const unsigned ldsw = (unsigned)wid * 1024u;
    const int aoff = lds_byte(wr * 64 + fr, fq * 8), boff = lds_byte(wc * 32 + fr, fq * 8);
#define PG8_SA(b, h) (((b) * 2 + (h)) * HTB)
#define PG8_SB(b, h) ((4 + (b) * 2 + (h)) * HTB)
#define PG8_STAGE(bufoff, gbase, voff) do { _Pragma("unroll") for (int _i = 0; _i < 2; ++_i) \
        __builtin_amdgcn_global_load_lds((const unsigned*)((const char*)(gbase) + (voff)[_i]), (PG8_LAS unsigned*)(lds + (bufoff) + ldsw + _i * 8192), 16, 0, 0); } while (0)
#define PG8_LDA(dst, b, h) do { _Pragma("unroll") for (int m = 0; m < 4; ++m) _Pragma("unroll") for (int k = 0; k < 2; ++k) dst[m][k] = *(const PG8_LAS bf16x8*)(lds + PG8_SA(b, h) + aoff + m * 2048 + k * 1024); } while (0)
#define PG8_LDB(dst, b, h) do { _Pragma("unroll") for (int n = 0; n < 2; ++n) _Pragma("unroll") for (int k = 0; k < 2; ++k) dst[n][k] = *(const PG8_LAS bf16x8*)(lds + PG8_SB(b, h) + boff + n * 2048 + k * 1024); } while (0)
#define PG8_MMA(ai, bj, At, Bt) do { __builtin_amdgcn_s_setprio(1); _Pragma("unroll") for (int m = 0; m < 4; ++m) _Pragma("unroll") for (int n = 0; n < 2; ++n) _Pragma("unroll") for (int k = 0; k < 2; ++k) \
        acc[ai][bj][m][n] = __builtin_amdgcn_mfma_f32_16x16x32_bf16(Bt[n][k], At[m][k], acc[ai][bj][m][n], 0, 0, 0); __builtin_amdgcn_s_setprio(0); } while (0)
#define PG8_WAIT_V(n) asm volatile("s_waitcnt vmcnt(" #n ")" ::: "memory")
#define PG8_WAIT_L(n) asm volatile("s_waitcnt lgkmcnt(" #n ")" ::: "memory")
#define PG8_BAR __builtin_amdgcn_s_barrier()
#define PG8_SCHED __builtin_amdgcn_sched_barrier(0)
    Unit cur, nxt; int ui = 0;
    if (!S.next(0, cur)) return;
    f32x4 acc[2][2][4][2];
#pragma unroll
    for (int a = 0; a < 2; ++a)
#pragma unroll
        for (int b = 0; b < 2; ++b)
#pragma unroll
            for (int m = 0; m < 4; ++m)
#pragma unroll
                for (int n = 0; n < 2; ++n) acc[a][b][m][n] = (f32x4){0.f, 0.f, 0.f, 0.f};
    bf16x8 At[4][2], B0[2][2], B1[2][2];
    const char* cA = (const char*)g.A + (size_t)cur.pm * tstep; const char* cB = (const char*)g.Bt + (size_t)cur.pn * tstep;
    S.a_ready(cur);
    if constexpr (SP2) {
        PG8_STAGE(PG8_SB(0, 0), cB, voffB); PG8_STAGE(PG8_SB(0, 1), cB + hstep, voffB); PG8_STAGE(PG8_SA(0, 0), cA, voffA); PG8_STAGE(PG8_SA(0, 1), cA + hstep, voffA);
        if (wr == 1) PG8_BAR;
        PG8_WAIT_V(2); PG8_BAR;
        PG8_STAGE(PG8_SB(1, 0), cB + kstep, voffB); PG8_STAGE(PG8_SA(1, 0), cA + kstep, voffA); PG8_STAGE(PG8_SB(1, 1), cB + hstep + kstep, voffB);
        PG8_WAIT_V(6); PG8_BAR;
    } else {
        PG8_STAGE(PG8_SB(0, 0), cB, voffB); PG8_STAGE(PG8_SA(0, 0), cA, voffA); PG8_STAGE(PG8_SB(0, 1), cB + hstep, voffB); PG8_STAGE(PG8_SA(0, 1), cA + hstep, voffA);
        if (wr == 1) PG8_BAR;
        PG8_WAIT_V(4); PG8_BAR;
        PG8_STAGE(PG8_SB(1, 0), cB + kstep, voffB); PG8_STAGE(PG8_SA(1, 0), cA + kstep, voffA); PG8_STAGE(PG8_SB(1, 1), cB + hstep + kstep, voffB);
        PG8_WAIT_V(6); PG8_BAR;
    }
    for (;;) {
        const bool has_next = S.next(ui + 1, nxt);
        const char* nA = has_next ? (const char*)g.A + (size_t)nxt.pm * tstep : cA; const char* nB = has_next ? (const char*)g.Bt + (size_t)nxt.pn * tstep : cB;
        for (int t = 0; t < nt; t += 2) {
            const bool last = (t == nt - 2);
            if constexpr (Epi::MID_T >= 0) { if (t == Epi::MID_T) { float rs[2][4]; E.load_scale(cur, wr, fr, rs);
                _Pragma("unroll") for (int a_ = 0; a_ < 2; ++a_) _Pragma("unroll") for (int m_ = 0; m_ < 4; ++m_) _Pragma("unroll") for (int b_ = 0; b_ < 2; ++b_) _Pragma("unroll") for (int n_ = 0; n_ < 2; ++n_) acc[a_][b_][m_][n_] *= rs[a_][m_]; } }
            const char* a1 = cA + (size_t)(t + 1) * kstep;
            const char* a2 = last ? nA : cA + (size_t)(t + 2) * kstep; const char* b2 = last ? nB : cB + (size_t)(t + 2) * kstep;
            const char* a3 = a2 + kstep; const char* b3 = b2 + kstep;
            if (last && has_next) S.a_ready(nxt);
            if constexpr (SP2) {
            PG8_LDB(B0, 0, 0); PG8_LDB(B1, 0, 1); PG8_SCHED; PG8_LDA(At, 0, 0); PG8_STAGE(PG8_SA(1, 1), a1 + hstep, voffA);
            PG8_WAIT_V(8); PG8_WAIT_L(0); PG8_BAR; PG8_MMA(0, 0, At, B0); PG8_MMA(0, 1, At, B1); PG8_BAR; PG8_SCHED;
            PG8_LDA(At, 0, 1); PG8_STAGE(PG8_SB(0, 0), b2, voffB); PG8_STAGE(PG8_SB(0, 1), b2 + hstep, voffB); PG8_STAGE(PG8_SA(0, 0), a2, voffA);
            PG8_WAIT_V(8); PG8_WAIT_L(0); PG8_BAR; PG8_MMA(1, 0, At, B0); PG8_MMA(1, 1, At, B1); PG8_BAR; PG8_SCHED;
            PG8_LDB(B0, 1, 0); PG8_LDB(B1, 1, 1); PG8_SCHED; PG8_LDA(At, 1, 0); PG8_STAGE(PG8_SA(0, 1), a2 + hstep, voffA);
            PG8_WAIT_V(8); PG8_WAIT_L(0); PG8_BAR; PG8_MMA(0, 0, At, B0); PG8_MMA(0, 1, At, B1); PG8_BAR; PG8_SCHED;
            PG8_LDA(At, 1, 1); PG8_STAGE(PG8_SB(1, 0), b3, voffB); PG8_STAGE(PG8_SB(1, 1), b3 + hstep, voffB); PG8_STAGE(PG8_SA(1, 0), a3, voffA);
            PG8_WAIT_V(8); PG8_WAIT_L(0); PG8_BAR; PG8_MMA(1, 0, At, B0); PG8_MMA(1, 1, At, B1); PG8_BAR; PG8_SCHED;
            } else {
            PG8_LDB(B0, 0, 0); PG8_SCHED; PG8_LDA(At, 0, 0); PG8_STAGE(PG8_SA(1, 1), a1 + hstep, voffA);
            PG8_WAIT_L(8); PG8_BAR; PG8_WAIT_L(0); PG8_MMA(0, 0, At, B0); PG8_BAR; PG8_SCHED;
            PG8_LDB(B1, 0, 1); PG8_STAGE(PG8_SB(0, 0), b2, voffB);
            PG8_BAR; PG8_WAIT_L(0); PG8_MMA(0, 1, At, B1); PG8_BAR;
            PG8_LDA(At, 0, 1); PG8_STAGE(PG8_SA(0, 0), a2, voffA);
            PG8_BAR; PG8_WAIT_L(0); PG8_MMA(1, 0, At, B0); PG8_BAR; PG8_SCHED;
            PG8_STAGE(PG8_SB(0, 1), b2 + hstep, voffB);
            PG8_WAIT_V(6); PG8_BAR; PG8_MMA(1, 1, At, B1); PG8_BAR;
            PG8_LDB(B0, 1, 0); PG8_SCHED; PG8_LDA(At, 1, 0); PG8_STAGE(PG8_SA(0, 1), a2 + hstep, voffA);
            PG8_WAIT_L(8); PG8_BAR; PG8_WAIT_L(0); PG8_MMA(0, 0, At, B0); PG8_BAR; PG8_SCHED;
            PG8_LDB(B1, 1, 1); PG8_STAGE(PG8_SB(1, 0), b3, voffB);
            PG8_BAR; PG8_WAIT_L(0); PG8_MMA(0, 1, At, B1); PG8_BAR;
            PG8_LDA(At, 1, 1); PG8_STAGE(PG8_SA(1, 0), a3, voffA);
            PG8_BAR; PG8_WAIT_L(0); PG8_MMA(1, 0, At, B0); PG8_BAR; PG8_SCHED;
            PG8_STAGE(PG8_SB(1, 1), b3 + hstep, voffB);
            PG8_WAIT_V(6); PG8_BAR; PG8_MMA(1, 1, At, B1); PG8_BAR;
            }
        }
        if constexpr (ALIGN_EPI) { if (wr == 0) PG8_BAR; }
        if constexpr (!Epi::AFTER_DRAIN) { E(acc, cur, wr, wc, fr, fq); S.done(cur); }
        if (!has_next) break;
#pragma unroll
        for (int a = 0; a < 2; ++a)
#pragma unroll
            for (int b = 0; b < 2; ++b)
#pragma unroll
                for (int m = 0; m < 4; ++m)
#pragma unroll
                    for (int n = 0; n < 2; ++n) acc[a][b][m][n] = (f32x4){0.f, 0.f, 0.f, 0.f};
        cur = nxt; cA = nA; cB = nB; ++ui;
        if constexpr (ALIGN_EPI) { if (wr == 1) PG8_BAR; }
    }
    PG8_WAIT_V(0);
    if constexpr (!ALIGN_EPI) { if (wr == 0) PG8_BAR; }
    PG8_BAR;
    if constexpr (Epi::AFTER_DRAIN) { E.fused(acc, cur, wr, wc, fr, fq, lds, wid, lane); S.done(cur); }
#undef PG8_SA
#undef PG8_SB
#undef PG8_STAGE
#undef PG8_LDA
#undef PG8_LDB
#undef PG8_MMA
#undef PG8_WAIT_V
#undef PG8_WAIT_L
#undef PG8_BAR
#undef PG8_SCHED
}
}
#include <hip/hip_bf16.h>
#include <cmath>
namespace attn_body {
using bf16=__hip_bfloat16;
using bf16x8=__attribute__((ext_vector_type(8)))short;
using s16x4=__attribute__((ext_vector_type(4)))short;
using f32x16=__attribute__((ext_vector_type(16)))float;
using u32x4=__attribute__((ext_vector_type(4)))unsigned;
constexpr int SEQ=2048,D=64,PQKV=5120,PO=2048;
constexpr int NW=8,QBLK=32,QB=QBLK*NW,KVBLK=64,NQB=SEQ/QB;
__device__ __forceinline__ int crow(int r,int hi){return (r&3)+8*(r>>2)+4*hi;}
#define SBAR() __builtin_amdgcn_sched_barrier(0)
__device__ __forceinline__ void cmask(f32x16&p0,f32x16&p1,int jb,int qrel,int hi){
  const float NEG=-INFINITY; int kb=64*jb+4*hi;
  #pragma unroll
  for(int r=0;r<16;++r){int kv=kb+(r&3)+8*(r>>2); if(kv>qrel)p0[r]=NEG; if(kv+32>qrel)p1[r]=NEG;}
}

constexpr int NSLOT=3, SLOTB=8192;
constexpr int LDS_K=0, LDS_V=NSLOT*SLOTB, LDS_WS=2*NSLOT*SLOTB, LDS_OST=LDS_WS+NW*64*4, LDS_V2=LDS_OST+NW*4096, LDS_BYTES=LDS_V2+NSLOT*SLOTB;
constexpr float C2=0.125f*1.4426950408889634f;
__device__ __forceinline__ void glds16s(const void*sbase,unsigned voff,unsigned lds_dst){unsigned keep;
  asm volatile("s_mov_b32 %0, m0\n\ts_mov_b32 m0, %3\n\ts_nop 0\n\tglobal_load_lds_dwordx4 %1, %2\n\ts_mov_b32 m0, %0":"=&s"(keep):"v"(voff),"s"(sbase),"s"(lds_dst):"memory");}
__device__ __forceinline__ void glds16(const void*gsrc,unsigned lds_dst){unsigned keep;
  asm volatile("s_mov_b32 %0, m0\n\ts_mov_b32 m0, %2\n\ts_nop 0\n\tglobal_load_lds_dwordx4 %1, off\n\ts_mov_b32 m0, %0":"=&s"(keep):"v"(gsrc),"s"(lds_dst):"memory");}
__device__ __forceinline__ float max3f(float a,float b,float c){float r;asm("v_max3_f32 %0, %1, %2, %3":"=v"(r):"v"(a),"v"(b),"v"(c));return r;}
__device__ __forceinline__ float max2f(float a,float b){float r;asm("v_max_f32_e32 %0, %1, %2":"=v"(r):"v"(a),"v"(b));return r;}
__device__ __forceinline__ float fadd_s(float a,float b){float r;asm("v_add_f32_e32 %0, %1, %2":"=v"(r):"v"(a),"v"(b));return r;}
__device__ __forceinline__ float fsub_s(float a,float b){float r;asm("v_sub_f32_e32 %0, %1, %2":"=v"(r):"v"(a),"v"(b));return r;}
typedef float f32x2_t __attribute__((ext_vector_type(2))); typedef __bf16 bf16x2_t __attribute__((ext_vector_type(2)));
__device__ __forceinline__ unsigned cvtpk_s(float lo,float hi){f32x2_t v={lo,hi};bf16x2_t b=__builtin_convertvector(v,bf16x2_t);return __builtin_bit_cast(unsigned,b);}
#define WAIT_BAR(N) asm volatile("s_waitcnt vmcnt(" #N ") lgkmcnt(0)\n\ts_barrier":::"memory")

__device__ __forceinline__ void qkt(f32x16&p0,f32x16&p1,const char*Kslot,const bf16x8*qr,const f32x16&negm,int r32,int hi){
  const char*kb=Kslot+hi*1024+r32*16;
  #pragma unroll
  for(int d0=0;d0<4;++d0){
    const bf16x8 b0=*reinterpret_cast<const bf16x8*>(kb+d0*2048);
    const bf16x8 b1=*reinterpret_cast<const bf16x8*>(kb+d0*2048+512);
    if(d0==0){p0=__builtin_amdgcn_mfma_f32_32x32x16_bf16(b0,qr[0],negm,0,0,0);p1=__builtin_amdgcn_mfma_f32_32x32x16_bf16(b1,qr[0],negm,0,0,0);}
    else{p0=__builtin_amdgcn_mfma_f32_32x32x16_bf16(b0,qr[d0],p0,0,0,0);p1=__builtin_amdgcn_mfma_f32_32x32x16_bf16(b1,qr[d0],p1,0,0,0);}}
}
typedef __attribute__((address_space(3))) const char* lds_cptr;
typedef short v4i16_t __attribute__((ext_vector_type(4)));
__device__ __forceinline__ void kload8(bf16x8*kf,lds_cptr kp){
  kf[0]=*(const __attribute__((address_space(3))) bf16x8*)(kp);      kf[1]=*(const __attribute__((address_space(3))) bf16x8*)(kp+512);
  kf[2]=*(const __attribute__((address_space(3))) bf16x8*)(kp+2048); kf[3]=*(const __attribute__((address_space(3))) bf16x8*)(kp+2560);
  kf[4]=*(const __attribute__((address_space(3))) bf16x8*)(kp+4096); kf[5]=*(const __attribute__((address_space(3))) bf16x8*)(kp+4608);
  kf[6]=*(const __attribute__((address_space(3))) bf16x8*)(kp+6144); kf[7]=*(const __attribute__((address_space(3))) bf16x8*)(kp+6656);
}
__device__ __forceinline__ void kload2(bf16x8*kf,lds_cptr kp,int j){ kf[2*j]=*(const __attribute__((address_space(3))) bf16x8*)(kp+j*2048); kf[2*j+1]=*(const __attribute__((address_space(3))) bf16x8*)(kp+j*2048+512); }
__device__ __forceinline__ s16x4 vtr(lds_cptr p){ return __builtin_bit_cast(s16x4,__builtin_amdgcn_ds_read_tr16_b64_v4i16((__attribute__((address_space(3))) v4i16_t*)p)); }
__device__ __forceinline__ float rowmax(const f32x16&p0,const f32x16&p1){
  float a=max3f(p0[0],p0[1],p1[0]),b=max3f(p0[2],p0[3],p1[1]);a=max3f(a,p1[2],p1[3]);
  #pragma unroll
  for(int r=4;r<16;r+=4){a=max3f(a,p0[r],p0[r+1]);b=max3f(b,p0[r+2],p0[r+3]);a=max3f(a,p1[r],p1[r+1]);b=max3f(b,p1[r+2],p1[r+3]);}
  const float m=max2f(a,b);
  auto rr=__builtin_amdgcn_permlane32_swap(__float_as_uint(m),__float_as_uint(m),false,false);
  return max2f(__uint_as_float(rr[0]),__uint_as_float(rr[1]));
}
__device__ __forceinline__ void pv(f32x16*o,int vb,bf16x8 pa0,bf16x8 pa1,bf16x8 pa2,bf16x8 pa3){
  #pragma unroll
  for(int d0=0;d0<2;++d0){s16x4 lo[4],hi[4];
    #pragma unroll
    for(int ks=0;ks<4;++ks){
      asm volatile("ds_read_b64_tr_b16 %0,%1 offset:%c2":"=&v"(lo[ks]):"v"(vb),"i"(d0*4096+ks*1024):"memory");
      asm volatile("ds_read_b64_tr_b16 %0,%1 offset:%c2":"=&v"(hi[ks]):"v"(vb),"i"(d0*4096+ks*1024+512):"memory");}
    asm volatile("s_waitcnt lgkmcnt(0)":::"memory");SBAR();
    #define PK(k) (bf16x8){lo[k][0],lo[k][1],lo[k][2],lo[k][3],hi[k][0],hi[k][1],hi[k][2],hi[k][3]}
    o[d0]=__builtin_amdgcn_mfma_f32_32x32x16_bf16(pa0,PK(0),o[d0],0,0,0);
    o[d0]=__builtin_amdgcn_mfma_f32_32x32x16_bf16(pa1,PK(1),o[d0],0,0,0);
    o[d0]=__builtin_amdgcn_mfma_f32_32x32x16_bf16(pa2,PK(2),o[d0],0,0,0);
    o[d0]=__builtin_amdgcn_mfma_f32_32x32x16_bf16(pa3,PK(3),o[d0],0,0,0);
    #undef PK
  }
}

#ifndef ATTN_STORE16
#define ATTN_STORE16(p,v) (*(u32x4*)(p)=(v))
#endif
typedef float f32x8a __attribute__((ext_vector_type(8))); typedef float f32x4a __attribute__((ext_vector_type(4)));
__device__ __forceinline__ f32x8a unpk8(u32x4 w){ f32x8a t; t[0]=__uint_as_float(w.x<<16); t[1]=__uint_as_float(w.x&0xffff0000u); t[2]=__uint_as_float(w.y<<16); t[3]=__uint_as_float(w.y&0xffff0000u);
  t[4]=__uint_as_float(w.z<<16); t[5]=__uint_as_float(w.z&0xffff0000u); t[6]=__uint_as_float(w.w<<16); t[7]=__uint_as_float(w.w&0xffff0000u); return t; }
template<int THRL,int MODE> __device__ __forceinline__ void attn_unit(int tid,int qb,const bf16*__restrict__ Qb,const bf16*__restrict__ Kh,const bf16*__restrict__ Vh,bf16*Ob,char*shm,const bf16*Ob0,float lam,const float*gsub,float dscale){
  const int lane=tid&63,r32=lane&31,hi=lane>>5; const int wid=__builtin_amdgcn_readfirstlane(tid>>6);
  const int q0=qb*QB;
  const bf16*Qw=Qb+(long)(q0+wid*QBLK)*PQKV;
  const unsigned lds0=(unsigned)(uintptr_t)shm;
  float*wsf=(float*)(shm+LDS_WS)+wid*64;
  const unsigned koff=(unsigned)(lane*PQKV+wid*8)*2u;
  const unsigned voff=(unsigned)((16*(wid&3)+(lane>>2))*PQKV+(wid>>2)*32+(lane&3)*8)*2u;
  const unsigned kdst=lds0+LDS_K+wid*1024, vdst=lds0+LDS_V+wid*1024, vdst2=lds0+LDS_V2+wid*1024;
  #define DMA_K(t,slot) glds16s(Kh+(long)(t)*KVBLK*PQKV,koff,(unsigned)__builtin_amdgcn_readfirstlane(kdst+(slot)))
  #define DMA_V(t,slot) do{ glds16s(Vh+(long)(t)*KVBLK*PQKV,voff,(unsigned)__builtin_amdgcn_readfirstlane(vdst+(slot))); glds16s(Vh+64+(long)(t)*KVBLK*PQKV,voff,(unsigned)__builtin_amdgcn_readfirstlane(vdst2+(slot))); }while(0)
  const int vb0=(int)(lds0+LDS_V)+((lane>>4)&1)*32+(lane&3)*8+(4*hi+((lane&15)>>2))*64;
  const char*Kbase=shm+LDS_K; bf16x8 kf[8];
  const lds_cptr shm3=(lds_cptr)shm; const lds_cptr kp0=shm3+LDS_K+hi*1024+r32*16; const lds_cptr vp0=shm3+LDS_V+((lane>>4)&1)*32+(lane&3)*8+(4*hi+((lane&15)>>2))*64;
  const int NT=(q0+QB)/KVBLK;
  DMA_K(0,0);DMA_V(0,0);DMA_K(1,SLOTB);
  bf16x8 qr[4];
  #pragma unroll
  for(int d0=0;d0<4;++d0)qr[d0]=*reinterpret_cast<const bf16x8*>(&Qw[(long)r32*PQKV+d0*16+hi*8]);
  float mhat=0.f,l_reg=0.f;float zz_=0.f;asm volatile("":"+v"(zz_));f32x16 o[4];f32x16 negm;
  _Pragma("unroll") for(int r=0;r<16;++r){o[0][r]=zz_;o[1][r]=zz_;o[2][r]=zz_;o[3][r]=zz_;negm[r]=zz_;} asm volatile("":"+v"(negm));
  const int qrel=wid*QBLK+r32;
  #define CMASK(P0,P1,t) do{int jb_=(t)-(NT-4); if(jb_>=0)cmask(P0,P1,jb_,qrel,hi);}while(0)
  bool resc=false;
  #define START(P0,P1) do{ const float rm=rowmax(P0,P1); resc=false; \
    { const float dl=rm; mhat=fadd_s(mhat,dl); \
      _Pragma("unroll") for(int r=0;r<16;++r){P0[r]=fsub_s(P0[r],dl);P1[r]=fsub_s(P1[r],dl);} \
      _Pragma("unroll") for(int r=0;r<16;++r)negm[r]=-mhat; asm volatile("":"+v"(negm)); } \
    _Pragma("unroll") for(int r=0;r<16;++r)P0[r]=__builtin_amdgcn_exp2f(P0[r]); }while(0)
  #define RESC() do{ if(resc){ asm volatile("s_waitcnt lgkmcnt(0)":::"memory"); \
      _Pragma("unroll") for(int d_=0;d_<4;++d_) _Pragma("unroll") for(int r=0;r<16;++r)o[d_][r]*=wsf[crow(r,hi)]; } }while(0)
  f32x16 pA0,pA1,pB0,pB1;
  int sl_prev=0,sl_cur=0,sl_next=SLOTB;
  #define ROT() do{sl_prev=sl_cur;sl_cur=sl_next;sl_next=(sl_next==(NSLOT-1)*SLOTB)?0:sl_next+SLOTB;}while(0)
  DMA_K(2,2*SLOTB);
  WAIT_BAR(4);
  qkt(pA0,pA1,Kbase,qr,negm,r32,hi);asm volatile("s_nop 15\n\ts_nop 7":"+v"(pA0),"+v"(pA1));CMASK(pA0,pA1,0);
  START(pA0,pA1);
  _Pragma("unroll") for(int r=0;r<16;++r)pA1[r]=__builtin_amdgcn_exp2f(pA1[r]);
  WAIT_BAR(0);
  DMA_K(3,0);DMA_V(1,SLOTB);
  ROT();
  kload8(kf,kp0+sl_cur);
  WAIT_BAR(3);
  s16x4 vlo[8],vhi[8]; u32x4 pw0,pw1,pw2,pw3;
  #define PKW(P,B) cvtpk_s(P[B],P[B+1])
  #define PAF(k) __builtin_bit_cast(bf16x8,pw##k)
  #define VFR(i) (bf16x8){vlo[i][0],vlo[i][1],vlo[i][2],vlo[i][3],vhi[i][0],vhi[i][1],vhi[i][2],vhi[i][3]}
  #define PIN(x) asm volatile("":"+v"(x))
  #define MX3(a,b,c) __builtin_fmaxf(__builtin_fmaxf((a),(b)),(c))
  #define GAPA(MF,A0,A1,A2,A3,W0,W1,PW) do{ MF; sacc+=A0; sacc+=A1; sacc+=A2; sacc+=A3; PIN(sacc); W0; W1; PIN(PW); SBAR(); }while(0)
  #define EX(v) __builtin_amdgcn_exp2f(v)
  #define GAPB(MF,X,B) do{ MF; X[B]=EX(X[B]); X[B+1]=EX(X[B+1]); X[B+2]=EX(X[B+2]); X[B+3]=EX(X[B+3]); PIN(X); SBAR(); }while(0)
  #define VRD(i) do{ vlo[i]=vtr(vp_+(((i)>>2)*4096+((i)&3)*1024)); vhi[i]=vtr(vp_+(((i)>>2)*4096+((i)&3)*1024+512)); }while(0)
  #define KRD(G,j) do{ if(G){ kload2(kf,kp0+sl_next,j); SBAR(); } }while(0)
  #define STEP(C0,C1,P0,P1,t,GK,GV,GL) do{ SBAR(); \
    const lds_cptr vp_=vp0+sl_prev; \
    VRD(0); SBAR(); float sacc=(P0[0]+P0[1]); \
    GAPA(C0=__builtin_amdgcn_mfma_f32_32x32x16_bf16(kf[0],qr[0],negm,0,0,0), P0[2],P0[3],P0[4],P0[5],     pw0[0]=PKW(P0,0), pw0[1]=PKW(P0,2), pw0); \
    VRD(4); SBAR(); GAPA(C1=__builtin_amdgcn_mfma_f32_32x32x16_bf16(kf[1],qr[0],negm,0,0,0), P0[6],P0[7],P0[8],P0[9],     pw0[2]=PKW(P0,4), pw0[3]=PKW(P0,6), pw0); \
    VRD(1); SBAR(); GAPA(C0=__builtin_amdgcn_mfma_f32_32x32x16_bf16(kf[2],qr[1],C0,0,0,0),   P0[10],P0[11],P0[12],P0[13], pw1[0]=PKW(P0,8), pw1[1]=PKW(P0,10), pw1); \
    VRD(5); SBAR(); GAPA(C1=__builtin_amdgcn_mfma_f32_32x32x16_bf16(kf[3],qr[1],C1,0,0,0),   P0[14],P0[15],P1[0],P1[1],   pw1[2]=PKW(P0,12),pw1[3]=PKW(P0,14), pw1); \
    VRD(2); SBAR(); GAPA(C0=__builtin_amdgcn_mfma_f32_32x32x16_bf16(kf[4],qr[2],C0,0,0,0),   P1[2],P1[3],P1[4],P1[5],     pw2[0]=PKW(P1,0), pw2[1]=PKW(P1,2), pw2); \
    VRD(6); SBAR(); GAPA(C1=__builtin_amdgcn_mfma_f32_32x32x16_bf16(kf[5],qr[2],C1,0,0,0),   P1[6],P1[7],P1[8],P1[9],     pw2[2]=PKW(P1,4), pw2[3]=PKW(P1,6), pw2); \
    VRD(3); SBAR(); GAPA(C0=__builtin_amdgcn_mfma_f32_32x32x16_bf16(kf[6],qr[3],C0,0,0,0),   P1[10],P1[11],P1[12],P1[13], pw3[0]=PKW(P1,8), pw3[1]=PKW(P1,10), pw3); \
    VRD(7); SBAR(); GAPA(C1=__builtin_amdgcn_mfma_f32_32x32x16_bf16(kf[7],qr[3],C1,0,0,0),   P1[14],P1[15],0.f,0.f,       pw3[2]=PKW(P1,12),pw3[3]=PKW(P1,14), pw3); \
    l_reg+=sacc; \
    if(GK){DMA_K((t)+3,sl_cur);} if(GV){DMA_V((t)+1,sl_next);} \
    CMASK(C0,C1,t); \
    { float a=MX3(C0[0],C0[1],C1[0]),b=MX3(C0[2],C0[3],C1[1]); a=MX3(a,C1[2],C1[3]); \
      _Pragma("unroll") for(int r=4;r<16;r+=4){a=MX3(a,C0[r],C0[r+1]);b=MX3(b,C0[r+2],C0[r+3]);a=MX3(a,C1[r],C1[r+1]);b=MX3(b,C1[r+2],C1[r+3]);} \
      float rm=__builtin_fmaxf(a,b); { auto rr=__builtin_amdgcn_permlane32_swap(__float_as_uint(rm),__float_as_uint(rm),false,false); rm=__builtin_fmaxf(__uint_as_float(rr[0]),__uint_as_float(rr[1])); } \
      resc=false; \
      if(__builtin_expect(__any(rm>(float)THRL),0)){ const float dl=__builtin_fmaxf(rm,0.f); mhat+=dl; \
        _Pragma("unroll") for(int r=0;r<16;++r){C0[r]-=dl;C1[r]-=dl;} \
        _Pragma("unroll") for(int r=0;r<16;++r)negm[r]=-mhat; asm volatile("":"+v"(negm)); \
        const float f=__builtin_amdgcn_exp2f(-dl); l_reg*=f; if(hi==0)wsf[r32]=f; resc=true; } } \
    SBAR(); \
    GAPB(o[0]=__builtin_amdgcn_mfma_f32_32x32x16_bf16(PAF(0),VFR(0),o[0],0,0,0), C0,0); \
    GAPB(o[1]=__builtin_amdgcn_mfma_f32_32x32x16_bf16(PAF(0),VFR(4),o[1],0,0,0), C0,4); \
    KRD(GL,0); GAPB(o[0]=__builtin_amdgcn_mfma_f32_32x32x16_bf16(PAF(1),VFR(1),o[0],0,0,0), C0,8); \
    KRD(GL,1); GAPB(o[1]=__builtin_amdgcn_mfma_f32_32x32x16_bf16(PAF(1),VFR(5),o[1],0,0,0), C0,12); \
    KRD(GL,2); GAPB(o[0]=__builtin_amdgcn_mfma_f32_32x32x16_bf16(PAF(2),VFR(2),o[0],0,0,0), C1,0); \
    KRD(GL,3); GAPB(o[1]=__builtin_amdgcn_mfma_f32_32x32x16_bf16(PAF(2),VFR(6),o[1],0,0,0), C1,4); \
    GAPB(o[0]=__builtin_amdgcn_mfma_f32_32x32x16_bf16(PAF(3),VFR(3),o[0],0,0,0), C1,8); \
    GAPB(o[1]=__builtin_amdgcn_mfma_f32_32x32x16_bf16(PAF(3),VFR(7),o[1],0,0,0), C1,12); \
    pv(o+2,vb0+(LDS_V2-LDS_V)+sl_prev,PAF(0),PAF(1),PAF(2),PAF(3));   \
    }while(0)
  int t=1;
  #undef CMASK
  #define CMASK(P0,P1,t) do{}while(0)
  for(;t+5<NT;t+=2){
    STEP(pB0,pB1,pA0,pA1,t,true,true,true);     WAIT_BAR(3); RESC(); ROT();
    STEP(pA0,pA1,pB0,pB1,t+1,true,true,true);   WAIT_BAR(3); RESC(); ROT();
  }
  #undef CMASK
  #define CMASK(P0,P1,t) do{int jb_=(t)-(NT-4); if(jb_>=0)cmask(P0,P1,jb_,qrel,hi);}while(0)
  #define ENDW(tt) do{ if((tt)+3<NT){WAIT_BAR(3);} else if((tt)+2<NT){WAIT_BAR(2);} else {WAIT_BAR(0);} }while(0)
  for(;t+1<NT;t+=2){
    STEP(pB0,pB1,pA0,pA1,t,(t+3<NT),(t+1<NT),(t+1<NT));       ENDW(t);   RESC(); ROT();
    STEP(pA0,pA1,pB0,pB1,t+1,(t+4<NT),(t+2<NT),(t+2<NT));     ENDW(t+1); RESC(); ROT();
  }
  STEP(pB0,pB1,pA0,pA1,NT-1,false,false,false); RESC();
  { float sacc=pB0[0]+pB0[1]; _Pragma("unroll") for(int r=2;r<16;++r)sacc+=pB0[r]; _Pragma("unroll") for(int r=0;r<16;++r)sacc+=pB1[r]; l_reg+=sacc;
    pw0=(u32x4){PKW(pB0,0),PKW(pB0,2),PKW(pB0,4),PKW(pB0,6)};pw1=(u32x4){PKW(pB0,8),PKW(pB0,10),PKW(pB0,12),PKW(pB0,14)};pw2=(u32x4){PKW(pB1,0),PKW(pB1,2),PKW(pB1,4),PKW(pB1,6)};pw3=(u32x4){PKW(pB1,8),PKW(pB1,10),PKW(pB1,12),PKW(pB1,14)};
    SBAR(); pv(o,vb0+sl_cur,PAF(0),PAF(1),PAF(2),PAF(3)); pv(o+2,vb0+(LDS_V2-LDS_V)+sl_cur,PAF(0),PAF(1),PAF(2),PAF(3)); }
  #undef PKW
  #undef PAF
  #undef VFR
  #undef PIN
  #undef MX3
  #undef GAPA
  #undef GAPB
  #undef EX
  #undef VRD
  #undef KRD
  #undef STEP
  #undef ENDW
  {auto rr=__builtin_amdgcn_permlane32_swap(__float_as_uint(l_reg),__float_as_uint(l_reg),false,false);l_reg=__uint_as_float(rr[0])+__uint_as_float(rr[1]);}
  if(hi==0)wsf[32+r32]=l_reg;asm volatile("s_waitcnt lgkmcnt(0)":::"memory");
  float rli[16];
  #pragma unroll
  for(int r=0;r<16;++r)rli[r]=__builtin_amdgcn_rcpf(wsf[32+crow(r,hi)]);
  bf16*Ow=Ob+(long)(q0+wid*QBLK)*PO;
  { bf16*stg=(bf16*)(shm+LDS_OST)+wid*2048;
    f32x8a dd[2][4];
    #pragma unroll
    for(int ph=0;ph<2;++ph){
      #pragma unroll
      for(int r=0;r<16;++r){const int orow=crow(r,hi);
        #pragma unroll
        for(int d0=0;d0<2;++d0)stg[orow*64+d0*32+r32]=__float2bfloat16(o[2*ph+d0][r]*rli[r]);}
      asm volatile("s_waitcnt lgkmcnt(0)":::"memory");
      #pragma unroll
      for(int i=0;i<4;++i){const int row=i*8+(lane>>3),ch=lane&7; const u32x4 v=*(const u32x4*)(stg+row*64+ch*8);
        if constexpr(MODE==0){ ATTN_STORE16(Ow+(long)row*PO+ph*64+ch*8,v); }
        else { const u32x4 w0=__builtin_nontemporal_load((const u32x4*)(Ob0+(long)(q0+wid*QBLK+row)*PO+ph*64+ch*8)); dd[ph][i]=unpk8(w0)-unpk8(v)*lam; } }
      asm volatile("s_waitcnt lgkmcnt(0)":::"memory"); }
    if constexpr(MODE==1){
      #pragma unroll
      for(int i=0;i<4;++i){const int row=i*8+(lane>>3),ch=lane&7; float ss=0.f;
        #pragma unroll
        for(int ph=0;ph<2;++ph){ _Pragma("unroll") for(int k=0;k<8;++k)ss+=dd[ph][i][k]*dd[ph][i][k]; }
        ss+=__shfl_xor(ss,1);ss+=__shfl_xor(ss,2);ss+=__shfl_xor(ss,4);
        const float rr=dscale/sqrtf(ss*(1.f/128.f)+1e-6f);
        #pragma unroll
        for(int ph=0;ph<2;++ph){ const float*gp=gsub+ph*64+ch*8; const f32x4a ga=*(const f32x4a*)gp, gb=*(const f32x4a*)(gp+4);
          const f32x8a d=dd[ph][i]*rr; u32x4 w; w.x=cvtpk_s(d[0]*ga[0],d[1]*ga[1]); w.y=cvtpk_s(d[2]*ga[2],d[3]*ga[3]); w.z=cvtpk_s(d[4]*gb[0],d[5]*gb[1]); w.w=cvtpk_s(d[6]*gb[2],d[7]*gb[3]);
          ATTN_STORE16(Ow+(long)row*PO+ph*64+ch*8,w); } } } }
  asm volatile("s_waitcnt lgkmcnt(0)\n\ts_barrier":::"memory");
  #undef DMA_K
  #undef DMA_V
  #undef CMASK
  #undef START
  #undef RESC
  #undef ROT
}
#undef SBAR
#undef WAIT_BAR
}
#define GAS __attribute__((address_space(1)))
#define LAS __attribute__((address_space(3)))
typedef unsigned short bfu;
typedef unsigned v4u __attribute__((ext_vector_type(4)));
typedef unsigned v2u __attribute__((ext_vector_type(2)));
typedef float f32x4 __attribute__((ext_vector_type(4)));
typedef float f32x8 __attribute__((ext_vector_type(8)));
typedef float f32x16 __attribute__((ext_vector_type(16)));
typedef short bf16x8 __attribute__((ext_vector_type(8)));
typedef short s16x4 __attribute__((ext_vector_type(4)));

constexpr int NWAVES = 8;
constexpr int NB = 8, SEQL = 2048, DMODEL = 2048, MTOK = NB * SEQL, MEML = 256, MROWS = NB * MEML;
constexpr int NIN = 5120, NKV = 1024, FFH = 5632, NGU = 2 * FFH;
constexpr int C_U = 0, C_C = 512, C_B = 1024, C_Q = 1536, C_K = 2560, C_V = 3584, C_QM = 4608;
constexpr float EPS = 1e-6f;
constexpr float LOG2E = 1.4426950408889634f;
constexpr float C2Q = 0.125f * LOG2E;
constexpr float C2M = 0.08838834764831845f * LOG2E;
constexpr float LAM_INIT = 0.2f;

constexpr size_t MiB = 1u << 20;
constexpr size_t WS_BAR = 0, BAR_ZERO_BYTES = 16384;
constexpr size_t WS_ROWSS2 = 65536 + 262144;
constexpr size_t WS_ROWSS = 65536;
constexpr size_t WS_WIN = 2 * MiB, WS_WKV = 22 * MiB, WS_WO = 26 * MiB, WS_WGU = 34 * MiB, WS_WD = 78 * MiB;
constexpr size_t WS_HB = 100 * MiB, WS_MEMN = 164 * MiB, WS_KVM = 172 * MiB, WS_VMT = 176 * MiB;
constexpr size_t WS_PROJ = 178 * MiB, WS_ODIFF = 338 * MiB, WS_MIXED = 402 * MiB, WS_OMEM = 466 * MiB, WS_END = 482 * MiB;
constexpr size_t WS_ACT = WS_PROJ;
static_assert(WS_ACT + (size_t)MTOK * FFH * 2 <= WS_MIXED, "act overlay");

constexpr int LDS_BARST = 147456 - 64;
constexpr int LDS_BYTES = 147456;

#define LDS_WAIT() asm volatile("s_waitcnt lgkmcnt(0)" ::: "memory")
__device__ __forceinline__ unsigned f2bf(float f) { unsigned u = __builtin_bit_cast(unsigned, f); return (u + 0x7fffu + ((u >> 16) & 1u)) >> 16; }
__device__ __forceinline__ unsigned pk2(float lo, float hi) { return f2bf(lo) | (f2bf(hi) << 16); }
__device__ __forceinline__ float bf_lo(unsigned w) { return __builtin_bit_cast(float, w << 16); }
__device__ __forceinline__ float bf_hi(unsigned w) { return __builtin_bit_cast(float, w & 0xffff0000u); }
__device__ __forceinline__ f32x8 unpack8(v4u w) { f32x8 t; t[0] = bf_lo(w.x); t[1] = bf_hi(w.x); t[2] = bf_lo(w.y); t[3] = bf_hi(w.y); t[4] = bf_lo(w.z); t[5] = bf_hi(w.z); t[6] = bf_lo(w.w); t[7] = bf_hi(w.w); return t; }
__device__ __forceinline__ v4u pack8(f32x8 t) { v4u w; w.x = pk2(t[0], t[1]); w.y = pk2(t[2], t[3]); w.z = pk2(t[4], t[5]); w.w = pk2(t[6], t[7]); return w; }
__device__ __forceinline__ f32x8 ld8f(const float* p) { const f32x4 a = *(const f32x4*)p, b = *(const f32x4*)(p + 4); f32x8 t; t[0] = a.x; t[1] = a.y; t[2] = a.z; t[3] = a.w; t[4] = b.x; t[5] = b.y; t[6] = b.z; t[7] = b.w; return t; }
__device__ __forceinline__ float sumsq8(f32x8 t) { return ((t[0] * t[0] + t[1] * t[1]) + (t[2] * t[2] + t[3] * t[3])) + ((t[4] * t[4] + t[5] * t[5]) + (t[6] * t[6] + t[7] * t[7])); }
__device__ __forceinline__ float wave_sum(float v) {
#pragma unroll
    for (int o = 1; o < 64; o <<= 1) v += __shfl_xor(v, o);
    return v;
}
__device__ __forceinline__ float rsq(float v) { return 1.0f / sqrtf(v); }

__device__ __forceinline__ void p0_transpose_item(const float* W, int K, int N, bfu* WT, int mode, const float* gk, LAS float* scr, int item, int lane) {
    const int nblk = N / 32, kb = item / nblk, nb = item % nblk, k0 = 64 * kb, n0 = 32 * nb;
    const int r0 = (mode == 0) ? n0 : (mode == 3) ? (256 * (n0 >> 8) + 128 * ((n0 >> 5) & 1) + 32 * ((n0 >> 6) & 3)) : (256 * (n0 >> 7) + (mode == 2 ? 128 : 0) + (n0 & 127));
#pragma unroll 8
    for (int i = 0; i < 32; ++i) { const int kk = 2 * i + (lane >> 5); scr[kk * 33 + (lane & 31)] = __builtin_nontemporal_load(W + (size_t)(k0 + kk) * N + n0 + (lane & 31)); }
    LDS_WAIT(); asm volatile("" ::: "memory");
    const int c = lane & 7;
    f32x8 gg; if (gk) gg = ld8f(gk + k0 + 8 * c); else { _Pragma("unroll") for (int i = 0; i < 8; ++i) gg[i] = 1.0f; }
    const bool pairperm = MK_FUSE_PREP && mode == 3 && n0 >= C_Q && n0 < C_V && ((n0 >> 5) & 1) == 0;
#pragma unroll
    for (int j = 0; j < 4; ++j) { const int n = (lane >> 3) + 8 * j; const LAS float* s = scr + (8 * c) * 33 + n;
        v4u o; o.x = pk2(s[0 * 33] * gg[0], s[1 * 33] * gg[1]); o.y = pk2(s[2 * 33] * gg[2], s[3 * 33] * gg[3]); o.z = pk2(s[4 * 33] * gg[4], s[5 * 33] * gg[5]); o.w = pk2(s[6 * 33] * gg[6], s[7 * 33] * gg[7]);
        const int nd = (pairperm && n < 16) ? (8 * ((n >> 2) & 1) + 4 * (n >> 3) + (n & 3)) : n;
        *(v4u*)(WT + (size_t)(r0 + nd) * K + k0 + 8 * c) = o; }
    LDS_WAIT(); asm volatile("" ::: "memory");
}
__device__ __forceinline__ void rms_row_to_bf16(const float* xrow, const float* g, bfu* orow, int lane) {
    const f32x4* xr = (const f32x4*)xrow + lane; const f32x4* gr = (const f32x4*)g + lane;
    f32x4 v[8]; float s = 0.f;
#pragma unroll
    for (int j = 0; j < 8; ++j) { v[j] = __builtin_nontemporal_load(xr + 64 * j); s += (v[j].x * v[j].x + v[j].y * v[j].y) + (v[j].z * v[j].z + v[j].w * v[j].w); }
    const float r = rsq(wave_sum(s) * (1.f / DMODEL) + EPS);
    unsigned long long* o8 = (unsigned long long*)orow + lane;
#pragma unroll
    for (int j = 0; j < 8; ++j) { const f32x4 gg = gr[64 * j]; const f32x4 o = v[j] * r * gg;
        o8[64 * j] = (unsigned long long)pk2(o.x, o.y) | ((unsigned long long)pk2(o.z, o.w) << 32); }
}

__device__ __forceinline__ void prep_phase(bfu* PROJ, bfu* DST, int dmask, const int* positions, const float* g_dq, const float* g_dk, const float* g_mq, int gw, int NGW, int lane) {
    const int sub = lane & 7;
    const f32x8 gq = ld8f(g_dq + 8 * sub), gk = ld8f(g_dk + 8 * sub), gmq = ld8f(g_mq + 8 * (lane & 15));
    constexpr double I2PI = 0.15915494309189535;
    constexpr double IF0 = 1.0 * I2PI, IF1 = 0.19392274474868576 * I2PI, IF2 = 0.03760603093086393 * I2PI, IF3 = 0.007292664737217109 * I2PI,
                     IF4 = 0.001414213562373095 * I2PI, IF5 = 0.0002742481756762073 * I2PI, IF6 = 5.318295896944988e-05 * I2PI, IF7 = 1.031338537721246e-05 * I2PI;
    v4u nx[5]; int npos = 0;
#define PREP_LOAD(mm) { const bfu* pr_ = PROJ + (size_t)(mm) * NIN; _Pragma("unroll") for (int s_ = 0; s_ < 4; ++s_) nx[s_] = *(const v4u*)(pr_ + C_Q + s_ * 512 + lane * 8); nx[4] = *(const v4u*)(pr_ + C_QM + lane * 8); npos = positions[mm]; }
    if (gw < MTOK) PREP_LOAD(gw)
    for (int m = gw; m < MTOK; m += NGW) {
        bfu* drow = DST + (size_t)(m & dmask) * NIN;
        v4u cu[5];
#pragma unroll
        for (int s_ = 0; s_ < 5; ++s_) cu[s_] = nx[s_];
        const double pos = (double)npos;
        if (m + NGW < MTOK) PREP_LOAD(m + NGW)
        f32x8 cs, sn;
#define ROPE_J(j, IFJ) { double rev = pos * (IFJ); rev -= __builtin_rint(rev); const float fr = (float)rev; cs[j] = __builtin_amdgcn_cosf(fr); sn[j] = __builtin_amdgcn_sinf(fr); }
        ROPE_J(0, IF0) ROPE_J(1, IF1) ROPE_J(2, IF2) ROPE_J(3, IF3) ROPE_J(4, IF4) ROPE_J(5, IF5) ROPE_J(6, IF6) ROPE_J(7, IF7)
#undef ROPE_J
#pragma unroll
        for (int st = 0; st < 4; ++st) {
            f32x8 t = unpack8(cu[st]);
            float ss = sumsq8(t); ss += __shfl_xor(ss, 1); ss += __shfl_xor(ss, 2); ss += __shfl_xor(ss, 4);
            const float r = rsq(ss * (1.f / 64.f) + EPS);
            const f32x8 g = (st < 2) ? gq : gk;
#pragma unroll
            for (int i = 0; i < 8; ++i) t[i] = t[i] * r * g[i];
            f32x8 o;
#pragma unroll
            for (int i = 0; i < 8; ++i) { const float other = __shfl_xor(t[i], 1);
                o[i] = (sub == 0) ? (t[i] * cs[i] - other * sn[i]) : ((sub == 1) ? (t[i] * cs[i] + other * sn[i]) : t[i]); }
            if (st < 2) {
#pragma unroll
                for (int i = 0; i < 8; ++i) o[i] *= C2Q;
            }
            *(v4u*)(drow + C_Q + st * 512 + lane * 8) = pack8(o);
        }
        {
            f32x8 t = unpack8(cu[4]);
            float ss = sumsq8(t); ss += __shfl_xor(ss, 1); ss += __shfl_xor(ss, 2); ss += __shfl_xor(ss, 4); ss += __shfl_xor(ss, 8);
            const float r = rsq(ss * (1.f / 128.f) + EPS) * C2M;
#pragma unroll
            for (int i = 0; i < 8; ++i) t[i] = t[i] * r * gmq[i];
            *(v4u*)(drow + C_QM + lane * 8) = pack8(t);
        }
    }
#undef PREP_LOAD
}

namespace memattn {
constexpr int KSTR = 272, VSTR = 520;
constexpr int LDS_KM = 0, LDS_VT = MEML * KSTR, LDS_TOTAL = LDS_VT + 128 * VSTR;
static_assert(LDS_TOTAL <= LDS_BYTES, "mem-attn LDS");
__device__ __forceinline__ int crow(int r, int hi) { return (r & 3) + 8 * (r >> 2) + 4 * hi; }
__device__ __forceinline__ unsigned cvtpk(float lo, float hi) { typedef float f2 __attribute__((ext_vector_type(2))); typedef __bf16 b2 __attribute__((ext_vector_type(2))); f2 v = {lo, hi}; b2 b = __builtin_convertvector(v, b2); return __builtin_bit_cast(unsigned, b); }
__device__ __forceinline__ bf16x8 pack_half(const f32x16& p, int s) { v4u w; w.x = cvtpk(p[8 * s], p[8 * s + 1]); w.y = cvtpk(p[8 * s + 2], p[8 * s + 3]); w.z = cvtpk(p[8 * s + 4], p[8 * s + 5]); w.w = cvtpk(p[8 * s + 6], p[8 * s + 7]); return __builtin_bit_cast(bf16x8, w); }
__device__ __forceinline__ void mem_unit(int tid, int b, int h, int qblk, const bfu* PROJ, const bfu* KVM, const float* g_mk, const float* g_mq, bfu* MIXED, float* rowss2, LAS unsigned char* lds) {
    const int lane = tid & 63, r32 = lane & 31, hi = lane >> 5; const int wid = __builtin_amdgcn_readfirstlane(tid >> 6);
    { const f32x8 gmk = ld8f(g_mk + 8 * (tid & 15));
#pragma unroll
      for (int i = 0; i < 8; ++i) { const int c = tid + 512 * i, kv = c >> 4, ch = c & 15;
        f32x8 t = unpack8(*(const v4u*)(KVM + (size_t)(b * MEML + kv) * NKV + h * 128 + ch * 8));
        float ss = sumsq8(t); ss += __shfl_xor(ss, 1); ss += __shfl_xor(ss, 2); ss += __shfl_xor(ss, 4); ss += __shfl_xor(ss, 8);
        const float r = rsq(ss * (1.f / 128.f) + EPS);
        t = t * r * gmk;
        *(LAS v4u*)(lds + LDS_KM + kv * KSTR + ch * 16) = pack8(t); } }
#pragma unroll
    for (int i = 0; i < 8; ++i) { const int c = tid + 512 * i, kv = c & 255, ch = c >> 8;
        const v4u w = *(const v4u*)(KVM + (size_t)(b * MEML + kv) * NKV + 512 + h * 128 + ch * 8);
        LAS bfu* dst = (LAS bfu*)(lds + LDS_VT + (ch * 8) * VSTR + kv * 2);
        dst[0 * (VSTR / 2)] = (bfu)(w.x & 0xffffu); dst[1 * (VSTR / 2)] = (bfu)(w.x >> 16); dst[2 * (VSTR / 2)] = (bfu)(w.y & 0xffffu); dst[3 * (VSTR / 2)] = (bfu)(w.y >> 16);
        dst[4 * (VSTR / 2)] = (bfu)(w.z & 0xffffu); dst[5 * (VSTR / 2)] = (bfu)(w.z >> 16); dst[6 * (VSTR / 2)] = (bfu)(w.w & 0xffffu); dst[7 * (VSTR / 2)] = (bfu)(w.w >> 16); }
    __syncthreads();
    const size_t row = (size_t)b * SEQL + qblk * 256 + wid * 32 + r32;
    const bfu* qrow = PROJ + row * NIN + C_QM + h * 128 + hi * 8;
    bf16x8 qf[8];
#pragma unroll
    for (int d0 = 0; d0 < 8; ++d0) qf[d0] = *(const bf16x8*)(qrow + d0 * 16);
#if MK_FUSE_PREP
    {
        float ss = 0.f;
#pragma unroll
        for (int d0 = 0; d0 < 8; ++d0) ss += sumsq8(unpack8(__builtin_bit_cast(v4u, qf[d0])));
        ss += __shfl_xor(ss, 32);
        const float r = rsq(ss * (1.f / 128.f) + EPS) * C2M;
#pragma unroll
        for (int d0 = 0; d0 < 8; ++d0) { f32x8 t = unpack8(__builtin_bit_cast(v4u, qf[d0])); const f32x8 g = ld8f(g_mq + d0 * 16 + hi * 8); t = t * r * g; qf[d0] = __builtin_bit_cast(bf16x8, pack8(t)); }
    }
#endif
    f32x16 oT[4];
#pragma unroll
    for (int dt = 0; dt < 4; ++dt)
#pragma unroll
        for (int r = 0; r < 16; ++r) oT[dt][r] = 0.f;
    float mrun = -1e30f, l = 0.f;
#pragma unroll 1
    for (int kc = 0; kc < 4; ++kc) {
        f32x16 p0, p1;
#pragma unroll
        for (int r = 0; r < 16; ++r) { p0[r] = 0.f; p1[r] = 0.f; }
        const LAS unsigned char* kb = lds + LDS_KM + (kc * 64 + r32) * KSTR + hi * 16;
#pragma unroll
        for (int d0 = 0; d0 < 8; ++d0) { const bf16x8 a0 = *(const LAS bf16x8*)(kb + d0 * 32), a1 = *(const LAS bf16x8*)(kb + 32 * KSTR + d0 * 32);
            p0 = __builtin_amdgcn_mfma_f32_32x32x16_bf16(a0, qf[d0], p0, 0, 0, 0); p1 = __builtin_amdgcn_mfma_f32_32x32x16_bf16(a1, qf[d0], p1, 0, 0, 0); }
        float mx = fmaxf(p0[0], p1[0]);
#pragma unroll
        for (int r = 1; r < 16; ++r) mx = fmaxf(mx, fmaxf(p0[r], p1[r]));
        mx = fmaxf(mx, __shfl_xor(mx, 32));
        const float mnew = fmaxf(mrun, mx), f = __builtin_amdgcn_exp2f(mrun - mnew); mrun = mnew;
        l *= f;
#pragma unroll
        for (int dt = 0; dt < 4; ++dt)
#pragma unroll
            for (int r = 0; r < 16; ++r) oT[dt][r] *= f;
        float sacc = 0.f;
#pragma unroll
        for (int r = 0; r < 16; ++r) { p0[r] = __builtin_amdgcn_exp2f(p0[r] - mnew); p1[r] = __builtin_amdgcn_exp2f(p1[r] - mnew); sacc += p0[r] + p1[r]; }
        l += sacc;
        bf16x8 pa[4]; pa[0] = pack_half(p0, 0); pa[1] = pack_half(p0, 1); pa[2] = pack_half(p1, 0); pa[3] = pack_half(p1, 1);
#pragma unroll
        for (int s = 0; s < 4; ++s)
#pragma unroll
            for (int dt = 0; dt < 4; ++dt) { const LAS unsigned char* va = lds + LDS_VT + (dt * 32 + r32) * VSTR + (kc * 64 + 16 * s + 4 * hi) * 2;
                const s16x4 lo = *(const LAS s16x4*)va, h4 = *(const LAS s16x4*)(va + 16);
                const bf16x8 a = __builtin_shufflevector(lo, h4, 0, 1, 2, 3, 4, 5, 6, 7);
                oT[dt] = __builtin_amdgcn_mfma_f32_32x32x16_bf16(a, pa[s], oT[dt], 0, 0, 0); }
    }
    l += __shfl_xor(l, 32);
    const float inv = 1.0f / l;
    bfu* orow = MIXED + row * DMODEL + 1536 + h * 128;
    { float ss = 0.f;
#pragma unroll
      for (int dt = 0; dt < 4; ++dt)
#pragma unroll
          for (int r = 0; r < 16; ++r) { const float v = oT[dt][r] * inv; ss += v * v; }
      ss += __shfl_xor(ss, 32);
      if (hi == 0) unsafeAtomicAdd(rowss2 + row, ss); }
#pragma unroll
    for (int dt = 0; dt < 4; ++dt)
#pragma unroll
        for (int g = 0; g < 4; ++g) { v2u w; w.x = pk2(oT[dt][4 * g] * inv, oT[dt][4 * g + 1] * inv); w.y = pk2(oT[dt][4 * g + 2] * inv, oT[dt][4 * g + 3] * inv);
            *(v2u*)(orow + dt * 32 + 8 * g + 4 * hi) = w; }
    __syncthreads();
}
}

__device__ __forceinline__ void conv_phase(const bfu* PROJ, bfu* MIXED, const float* conv_w, const float* g_conv_out, int gw, int NGW, int lane) {
    const f32x8 w0 = ld8f(conv_w + lane * 8), w1 = ld8f(conv_w + 512 + lane * 8), w2 = ld8f(conv_w + 1024 + lane * 8), gco = ld8f(g_conv_out + lane * 8);
    v4u nx[7];
#define CONV_LOAD(mm) { const int s_ = (mm) & (SEQL - 1); const bfu* p0_ = PROJ + (size_t)(mm) * NIN + lane * 8; const bfu* p1_ = p0_ - (s_ >= 1 ? NIN : 0); const bfu* p2_ = p0_ - (s_ >= 2 ? 2 * NIN : 0); \
        nx[0] = *(const v4u*)(p0_ + C_U); nx[1] = *(const v4u*)(p0_ + C_C); nx[2] = *(const v4u*)(p0_ + C_B); nx[3] = *(const v4u*)(p1_ + C_U); nx[4] = *(const v4u*)(p1_ + C_C); nx[5] = *(const v4u*)(p2_ + C_U); nx[6] = *(const v4u*)(p2_ + C_C); }
    if (gw < MTOK) CONV_LOAD(gw)
    for (int m = gw; m < MTOK; m += NGW) {
        const int s = m & (SEQL - 1);
        v4u cu[7];
#pragma unroll
        for (int i = 0; i < 7; ++i) cu[i] = nx[i];
        if (m + NGW < MTOK) CONV_LOAD(m + NGW)
        const f32x8 z2 = unpack8(cu[0]) * unpack8(cu[1]), bg = unpack8(cu[2]);
        const float k1 = (s >= 1) ? 1.f : 0.f, k0 = (s >= 2) ? 1.f : 0.f;
        const f32x8 z1 = unpack8(cu[3]) * unpack8(cu[4]) * k1, z0 = unpack8(cu[5]) * unpack8(cu[6]) * k0;
        f32x8 y = bg * (w0 * z0 + w1 * z1 + w2 * z2);
        const float r = rsq(wave_sum(sumsq8(y)) * (1.f / 512.f) + EPS);
        y = y * r * gco;
        *(v4u*)(MIXED + (size_t)m * DMODEL + lane * 8) = pack8(y);
    }
#undef CONV_LOAD
}
__device__ __forceinline__ void finalize_phase(const bfu* PROJ, const bfu* ODIFF, const bfu* OMEM, bfu* MIXED, const float* conv_w, const float* g_conv_out, const float* lq1, const float* lk1, const float* lq2, const float* lk2,
                                               const float* g_sub, const float* g_mem_out, int gw, int NGW, int lane) {
#if !MK_FUSE_PREP
    conv_phase(PROJ, MIXED, conv_w, g_conv_out, gw, NGW, lane);
#endif
    const f32x8 gmo = ld8f(g_mem_out + lane * 8);
    const int hd = lane >> 3, sub = lane & 7;
    const f32x8 gs0 = ld8f(g_sub + sub * 16), gs1 = ld8f(g_sub + sub * 16 + 8);
    const float lam = __expf(wave_sum(lq1[lane] * lk1[lane])) - __expf(wave_sum(lq2[lane] * lk2[lane])) + LAM_INIT;
    v4u nx[5];
#define FIN_LOAD(mm) { nx[4] = *(const v4u*)(OMEM + (size_t)(mm) * 512 + lane * 8); }
    if (gw < MTOK) FIN_LOAD(gw)
    for (int m = gw; m < MTOK; m += NGW) {
        bfu* mrow = MIXED + (size_t)m * DMODEL;
        v4u cu[5];
#pragma unroll
        for (int i = 0; i < 5; ++i) cu[i] = nx[i];
        if (m + NGW < MTOK) FIN_LOAD(m + NGW)
        {
            f32x8 t = unpack8(cu[4]);
            const float r = rsq(wave_sum(sumsq8(t)) * (1.f / 512.f) + EPS);
            t = t * r * gmo;
            *(v4u*)(mrow + 1536 + lane * 8) = pack8(t);
        }
    }
#undef FIN_LOAD
}

#define XB_TMO      128
#define XB_XCNT(j)  (256  + 64 * (j))
#define XB_XSUB(j)  (1280 + 64 * (j))
#define XB_XGEN(j)  (2304 + 64 * (j))
#define XB_TOP      3328
#define XB_TOPGEN   3392
#define XCD_BAR_WORDS 3456
#define XB_SPIN_CAP (1u << 18)

__device__ __forceinline__ unsigned xb_ld(unsigned* p)              { return __hip_atomic_load(p, __ATOMIC_RELAXED, __HIP_MEMORY_SCOPE_AGENT); }
__device__ __forceinline__ unsigned xb_add(unsigned* p, unsigned v) { return __hip_atomic_fetch_add(p, v, __ATOMIC_RELAXED, __HIP_MEMORY_SCOPE_AGENT); }
__device__ __forceinline__ unsigned xb_xcc_id() { return (unsigned)__builtin_amdgcn_s_getreg((3 << 11) | 20) & 0xFu; }
#define XB_SPIN(cond, bar) do { unsigned _sp = 0; while (cond) { __builtin_amdgcn_s_sleep(1); \
    if ((++_sp & 255u) == 0u) { if (xb_ld(&(bar)[XB_TMO])) break; if (_sp > XB_SPIN_CAP) { atomicAdd(&(bar)[XB_TMO], 1u); break; } } } } while (0)

struct XcdBarrier {
    unsigned* bar; unsigned x;
    volatile LAS unsigned* st;
};

__device__ __forceinline__ XcdBarrier xcd_barrier_post(unsigned* bar, volatile LAS unsigned* st, int tid) {
    XcdBarrier b; b.bar = bar; b.x = xb_xcc_id(); b.st = st;
    if (tid == 0) (void)xb_add(&bar[XB_XCNT(b.x)], 1u);
    return b;
}
__device__ __forceinline__ void xcd_barrier_complete(unsigned* bar, unsigned x, unsigned& nloc, unsigned& nx) {
    const unsigned G = gridDim.x * gridDim.y * gridDim.z;
    unsigned sum, cnt, mine, sp = 0u;
    for (;;) {
        sum = 0u; cnt = 0u; mine = 0u;
#pragma unroll
        for (unsigned j = 0; j < 16; ++j) { const unsigned c = xb_ld(&bar[XB_XCNT(j)]); sum += c; cnt += (c > 0u) ? 1u : 0u; mine = (j == x) ? c : mine; }
        if (sum == G) break;
        __builtin_amdgcn_s_sleep(1);
        if ((++sp & 255u) == 0u) { if (xb_ld(&bar[XB_TMO])) break; if (sp > XB_SPIN_CAP) { atomicAdd(&bar[XB_TMO], 1u); break; } }
    }
    nloc = mine > 0u ? mine : 1u; nx = cnt > 0u ? cnt : 1u;
}

__device__ __forceinline__ void xcd_barrier(const XcdBarrier& b, int tid) {
    asm volatile("s_waitcnt vmcnt(0)" ::: "memory");
    __syncthreads();
    if (tid == 0) {
        unsigned* bar = b.bar;
        __builtin_amdgcn_s_waitcnt(0);
        unsigned nloc = b.st[0], nx = b.st[1];
        if (nloc == 0u) { xcd_barrier_complete(bar, b.x, nloc, nx); b.st[0] = nloc; b.st[1] = nx; }
        const unsigned old = xb_add(&bar[XB_XSUB(b.x)], 1u);
        const unsigned gen = old / nloc;
        if (old + 1u == (gen + 1u) * nloc) {
            __builtin_amdgcn_fence(__ATOMIC_RELEASE, "agent");
            asm volatile("s_waitcnt vmcnt(0)" ::: "memory");
            const unsigned og = xb_add(&bar[XB_TOP], 1u);
            const unsigned tg = og / nx;
            if (og + 1u == (tg + 1u) * nx) xb_add(&bar[XB_TOPGEN], 1u);
            else XB_SPIN(xb_ld(&bar[XB_TOPGEN]) == tg, bar);
            __builtin_amdgcn_fence(__ATOMIC_ACQUIRE, "agent");
            xb_add(&bar[XB_XGEN(b.x)], 1u);
            asm volatile("s_waitcnt vmcnt(0)" ::: "memory");
        } else {
            XB_SPIN(xb_ld(&bar[XB_XGEN(b.x)]) == gen, bar);
            __builtin_amdgcn_fence(__ATOMIC_ACQUIRE, "agent");
            asm volatile("s_waitcnt vmcnt(0)" ::: "memory");
        }
    }
    __syncthreads();
}

__device__ __forceinline__ int fresh_tid(int wave) { unsigned z; asm volatile("s_mov_b32 %0, 0" : "=s"(z)); return wave * 64 + (int)__builtin_amdgcn_mbcnt_hi(~0u, __builtin_amdgcn_mbcnt_lo(~0u, z)); }
struct Args { const float* in[24]; float* out; unsigned char* ws; int ph_lo, ph_hi; };
constexpr int N_PHASES = 8;
__global__ void __launch_bounds__(NWAVES * 64, 2) mk_fwd(Args a) {
    extern __shared__ __attribute__((aligned(16))) unsigned char lds_raw[];
    LAS unsigned char* lds = (LAS unsigned char*)lds_raw;
    cg::grid_group grid = cg::this_grid();
    const int wave0 = __builtin_amdgcn_readfirstlane((int)threadIdx.x >> 6);
    const int G = gridDim.x, bx = blockIdx.x, vcu = (G % 8 == 0) ? (bx % 8) * (G / 8) + bx / 8 : bx;
    const int NGW = G * NWAVES;
#define LANE_VARS() const int tid_ = fresh_tid(wave0); const int lane = tid_ & 63, wave = wave0, gw = vcu * NWAVES + wave; (void)lane; (void)gw;
    typedef const __attribute__((address_space(4))) Args* kargs_t;
#define KARGS() ({ unsigned long long v_ = (unsigned long long)__builtin_amdgcn_kernarg_segment_ptr(); asm volatile("" : "+s"(v_)); (kargs_t)v_; })
#define WSP(ka, off) ((bfu*)((ka)->ws + (off)))
#define IN(k) (a.ph_lo <= (k) && (k) < a.ph_hi)
#define SEAM(k) do { if (IN(k) && IN((k) + 1)) { xcd_barrier(xbar, fresh_tid(wave0)); if (PROBE_DUP == 100) xcd_barrier(xbar, fresh_tid(wave0)); } } while (0)
    volatile LAS unsigned* xst = (volatile LAS unsigned*)(lds + LDS_BARST);
    { const int t_ = fresh_tid(wave0); if (t_ == 0) { xst[0] = 0u; xst[1] = 0u; } __syncthreads(); }
    XcdBarrier xbar; xbar.bar = (unsigned*)(a.ws + WS_BAR); xbar.x = 0; xbar.st = xst;
    if (a.ph_hi - a.ph_lo > 2) { xbar = xcd_barrier_post((unsigned*)(a.ws + WS_BAR), xst, fresh_tid(wave0)); if (PROBE_DUP == 101) grid.sync(); }

    for (int rep_ = 0; rep_ < (PROBE_DUP == 0 ? 2 : 1); ++rep_) if (IN(0)) {
        LANE_VARS(); kargs_t ka = KARGS(); const float *x = ka->in[0], *mem = ka->in[1], *g_mix = ka->in[3], *g_mem = ka->in[4], *w_in = ka->in[5], *w_mem_kv = ka->in[15], *w_o = ka->in[19], *w_gate = ka->in[21], *w_up = ka->in[22], *w_down = ka->in[23], *g_ffn = ka->in[20];
        bfu *WIN = WSP(ka, WS_WIN), *WKV = WSP(ka, WS_WKV), *WO = WSP(ka, WS_WO), *WGU = WSP(ka, WS_WGU), *WD = WSP(ka, WS_WD), *HB = WSP(ka, WS_HB), *MEMN = WSP(ka, WS_MEMN);
        LAS float* scr = (LAS float*)(lds + wave * 16384);
        constexpr int I_IN = (DMODEL / 64) * (NIN / 32), I_KV = (DMODEL / 64) * (NKV / 32), I_O = (DMODEL / 64) * (DMODEL / 32), I_G = (DMODEL / 64) * (FFH / 32), I_D = (FFH / 64) * (DMODEL / 32);
        constexpr int NITEMS = I_IN + I_KV + (MK_FUSE_PREP ? 0 : 2 * I_G);
        for (int it = gw; it < NITEMS; it += NGW) {
            int r = it;
            if (r < I_IN) { p0_transpose_item(w_in, DMODEL, NIN, WIN, 3, nullptr, scr, r, lane); continue; } r -= I_IN;
            if (r < I_KV) { p0_transpose_item(w_mem_kv, DMODEL, NKV, WKV, 0, nullptr, scr, r, lane); continue; } r -= I_KV;
            if (r < I_G) { p0_transpose_item(w_gate, DMODEL, FFH, WGU, 1, g_ffn, scr, r, lane); continue; } r -= I_G;
            p0_transpose_item(w_up, DMODEL, FFH, WGU, 2, g_ffn, scr, r, lane);
        }
        { float* rowss = (float*)(ka->ws + WS_ROWSS); float* rowss2 = (float*)(ka->ws + WS_ROWSS2); for (int i = gw * 64 + lane; i < MTOK; i += NGW * 64) { rowss[i] = 0.f; rowss2[i] = 0.f; } }
        for (int m = gw; m < MTOK; m += NGW) rms_row_to_bf16(x + (size_t)m * DMODEL, g_mix, HB + (size_t)m * DMODEL, lane);
        for (int m = gw; m < MROWS; m += NGW) rms_row_to_bf16(mem + (size_t)m * DMODEL, g_mem, MEMN + (size_t)m * DMODEL, lane);
        __syncthreads();
    }
    SEAM(0);
    for (int rep_ = 0; rep_ < (PROBE_DUP == 1 ? 2 : 1); ++rep_) if (IN(1)) {
        kargs_t ka = KARGS(); bfu *WIN = WSP(ka, WS_WIN), *HB = WSP(ka, WS_HB), *PROJ = WSP(ka, WS_PROJ);
        { pg8::Gemm g{HB, WIN, MTOK, NIN, DMODEL}; pg8::StaticOrder S; S.init(MTOK, NIN, G, bx); pg8::EpiProj<MK_FUSE_PREP != 0> E{PROJ, NIN, (const int*)ka->in[2], ka->in[8], ka->in[9], C2Q, EPS};
          pg8::gemm_phase<pg8::EpiProj<MK_FUSE_PREP != 0>, pg8::StaticOrder, true, true>(fresh_tid(wave0), lds, g, S, E); }
    }
    SEAM(1);
    for (int rep_ = 0; rep_ < (PROBE_DUP == 2 ? 2 : 1); ++rep_) if (IN(2)) {
        constexpr int NGEMM = 32; const bool split = G >= 2 * NGEMM;
        if (!split || bx < NGEMM) { kargs_t ka = KARGS(); pg8::Gemm g{WSP(ka, WS_MEMN), WSP(ka, WS_WKV), MROWS, NKV, DMODEL}; pg8::StaticOrder S; S.init(MROWS, NKV, split ? NGEMM : G, bx); pg8::EpiStoreBf16 E{WSP(ka, WS_KVM), NKV};
            pg8::gemm_phase<pg8::EpiStoreBf16, pg8::StaticOrder, true, true>(fresh_tid(wave0), lds, g, S, E); }
        if (!split || bx >= NGEMM) { LANE_VARS(); kargs_t ka = KARGS(); const int ci = split ? bx - NGEMM : bx, ncu = split ? G - NGEMM : G;
#if !MK_FUSE_PREP
            prep_phase(WSP(ka, WS_PROJ), WSP(ka, WS_PROJ), 0xffffff, (const int*)ka->in[2], ka->in[8], ka->in[9], ka->in[16], ci * NWAVES + wave, ncu * NWAVES, lane);
#else
            conv_phase(WSP(ka, WS_PROJ), WSP(ka, WS_MIXED), ka->in[6], ka->in[7], ci * NWAVES + wave, ncu * NWAVES, lane);
#endif
            { constexpr int I_O = (DMODEL / 64) * (DMODEL / 32), I_D = (FFH / 64) * (DMODEL / 32), I_G = MK_FUSE_PREP ? (DMODEL / 64) * (FFH / 32) : 0; LAS float* scr = (LAS float*)(lds + wave * 16384);
              const float *w_o = ka->in[19], *w_down = ka->in[23]; bfu *WO = WSP(ka, WS_WO), *WD = WSP(ka, WS_WD);
              for (int it = ci * NWAVES + wave; it < I_O + I_D + 2 * I_G; it += ncu * NWAVES) { int r = it;
                  if (r < I_O) { p0_transpose_item(w_o, DMODEL, DMODEL, WO, 0, (64 * (r / (DMODEL / 32)) >= 1536) ? ka->in[18] - 1536 : nullptr, scr, r, lane); continue; } r -= I_O;
                  if (r < I_D) { p0_transpose_item(w_down, FFH, DMODEL, WD, 0, nullptr, scr, r, lane); continue; } r -= I_D;
                  if (r < I_G) { p0_transpose_item(ka->in[21], DMODEL, FFH, WSP(ka, WS_WGU), 1, ka->in[20], scr, r, lane); continue; } r -= I_G;
                  p0_transpose_item(ka->in[22], DMODEL, FFH, WSP(ka, WS_WGU), 2, ka->in[20], scr, r, lane); }
              __syncthreads(); } }
    }
    SEAM(2);
    for (int rep_ = 0; rep_ < (PROBE_DUP == 3 ? 2 : 1); ++rep_) if (IN(3)) {
        kargs_t ka = KARGS(); bfu *PROJ = WSP(ka, WS_PROJ), *ODIFF = WSP(ka, WS_ODIFF), *KVM = WSP(ka, WS_KVM);
        for (int s = vcu; s < NB * 32; s += G) {
            const int pr = s & 3, h = (s >> 2) & 7, b = s >> 5;
            const attn_body::bf16* base = (const attn_body::bf16*)PROJ + (size_t)b * SEQL * NIN;
            const attn_body::bf16* Q0 = base + C_Q + h * 128; const attn_body::bf16* K0 = base + C_K + h * 128; const attn_body::bf16* Vh = base + C_V + h * 128;
            attn_body::bf16* Opark = (attn_body::bf16*)ODIFF + (size_t)b * SEQL * DMODEL + h * 256;
            attn_body::bf16* Omix = (attn_body::bf16*)WSP(ka, WS_MIXED) + (size_t)b * SEQL * DMODEL + 512 + h * 128;
            float lam; { LANE_VARS(); lam = __expf(wave_sum(ka->in[10][lane] * ka->in[11][lane])) - __expf(wave_sum(ka->in[12][lane] * ka->in[13][lane])) + LAM_INIT; }
            const float* gsub = ka->in[14];
#define AU2_(q) do { attn_body::attn_unit<8, 0>(fresh_tid(wave0), (q), Q0, K0, Vh, Opark, (char*)lds_raw, nullptr, 0.f, nullptr, 0.f); \
                     attn_body::attn_unit<8, 1>(fresh_tid(wave0), (q), Q0 + 64, K0 + 64, Vh, Omix, (char*)lds_raw, Opark, lam, gsub, 1.0f - LAM_INIT); } while (0)
            if (pr == 0) { AU2_(7); AU2_(0); } else if (pr == 1) { AU2_(6); AU2_(1); } else if (pr == 2) { AU2_(5); AU2_(2); } else { AU2_(4); AU2_(3); }
#undef AU2_
        }
        for (int mrep_ = 0; mrep_ < (PROBE_DUP == 103 ? 2 : 1); ++mrep_)
        for (int u = vcu; u < NB * 4 * 8; u += G) memattn::mem_unit(fresh_tid(wave0), u >> 5, (u >> 3) & 3, u & 7, PROJ, KVM, ka->in[17], ka->in[16], WSP(ka, WS_MIXED), (float*)(ka->ws + WS_ROWSS2), lds);
    }
    SEAM(3);
    for (int rep_ = 0; rep_ < (PROBE_DUP == 5 ? 2 : 1); ++rep_) if (IN(5)) { kargs_t ka = KARGS(); const float* x = ka->in[0]; bfu *MIXED = WSP(ka, WS_MIXED), *WO = WSP(ka, WS_WO);
        pg8::Gemm g{MIXED, WO, MTOK, DMODEL, DMODEL}; pg8::StaticOrder S; S.init(MTOK, DMODEL, G, bx); pg8::EpiResNormMid E{x, DMODEL, WSP(ka, WS_HB), (float*)(ka->ws + WS_ROWSS + (rep_ == 0 ? 0 : 131072)), (const float*)(ka->ws + WS_ROWSS2), 1.0f / 512.0f, EPS};
        pg8::gemm_phase<pg8::EpiResNormMid, pg8::StaticOrder, true, true>(fresh_tid(wave0), lds, g, S, E); }
    SEAM(5);
    for (int rep_ = 0; rep_ < (PROBE_DUP == 6 ? 2 : 1); ++rep_) if (IN(6)) { kargs_t ka = KARGS(); bfu *HB = WSP(ka, WS_HB), *WGU = WSP(ka, WS_WGU), *ACT = WSP(ka, WS_ACT);
        pg8::Gemm g{HB, WGU, MTOK, NGU, DMODEL}; pg8::StaticOrder S; S.init(MTOK, NGU, G, bx); pg8::EpiSwiGLU E{ACT, FFH, (const float*)(ka->ws + WS_ROWSS), 1.0f / DMODEL, EPS};
        pg8::gemm_phase<pg8::EpiSwiGLU, pg8::StaticOrder, true, true>(fresh_tid(wave0), lds, g, S, E); }
    SEAM(6);
    for (int rep_ = 0; rep_ < (PROBE_DUP == 7 ? 2 : 1); ++rep_) if (IN(7)) { kargs_t ka = KARGS(); float* out = ka->out; bfu *ACT = WSP(ka, WS_ACT), *WD = WSP(ka, WS_WD);
        pg8::Gemm g{ACT, WD, MTOK, DMODEL, FFH}; pg8::StaticOrder S; S.init(MTOK, DMODEL, G, bx); pg8::EpiResBf16 E{WSP(ka, WS_HB), out, DMODEL};
        pg8::gemm_phase<pg8::EpiResBf16, pg8::StaticOrder, true, true>(fresh_tid(wave0), lds, g, S, E); }
#undef IN
#undef SEAM
#undef KARGS
#undef LANE_VARS
#undef WSP
}

extern "C" void kernel_launch(void* const* d_in, const int* in_sizes, int n_in, void* d_out, int out_size, void* d_ws, size_t ws_size, hipStream_t stream) {
    static int grid = 0;
    if (grid == 0) {
        if (n_in != 24 || in_sizes[0] != MTOK * DMODEL || out_size != MTOK * DMODEL || ws_size < WS_END) {
            fprintf(stderr, "kernel_launch: unexpected shapes (n_in %d, in0 %d, out %d, ws %zu); nothing launched\n", n_in, n_in > 0 ? in_sizes[0] : -1, out_size, ws_size); grid = -1; return; }
        int dev = 0, cus = 0, per_cu = 0;
        if (hipGetDevice(&dev) != hipSuccess || hipDeviceGetAttribute(&cus, hipDeviceAttributeMultiprocessorCount, dev) != hipSuccess) { fprintf(stderr, "kernel_launch: device query failed\n"); grid = -1; return; }
        if (hipFuncSetAttribute((const void*)mk_fwd, hipFuncAttributeMaxDynamicSharedMemorySize, LDS_BYTES) != hipSuccess) { fprintf(stderr, "kernel_launch: hipFuncSetAttribute failed\n"); grid = -1; return; }
        if (hipOccupancyMaxActiveBlocksPerMultiprocessor(&per_cu, (const void*)mk_fwd, NWAVES * 64, LDS_BYTES) != hipSuccess || per_cu < 1) { fprintf(stderr, "kernel_launch: occupancy query reports %d workgroups per CU\n", per_cu); (void)hipGetLastError(); grid = -1; return; }
        grid = cus;
    }
    if (grid < 0) return;
    if (hipMemsetAsync((char*)d_ws + WS_BAR, 0, BAR_ZERO_BYTES, stream) != hipSuccess) { fprintf(stderr, "kernel_launch: hipMemsetAsync of the barrier words failed\n"); return; }
    Args a{};
    for (int i = 0; i < 24; ++i) a.in[i] = (const float*)d_in[i];
    a.out = (float*)d_out; a.ws = (unsigned char*)d_ws;
#if MK_MULTI
    for (int p = 0; p < N_PHASES; ++p) { a.ph_lo = p; a.ph_hi = p + 1; hipLaunchKernelGGL(mk_fwd, dim3(grid), dim3(NWAVES * 64), LDS_BYTES, stream, a); }
#else
    a.ph_lo = 0; a.ph_hi = N_PHASES;
    void* args[] = {&a};
    const hipError_t e = hipLaunchCooperativeKernel((const void*)mk_fwd, dim3(grid), dim3(NWAVES * 64), args, LDS_BYTES, stream);
    if (e != hipSuccess) fprintf(stderr, "kernel_launch: cooperative launch failed: %s (grid %d)\n", hipGetErrorString(e), grid);
#endif
}
```
